# Optimizing an MI355X kernel written in HIP

```python
import jax
import jax.numpy as jnp
from jax import lax
import numpy as np

D_MODEL = 2048
BATCH = 2
SEQ = 8192
DEPTH = 4

N_MIXERS = 2
SC_KERNEL = 3
DN_HEAD_DIM = 128
DN_KEY_HEADS = D_MODEL // DN_HEAD_DIM
DN_VALUE_HEADS = 2 * DN_KEY_HEADS
DN_KEY_DIM = DN_KEY_HEADS * DN_HEAD_DIM
DN_VALUE_DIM = DN_VALUE_HEADS * DN_HEAD_DIM
DN_QKV_DIM = 2 * DN_KEY_DIM + DN_VALUE_DIM
DN_PROJ_DIM = DN_QKV_DIM + DN_VALUE_DIM + 2 * DN_VALUE_HEADS
DN_CONV_KERNEL = 4
DN_CHUNK = 64
FFN_HIDDEN = -(-8 * D_MODEL // (3 * 256)) * 256
DEEPNORM_ALPHA = (2 * DEPTH) ** 0.25
DEEPNORM_BETA = (8 * DEPTH) ** -0.25
LN_EPS = 1e-5
RMS_EPS = 1e-6
N_SC_LAYERS = (DEPTH + 1) // 2
N_DN_LAYERS = DEPTH // 2

kernel_name = 'hybrid_shortconv_gdn_deepnorm'


def layer_norm(x, gain, bias):
    xf = x.astype(jnp.float32)
    mu = jnp.mean(xf, -1, keepdims=True)
    var = jnp.mean(jnp.square(xf - mu), -1, keepdims=True)
    return ((xf - mu) * lax.rsqrt(var + LN_EPS) * gain + bias).astype(x.dtype)


def l2_normalize(t):
    return t * lax.rsqrt(jnp.sum(t * t, -1, keepdims=True) + RMS_EPS)


def causal_depthwise_conv(u, w):
    k = w.shape[0]
    s = u.shape[1]
    u_pad = jnp.pad(u, ((0, 0), (k - 1, 0), (0, 0)))
    out = u_pad[:, 0:s] * w[0]
    for j in range(1, k):
        out = out + u_pad[:, j:j + s] * w[j]
    return out


def short_conv_mixer(x, w_in, conv_w, w_out):
    proj = x @ w_in
    gate_b = proj[..., :D_MODEL]
    gate_c = proj[..., D_MODEL:2 * D_MODEL]
    h = proj[..., 2 * D_MODEL:]
    y = causal_depthwise_conv(gate_c * h, conv_w)
    return (gate_b * y) @ w_out


def chunk_gated_delta_rule(q, k, v, beta, g):
    b, s, h, dk = q.shape
    dv = v.shape[-1]
    c = DN_CHUNK
    n = s // c

    def blocks(t):
        return t.reshape(b, n, c, h, -1).transpose(0, 3, 1, 2, 4)

    q, k, v = blocks(q), blocks(k), blocks(v)
    beta = blocks(beta[..., None])[..., 0]
    g = lax.cumsum(blocks(g[..., None])[..., 0], axis=3)
    causal = jnp.tril(jnp.ones((c, c), dtype=bool))
    strict = jnp.tril(jnp.ones((c, c), dtype=bool), -1)
    decay = jnp.exp(jnp.where(causal, g[..., :, None] - g[..., None, :], -jnp.inf))
    k_beta = k * beta[..., None]
    v_beta = v * beta[..., None]
    a_kk = jnp.where(strict, jnp.einsum('bhncd,bhnmd->bhncm', k_beta, k) * decay, 0.0) + jnp.eye(c, dtype=q.dtype)
    rhs = jnp.concatenate([v_beta, k_beta * jnp.exp(g)[..., None]], axis=-1)
    sol = lax.linalg.triangular_solve(a_kk, rhs, left_side=True, lower=True)
    u = sol[..., :dv]
    w = sol[..., dv:]
    a_qk = jnp.einsum('bhncd,bhnmd->bhncm', q, k) * decay
    q_dec = q * jnp.exp(g)[..., None]
    k_tail = k * jnp.exp(g[..., -1:] - g)[..., None]
    chunk_decay = jnp.exp(g[..., -1])

    def step(state, inp):
        qd, kt, uc, wc, aqk, cd = inp
        v_new = uc - jnp.einsum('bhck,bhkv->bhcv', wc, state)
        o = jnp.einsum('bhck,bhkv->bhcv', qd, state) + jnp.einsum('bhcm,bhmv->bhcv', aqk, v_new)
        state = state * cd[..., None, None] + jnp.einsum('bhck,bhcv->bhkv', kt, v_new)
        return state, o

    xs = (jnp.moveaxis(q_dec, 2, 0), jnp.moveaxis(k_tail, 2, 0), jnp.moveaxis(u, 2, 0),
          jnp.moveaxis(w, 2, 0), jnp.moveaxis(a_qk, 2, 0), jnp.moveaxis(chunk_decay, 2, 0))
    _, o = lax.scan(step, jnp.zeros((b, h, dk, dv), q.dtype), xs)
    return o.transpose(1, 0, 3, 2, 4).reshape(b, s, h, dv)


def gated_deltanet(x, w_in, conv_w, a_log, dt_bias, norm_w, w_out):
    b, s, _ = x.shape
    proj = x @ w_in
    o1 = DN_QKV_DIM
    o2 = o1 + DN_VALUE_DIM
    o3 = o2 + DN_VALUE_HEADS
    qkv = proj[..., :o1]
    z = proj[..., o1:o2]
    beta_raw = proj[..., o2:o3]
    a_raw = proj[..., o3:]
    qkv = jax.nn.silu(causal_depthwise_conv(qkv, conv_w)).astype(jnp.float32)
    q = qkv[..., :DN_KEY_DIM].reshape(b, s, DN_KEY_HEADS, DN_HEAD_DIM)
    k = qkv[..., DN_KEY_DIM:2 * DN_KEY_DIM].reshape(b, s, DN_KEY_HEADS, DN_HEAD_DIM)
    v = qkv[..., 2 * DN_KEY_DIM:].reshape(b, s, DN_VALUE_HEADS, DN_HEAD_DIM)
    rep = DN_VALUE_HEADS // DN_KEY_HEADS
    q = jnp.repeat(l2_normalize(q) * (DN_HEAD_DIM ** -0.5), rep, axis=2)
    k = jnp.repeat(l2_normalize(k), rep, axis=2)
    beta = jax.nn.sigmoid(beta_raw.astype(jnp.float32))
    g = -jnp.exp(a_log.astype(jnp.float32)) * jax.nn.softplus(
        a_raw.astype(jnp.float32) + dt_bias.astype(jnp.float32))
    o = chunk_gated_delta_rule(q, k, v, beta, g)
    o = o * lax.rsqrt(jnp.mean(jnp.square(o), -1, keepdims=True) + RMS_EPS) * norm_w.astype(jnp.float32)
    o = o * jax.nn.silu(z.astype(jnp.float32).reshape(b, s, DN_VALUE_HEADS, DN_HEAD_DIM))
    return o.reshape(b, s, DN_VALUE_DIM).astype(x.dtype) @ w_out


def swiglu(x, w_gate_up, w_down):
    gu = x @ w_gate_up
    return (jax.nn.silu(gu[..., :FFN_HIDDEN]) * gu[..., FFN_HIDDEN:]) @ w_down


def setup_inputs(seed: int = 0) -> dict:
    key = jax.random.key(seed)
    ks = jax.random.split(key, 16)

    def normal(k, shape, scale):
        return jax.random.normal(k, shape, jnp.float32) * scale

    dt = jnp.exp(jax.random.uniform(ks[7], (N_DN_LAYERS, DN_VALUE_HEADS), jnp.float32,
                                    np.log(1e-3), np.log(1e-1)))
    return {
        'x': normal(ks[0], (BATCH, SEQ, D_MODEL), 1.0),
        'sc_w_in': normal(ks[1], (N_SC_LAYERS, D_MODEL, 3 * D_MODEL), D_MODEL ** -0.5),
        'sc_conv_w': normal(ks[2], (N_SC_LAYERS, SC_KERNEL, D_MODEL), SC_KERNEL ** -0.5),
        'sc_w_out': normal(ks[3], (N_SC_LAYERS, D_MODEL, D_MODEL), DEEPNORM_BETA * D_MODEL ** -0.5),
        'dn_w_in': normal(ks[4], (N_DN_LAYERS, D_MODEL, DN_PROJ_DIM), D_MODEL ** -0.5),
        'dn_conv_w': normal(ks[5], (N_DN_LAYERS, DN_CONV_KERNEL, DN_QKV_DIM), DN_CONV_KERNEL ** -0.5),
        'dn_a_log': jnp.log(jax.random.uniform(ks[6], (N_DN_LAYERS, DN_VALUE_HEADS), jnp.float32, 1.0, 16.0)),
        'dn_dt_bias': dt + jnp.log(-jnp.expm1(-dt)),
        'dn_norm_w': 1.0 + normal(ks[8], (N_DN_LAYERS, DN_HEAD_DIM), 0.01),
        'dn_w_out': normal(ks[9], (N_DN_LAYERS, DN_VALUE_DIM, D_MODEL), DEEPNORM_BETA * DN_VALUE_DIM ** -0.5),
        'ffn_w_gate_up': normal(ks[10], (DEPTH, D_MODEL, 2 * FFN_HIDDEN), D_MODEL ** -0.5),
        'ffn_w_down': normal(ks[11], (DEPTH, FFN_HIDDEN, D_MODEL), DEEPNORM_BETA * FFN_HIDDEN ** -0.5),
        'ln_gain': 1.0 + normal(ks[12], (DEPTH, 2, D_MODEL), 0.02),
        'ln_bias': normal(ks[13], (DEPTH, 2, D_MODEL), 0.02),
    }


def reference(x, sc_w_in, sc_conv_w, sc_w_out, dn_w_in, dn_conv_w, dn_a_log, dn_dt_bias,
              dn_norm_w, dn_w_out, ffn_w_gate_up, ffn_w_down, ln_gain, ln_bias):
    for i in range(DEPTH):
        j = i // N_MIXERS
        if i % N_MIXERS == 0:
            h = short_conv_mixer(x, sc_w_in[j], sc_conv_w[j], sc_w_out[j])
        else:
            h = gated_deltanet(x, dn_w_in[j], dn_conv_w[j], dn_a_log[j], dn_dt_bias[j],
                               dn_norm_w[j], dn_w_out[j])
        x = layer_norm(DEEPNORM_ALPHA * x + h, ln_gain[i, 0], ln_bias[i, 0])
        x = layer_norm(DEEPNORM_ALPHA * x + swiglu(x, ffn_w_gate_up[i], ffn_w_down[i]),
                       ln_gain[i, 1], ln_bias[i, 1])
    return x
```

```cpp
#include <hip/hip_runtime.h>
#include <cstdio>
#include <cstdint>
namespace pg8 {
#define PG8_LAS __attribute__((address_space(3)))
typedef unsigned short bf16_t;
typedef short bf16x8 __attribute__((ext_vector_type(8)));
typedef float f32x4 __attribute__((ext_vector_type(4)));
typedef unsigned u32x4 __attribute__((ext_vector_type(4)));
constexpr int BM = 256, BK = 64, HALF = 128, HTB = HALF * BK * 2  , STAGE_BYTES = 8 * HTB, NXCD = 8, WGM = 8;

__host__ __device__ __forceinline__ int lds_byte(int r, int c) { const int st = (r >> 4) * 2 + (c >> 5), rr = r & 15, cc = c & 31, ob = rr * 64 + cc * 2; return st * 1024 + (ob ^ (((ob >> 9) & 1) << 5)); }
__host__ __device__ __forceinline__ void stage_rc(int b, int& R, int& C) { const int st = b / 1024, sb = b % 1024, swz = sb ^ (((sb >> 9) & 1) << 5); R = (st >> 1) * 16 + swz / 64; C = (st & 1) * 32 + (swz % 64) / 2; }
__host__ __device__ __forceinline__ int perm32(int rho) { const int n = rho >> 4, i = rho & 15; return 8 * (i >> 2) + 4 * n + (i & 3); }

struct Unit { int pm, pn; };
struct Gemm { const bf16_t* A; const bf16_t* Bt; int M, N, K; };

struct StaticOrder {
    int nM, nN, nwg, G, c;
    __host__ __device__ void init(int M, int N, int G_, int c_) { nM = M / BM; nN = N / BM; nwg = nM * nN; G = G_; c = c_; }
    __host__ __device__ bool next(int i, Unit& u) const {
        const long L = (long)i * G + c; if (L >= nwg) return false;
        int wgid = (int)L; { const int q = nwg / NXCD, r = nwg % NXCD, xcd = wgid % NXCD, off = wgid / NXCD; wgid = (xcd < r ? xcd * (q + 1) : r * (q + 1) + (xcd - r) * q) + off; }
        const int nig = WGM * nN, gid = wgid / nig, fm = gid * WGM, gsz = (nM - fm) < WGM ? (nM - fm) : WGM;
        u.pm = fm + ((wgid % nig) % gsz); u.pn = (wgid % nig) / gsz; return true;
    }
    __device__ __forceinline__ void a_ready(const Unit&) const {}
    __device__ __forceinline__ void done(const Unit&) const {}
};


typedef float f32x2_t __attribute__((ext_vector_type(2)));
typedef __bf16 bf16x2_t __attribute__((ext_vector_type(2)));
__device__ __forceinline__ unsigned cvt_pk_bf16(float lo, float hi) { f32x2_t v = {lo, hi}; bf16x2_t b = __builtin_convertvector(v, bf16x2_t); return __builtin_bit_cast(unsigned, b); }
__device__ __forceinline__ float silu_f(float v) { return v * __builtin_amdgcn_rcpf(1.0f + __expf(-v)); }

struct EpiStore2 {
    static constexpr bool PERM = true, AFTER_DRAIN = false;
    bf16_t* O0; int ld0; bf16_t* O1; int ld1; int split;
    __device__ __forceinline__ void operator()(const f32x4 (&acc)[2][2][4][2], const Unit& u, int wr, int wc, int fr, int fq) const {
        int colt = u.pn * BM; bf16_t* base = O0; int ld = ld0;
        if (colt >= split) { base = O1; ld = ld1; colt -= split; }
        const int row0 = u.pm * BM + wr * 64 + fr, col0 = colt + wc * 32 + 8 * fq;
#pragma unroll
        for (int ai = 0; ai < 2; ++ai)
#pragma unroll
            for (int m = 0; m < 4; ++m) { bf16_t* rowp = base + (size_t)(row0 + ai * HALF + m * 16) * ld + col0;
#pragma unroll
                for (int bj = 0; bj < 2; ++bj) { const f32x4 v0 = acc[ai][bj][m][0], v1 = acc[ai][bj][m][1];
                    u32x4 w; w.x = cvt_pk_bf16(v0[0], v0[1]); w.y = cvt_pk_bf16(v0[2], v0[3]); w.z = cvt_pk_bf16(v1[0], v1[1]); w.w = cvt_pk_bf16(v1[2], v1[3]);
                    *(u32x4*)(rowp + bj * HALF) = w; } }
    }
};
template <int ACT> struct EpiGate {
    static constexpr bool PERM = true, AFTER_DRAIN = false;
    bf16_t* P; int ldp; bf16_t* G; int ldg; int pn_plain;
    __device__ __forceinline__ void operator()(const f32x4 (&acc)[2][2][4][2], const Unit& u, int wr, int wc, int fr, int fq) const {
        const int row0 = u.pm * BM + wr * 64 + fr;
        if (u.pn < pn_plain) {
            const int col0 = u.pn * BM + wc * 32 + 8 * fq;
#pragma unroll
            for (int ai = 0; ai < 2; ++ai)
#pragma unroll
                for (int m = 0; m < 4; ++m) { bf16_t* rowp = P + (size_t)(row0 + ai * HALF + m * 16) * ldp + col0;
#pragma unroll
                    for (int bj = 0; bj < 2; ++bj) { const f32x4 v0 = acc[ai][bj][m][0], v1 = acc[ai][bj][m][1];
                        u32x4 w; w.x = cvt_pk_bf16(v0[0], v0[1]); w.y = cvt_pk_bf16(v0[2], v0[3]); w.z = cvt_pk_bf16(v1[0], v1[1]); w.w = cvt_pk_bf16(v1[2], v1[3]);
                        *(u32x4*)(rowp + bj * HALF) = w; } }
        } else {
            const int col0 = (u.pn - pn_plain) * HALF + wc * 32 + 8 * fq;
#pragma unroll
            for (int ai = 0; ai < 2; ++ai)
#pragma unroll
                for (int m = 0; m < 4; ++m) { bf16_t* rowp = G + (size_t)(row0 + ai * HALF + m * 16) * ldg + col0;
                    f32x4 a0 = acc[ai][0][m][0], a1 = acc[ai][0][m][1]; const f32x4 b0 = acc[ai][1][m][0], b1 = acc[ai][1][m][1];
                    if (ACT == 1) {
#pragma unroll
                        for (int e = 0; e < 4; ++e) { a0[e] = silu_f(a0[e]); a1[e] = silu_f(a1[e]); } }
                    a0 = a0 * b0; a1 = a1 * b1;
                    u32x4 w; w.x = cvt_pk_bf16(a0[0], a0[1]); w.y = cvt_pk_bf16(a0[2], a0[3]); w.z = cvt_pk_bf16(a1[0], a1[1]); w.w = cvt_pk_bf16(a1[2], a1[3]);
                    *(u32x4*)rowp = w; }
        }
    }
};

template <class Epi, class Sched, bool ALIGN_EPI = false, bool SP2 = false>
__device__ __forceinline__ void gemm_phase(PG8_LAS unsigned char* lds, const Gemm g, const Sched& S, const Epi& E) {
    int tid_o = threadIdx.x; asm volatile("" : "+v"(tid_o));
    const int tid = tid_o, wid = __builtin_amdgcn_readfirstlane(tid >> 6), lane = tid & 63, wr = wid >> 2, wc = wid & 3, fr = lane & 15, fq = lane >> 4;
    const int K = g.K, nt = K / BK;
    unsigned voffA[2], voffB[2];
#pragma unroll
    for (int i = 0; i < 2; ++i) { int R, C; stage_rc(tid * 16 + i * 8192, R, C); const int Rb = Epi::PERM ? ((R & ~31) + perm32(R & 31)) : R;
        voffA[i] = (unsigned)(R * K + C) * 2u; voffB[i] = (unsigned)(Rb * K + C) * 2u; }
    const size_t kstep = (size_t)(BK * 2);
    const size_t hstep = (size_t)HALF * K * 2;
    const size_t tstep = 2 * hstep;
    const unsigned ldsw = (unsigned)wid * 1024u;
    const int aoff = lds_byte(wr * 64 + fr, fq * 8), boff = lds_byte(wc * 32 + fr, fq * 8);
#define PG8_SA(b, h) (((b) * 2 + (h)) * HTB)
#define PG8_SB(b, h) ((4 + (b) * 2 + (h)) * HTB)
#define PG8_STAGE(bufoff, gbase, voff) do { _Pragma("unroll") for (int _i = 0; _i < 2; ++_i) \
        __builtin_amdgcn_global_load_lds((const unsigned*)((const char*)(gbase) + (voff)[_i]), (PG8_LAS unsigned*)(lds + (bufoff) + ldsw + _i * 8192), 16, 0, 0); } while (0)
#define PG8_LDA(dst, b, h) do { _Pragma("unroll") for (int m = 0; m < 4; ++m) _Pragma("unroll") for (int k = 0; k < 2; ++k) dst[m][k] = *(const PG8_LAS bf16x8*)(lds + PG8_SA(b, h) + aoff + m * 2048 + k * 1024); } while (0)
#define PG8_LDB(dst, b, h) do { _Pragma("unroll") for (int n = 0; n < 2; ++n) _Pragma("unroll") for (int k = 0; k < 2; ++k) dst[n][k] = *(const PG8_LAS bf16x8*)(lds + PG8_SB(b, h) + boff + n * 2048 + k * 1024); } while (0)
#define PG8_MMA(ai, bj, At, Bt) do { __builtin_amdgcn_s_setprio(1); _Pragma("unroll") for (int m = 0; m < 4; ++m) _Pragma("unroll") for (int n = 0; n < 2; ++n) _Pragma("unroll") for (int k = 0; k < 2; ++k) \
        acc[ai][bj][m][n] = __builtin_amdgcn_mfma_f32_16x16x32_bf16(Bt[n][k], At[m][k], acc[ai][bj][m][n], 0, 0, 0); __builtin_amdgcn_s_setprio(0); } while (0)
#define PG8_WAIT_V(n) asm volatile("s_waitcnt vmcnt(" #n ")" ::: "memory")
#define PG8_WAIT_L(n) asm volatile("s_waitcnt lgkmcnt(" #n ")" ::: "memory")
#define PG8_BAR __builtin_amdgcn_s_barrier()
#define PG8_SCHED __builtin_amdgcn_sched_barrier(0)
    Unit cur, nxt; int ui = 0;
    if (!S.next(0, cur)) return;
    f32x4 acc[2][2][4][2];
#pragma unroll
    for (int a = 0; a < 2; ++a)
#pragma unroll
        for (int b = 0; b < 2; ++b)
#pragma unroll
            for (int m = 0; m < 4; ++m)
#pragma unroll
                for (int n = 0; n < 2; ++n) acc[a][b][m][n] = (f32x4){0.f, 0.f, 0.f, 0.f};
    bf16x8 At[4][2], B0[2][2], B1[2][2];
    const char* cA = (const char*)g.A + (size_t)cur.pm * tstep; const char* cB = (const char*)g.Bt + (size_t)cur.pn * tstep;
    S.a_ready(cur);
    if constexpr (SP2) {
        PG8_STAGE(PG8_SB(0, 0), cB, voffB); PG8_STAGE(PG8_SB(0, 1), cB + hstep, voffB); PG8_STAGE(PG8_SA(0, 0), cA, voffA); PG8_STAGE(PG8_SA(0, 1), cA + hstep, voffA);
        if (wr == 1) PG8_BAR;
        PG8_WAIT_V(2); PG8_BAR;
        PG8_STAGE(PG8_SB(1, 0), cB + kstep, voffB); PG8_STAGE(PG8_SA(1, 0), cA + kstep, voffA); PG8_STAGE(PG8_SB(1, 1), cB + hstep + kstep, voffB);
        PG8_WAIT_V(6); PG8_BAR;
    } else {
        PG8_STAGE(PG8_SB(0, 0), cB, voffB); PG8_STAGE(PG8_SA(0, 0), cA, voffA); PG8_STAGE(PG8_SB(0, 1), cB + hstep, voffB); PG8_STAGE(PG8_SA(0, 1), cA + hstep, voffA);
        if (wr == 1) PG8_BAR;
        PG8_WAIT_V(4); PG8_BAR;
        PG8_STAGE(PG8_SB(1, 0), cB + kstep, voffB); PG8_STAGE(PG8_SA(1, 0), cA + kstep, voffA); PG8_STAGE(PG8_SB(1, 1), cB + hstep + kstep, voffB);
        PG8_WAIT_V(6); PG8_BAR;
    }
    for (;;) {
        const bool has_next = S.next(ui + 1, nxt);
        const char* nA = has_next ? (const char*)g.A + (size_t)nxt.pm * tstep : cA; const char* nB = has_next ? (const char*)g.Bt + (size_t)nxt.pn * tstep : cB;
        for (int t = 0; t < nt; t += 2) {
            const bool last = (t == nt - 2);
            const char* a1 = cA + (size_t)(t + 1) * kstep;
            const char* a2 = last ? nA : cA + (size_t)(t + 2) * kstep; const char* b2 = last ? nB : cB + (size_t)(t + 2) * kstep;
            const char* a3 = a2 + kstep; const char* b3 = b2 + kstep;
            if (last && has_next) S.a_ready(nxt);
            if constexpr (SP2) {
            PG8_LDB(B0, 0, 0); PG8_LDB(B1, 0, 1); PG8_SCHED; PG8_LDA(At, 0, 0); PG8_STAGE(PG8_SA(1, 1), a1 + hstep, voffA);
            PG8_WAIT_V(8); PG8_WAIT_L(0); PG8_BAR; PG8_MMA(0, 0, At, B0); PG8_MMA(0, 1, At, B1); PG8_BAR; PG8_SCHED;
            PG8_LDA(At, 0, 1); PG8_STAGE(PG8_SB(0, 0), b2, voffB); PG8_STAGE(PG8_SB(0, 1), b2 + hstep, voffB); PG8_STAGE(PG8_SA(0, 0), a2, voffA);
            PG8_WAIT_V(8); PG8_WAIT_L(0); PG8_BAR; PG8_MMA(1, 0, At, B0); PG8_MMA(1, 1, At, B1); PG8_BAR; PG8_SCHED;
            PG8_LDB(B0, 1, 0); PG8_LDB(B1, 1, 1); PG8_SCHED; PG8_LDA(At, 1, 0); PG8_STAGE(PG8_SA(0, 1), a2 + hstep, voffA);
            PG8_WAIT_V(8); PG8_WAIT_L(0); PG8_BAR; PG8_MMA(0, 0, At, B0); PG8_MMA(0, 1, At, B1); PG8_BAR; PG8_SCHED;
            PG8_LDA(At, 1, 1); PG8_STAGE(PG8_SB(1, 0), b3, voffB); PG8_STAGE(PG8_SB(1, 1), b3 + hstep, voffB); PG8_STAGE(PG8_SA(1, 0), a3, voffA);
            PG8_WAIT_V(8); PG8_WAIT_L(0); PG8_BAR; PG8_MMA(1, 0, At, B0); PG8_MMA(1, 1, At, B1); PG8_BAR; PG8_SCHED;
            } else {
            PG8_LDB(B0, 0, 0); PG8_SCHED; PG8_LDA(At, 0, 0); PG8_STAGE(PG8_SA(1, 1), a1 + hstep, voffA);
            PG8_WAIT_L(8); PG8_BAR; PG8_WAIT_L(0); PG8_MMA(0, 0, At, B0); PG8_BAR; PG8_SCHED;
            PG8_LDB(B1, 0, 1); PG8_STAGE(PG8_SB(0, 0), b2, voffB);
            PG8_BAR; PG8_WAIT_L(0); PG8_MMA(0, 1, At, B1); PG8_BAR;
            PG8_LDA(At, 0, 1); PG8_STAGE(PG8_SA(0, 0), a2, voffA);
            PG8_BAR; PG8_WAIT_L(0); PG8_MMA(1, 0, At, B0); PG8_BAR; PG8_SCHED;
            PG8_STAGE(PG8_SB(0, 1), b2 + hstep, voffB);
            PG8_WAIT_V(6); PG8_BAR; PG8_MMA(1, 1, At, B1); PG8_BAR;
            PG8_LDB(B0, 1, 0); PG8_SCHED; PG8_LDA(At, 1, 0); PG8_STAGE(PG8_SA(0, 1), a2 + hstep, voffA);
            PG8_WAIT_L(8); PG8_BAR; PG8_WAIT_L(0); PG8_MMA(0, 0, At, B0); PG8_BAR; PG8_SCHED;
            PG8_LDB(B1, 1, 1); PG8_STAGE(PG8_SB(1, 0), b3, voffB);
            PG8_BAR; PG8_WAIT_L(0); PG8_MMA(0, 1, At, B1); PG8_BAR;
            PG8_LDA(At, 1, 1); PG8_STAGE(PG8_SA(1, 0), a3, voffA);
            PG8_BAR; PG8_WAIT_L(0); PG8_MMA(1, 0, At, B0); PG8_BAR; PG8_SCHED;
            PG8_STAGE(PG8_SB(1, 1), b3 + hstep, voffB);
            PG8_WAIT_V(6); PG8_BAR; PG8_MMA(1, 1, At, B1); PG8_BAR;
            }
        }
        if constexpr (ALIGN_EPI) { if (wr == 0) PG8_BAR; }
        if constexpr (!Epi::AFTER_DRAIN) { E(acc, cur, wr, wc, fr, fq); S.done(cur); }
        if (!has_next) break;
#pragma unroll
        for (int a = 0; a < 2; ++a)
#pragma unroll
            for (int b = 0; b < 2; ++b)
#pragma unroll
                for (int m = 0; m < 4; ++m)
#pragma unroll
                    for (int n = 0; n < 2; ++n) acc[a][b][m][n] = (f32x4){0.f, 0.f, 0.f, 0.f};
        cur = nxt; cA = nA; cB = nB; ++ui;
        if constexpr (ALIGN_EPI) { if (wr == 1) PG8_BAR; }
    }
    PG8_WAIT_V(0);
    if constexpr (!ALIGN_EPI) { if (wr == 0) PG8_BAR; }
    PG8_BAR;
    if constexpr (Epi::AFTER_DRAIN) { E.fused(acc, cur, wr, wc, fr, fq, lds, wid, lane); S.done(cur); }
#undef PG8_SA
#undef PG8_SB
#undef PG8_STAGE
#undef PG8_LDA
#undef PG8_LDB
#undef PG8_MMA
#undef PG8_WAIT_V
#undef PG8_WAIT_L
#undef PG8_BAR
#undef PG8_SCHED
}
}

#ifndef PG8_SP2
#define PG8_SP2 true
#endif
#ifndef PG8_ALIGN
#define PG8_ALIGN true
#endif
#ifndef MK_PER_PHASE
#define MK_PER_PHASE 0
#endif

constexpr int NWAVES = 8;
constexpr int DM = 2048, BATCH = 2, SEQ = 8192, M = BATCH * SEQ, DEPTH = 4;
constexpr int HD = 128, HK = 16, HV = 32, KDIM = 2048, VDIM = 4096, QKV = 8192;
constexpr int DNP = 12352, DNP_MAIN = 12288;
constexpr int FF = 5632;
constexpr float LN_EPS = 1e-5f, RMS_EPS = 1e-6f;
constexpr float ALPHA = 1.6817928305074290f;
constexpr int N_PHASES = 33;

constexpr size_t MiB = 1u << 20;
constexpr size_t WS_CTL = 0, CTL_ZERO_BYTES = 1 * MiB;
constexpr size_t WS_W_SCIN = 1 * MiB;
constexpr size_t WS_W_SCOUT = WS_W_SCIN + 48 * MiB;
constexpr size_t WS_W_DNIN = WS_W_SCOUT + 16 * MiB;
constexpr size_t WS_W_BA = WS_W_DNIN + 96 * MiB;
constexpr size_t WS_W_DNOUT = WS_W_BA + 1 * MiB;
constexpr size_t WS_W_GU = WS_W_DNOUT + 32 * MiB;
constexpr size_t WS_W_DOWN = WS_W_GU + 176 * MiB;
constexpr size_t WS_XB = WS_W_DOWN + 88 * MiB;
constexpr size_t WS_BIGA = WS_XB + 64 * MiB;
constexpr size_t WS_QKV = WS_BIGA, WS_Z = WS_BIGA + 256 * MiB, WS_O = WS_BIGA;
constexpr size_t WS_GB = WS_BIGA, WS_CU = WS_BIGA + 64 * MiB, WS_A2 = WS_BIGA + 128 * MiB, WS_HID = WS_BIGA;
constexpr size_t WS_BIGB = WS_BIGA + 384 * MiB;
constexpr size_t WS_QC = WS_BIGB, WS_KC = WS_BIGB + 64 * MiB, WS_VC = WS_BIGB + 128 * MiB, WS_A3 = WS_BIGB + 256 * MiB, WS_H1 = WS_BIGB;
constexpr size_t WS_BA = WS_BIGB + 384 * MiB;
constexpr size_t WS_BETA = WS_BA + 4 * MiB, WS_DEC = WS_BETA + 2 * MiB;
constexpr size_t WS_END = WS_DEC + 2 * MiB;
static_assert(WS_END <= (size_t)1476395008ull, "d_ws map exceeds the guaranteed workspace");
constexpr int CW_BAR = 4096;

constexpr int RING_OFF = 0, RING_BYTES = 131072;
constexpr int LDSCTL_OFF = RING_BYTES, MISC_OFF = LDSCTL_OFF + 320, PTAB_OFF = LDSCTL_OFF + 1024;
constexpr int LDS_BYTES = 147456;

#define GAS __attribute__((address_space(1)))
#define LAS __attribute__((address_space(3)))
typedef unsigned short bf16;
typedef unsigned v4u __attribute__((ext_vector_type(4)));
typedef unsigned v2u __attribute__((ext_vector_type(2)));
typedef float f32x4 __attribute__((ext_vector_type(4)));
typedef float f32x16 __attribute__((ext_vector_type(16)));
typedef short bf16x8 __attribute__((ext_vector_type(8)));
typedef GAS unsigned gu32;
#define RLX_AGENT __ATOMIC_RELAXED, __HIP_MEMORY_SCOPE_AGENT
#define LDS_WAIT() asm volatile("s_waitcnt lgkmcnt(0)" ::: "memory")
#define VM_WAIT() asm volatile("s_waitcnt vmcnt(0)" ::: "memory")
__device__ __forceinline__ unsigned pk2(float lo, float hi) { return pg8::cvt_pk_bf16(lo, hi); }
__device__ __forceinline__ float bf_lo(unsigned w) { return __uint_as_float(w << 16); }
__device__ __forceinline__ float bf_hi(unsigned w) { return __uint_as_float(w & 0xffff0000u); }
__device__ __forceinline__ float silu_f(float v) { return v * __builtin_amdgcn_rcpf(1.0f + __expf(-v)); }
#define XB_TMO      128
#define XB_XCNT(j)  (256  + 64 * (j))
#define XB_XSUB(j)  (1280 + 64 * (j))
#define XB_XGEN(j)  (2304 + 64 * (j))
#define XB_TOP      3328
#define XB_TOPGEN   3392
#define XCD_BAR_WORDS 3456
#define XB_SPIN_CAP (1u << 21)

__device__ __forceinline__ unsigned xb_ld(unsigned* p)              { return __hip_atomic_load(p, __ATOMIC_RELAXED, __HIP_MEMORY_SCOPE_AGENT); }
__device__ __forceinline__ unsigned xb_add(unsigned* p, unsigned v) { return __hip_atomic_fetch_add(p, v, __ATOMIC_RELAXED, __HIP_MEMORY_SCOPE_AGENT); }
__device__ __forceinline__ unsigned xb_xcc_id() { return (unsigned)__builtin_amdgcn_s_getreg((3 << 11) | 20) & 0xFu; }
#define XB_SPIN(cond, bar) do { unsigned _sp = 0; while (cond) { __builtin_amdgcn_s_sleep(1); \
    if ((++_sp & 255u) == 0u) { if (xb_ld(&(bar)[XB_TMO])) break; if (_sp > XB_SPIN_CAP) { atomicAdd(&(bar)[XB_TMO], 1u); break; } } } } while (0)

struct XcdBarrier {
    unsigned* bar; unsigned x;
    volatile LAS unsigned* st;
};

__device__ __forceinline__ XcdBarrier xcd_barrier_post(unsigned* bar, volatile LAS unsigned* st) {
    XcdBarrier b; b.bar = bar; b.x = xb_xcc_id(); b.st = st;
    if (threadIdx.x == 0) (void)xb_add(&bar[XB_XCNT(b.x)], 1u);
    return b;
}
__device__ __forceinline__ void xcd_barrier_complete(unsigned* bar, unsigned x, unsigned& nloc, unsigned& nx) {
    const unsigned G = gridDim.x * gridDim.y * gridDim.z;
    unsigned sum, cnt, mine, sp = 0u;
    for (;;) {
        sum = 0u; cnt = 0u; mine = 0u;
#pragma unroll
        for (unsigned j = 0; j < 16; ++j) { const unsigned c = xb_ld(&bar[XB_XCNT(j)]); sum += c; cnt += (c > 0u) ? 1u : 0u; mine = (j == x) ? c : mine; }
        if (sum == G) break;
        __builtin_amdgcn_s_sleep(1);
        if ((++sp & 255u) == 0u) { if (xb_ld(&bar[XB_TMO])) break; if (sp > XB_SPIN_CAP) { atomicAdd(&bar[XB_TMO], 1u); break; } }
    }
    nloc = mine > 0u ? mine : 1u; nx = cnt > 0u ? cnt : 1u;
}

__device__ __forceinline__ void xcd_barrier(const XcdBarrier& b) {
    asm volatile("s_waitcnt vmcnt(0)" ::: "memory");
    __syncthreads();
    if (threadIdx.x == 0) {
        unsigned* bar = b.bar;
        __builtin_amdgcn_s_waitcnt(0);
        unsigned nloc = b.st[0], nx = b.st[1];
        if (nloc == 0u) { xcd_barrier_complete(bar, b.x, nloc, nx); b.st[0] = nloc; b.st[1] = nx; }
        const unsigned old = xb_add(&bar[XB_XSUB(b.x)], 1u);
        const unsigned gen = old / nloc;
        if (old + 1u == (gen + 1u) * nloc) {
            __builtin_amdgcn_fence(__ATOMIC_RELEASE, "agent");
            asm volatile("s_waitcnt vmcnt(0)" ::: "memory");
            const unsigned og = xb_add(&bar[XB_TOP], 1u);
            const unsigned tg = og / nx;
            if (og + 1u == (tg + 1u) * nx) xb_add(&bar[XB_TOPGEN], 1u);
            else XB_SPIN(xb_ld(&bar[XB_TOPGEN]) == tg, bar);
            __builtin_amdgcn_fence(__ATOMIC_ACQUIRE, "agent");
            xb_add(&bar[XB_XGEN(b.x)], 1u);
            asm volatile("s_waitcnt vmcnt(0)" ::: "memory");
        } else {
            XB_SPIN(xb_ld(&bar[XB_XGEN(b.x)]) == gen, bar);
            __builtin_amdgcn_fence(__ATOMIC_ACQUIRE, "agent");
            asm volatile("s_waitcnt vmcnt(0)" ::: "memory");
        }
    }
    __syncthreads();
}

__device__ __forceinline__ float wave_sum(float v) {
#pragma unroll
    for (int o = 1; o < 64; o <<= 1) v += __shfl_xor(v, o);
    return v;
}
__device__ __forceinline__ float sum16(float v) {
    v += __shfl_xor(v, 1); v += __shfl_xor(v, 2); v += __shfl_xor(v, 4); v += __shfl_xor(v, 8);
    return v;
}
template <int CTRL> __device__ __forceinline__ float dppf(float v) { return __builtin_bit_cast(float, __builtin_amdgcn_update_dpp(0, __builtin_bit_cast(int, v), CTRL, 0xF, 0xF, false)); }
__device__ __forceinline__ float rowsum16(float v) {
    v += dppf<0x128>(v); v += dppf<0x124>(v); v += dppf<0x122>(v); v += dppf<0x121>(v);
    return v;
}
__device__ __forceinline__ void unpack8(const v4u w, float (&f)[8]) {
    f[0] = bf_lo(w.x); f[1] = bf_hi(w.x); f[2] = bf_lo(w.y); f[3] = bf_hi(w.y); f[4] = bf_lo(w.z); f[5] = bf_hi(w.z); f[6] = bf_lo(w.w); f[7] = bf_hi(w.w);
}
__device__ __forceinline__ v4u pack8(const float (&f)[8]) { v4u o; o.x = pk2(f[0], f[1]); o.y = pk2(f[2], f[3]); o.z = pk2(f[4], f[5]); o.w = pk2(f[6], f[7]); return o; }

__device__ __forceinline__ void p0_transpose_item(const float* W, int ldw, int src_col0, bf16* WT, int K, int dst_row0, int k0, LAS float* scr, int lane) {
#pragma unroll 8
    for (int i = 0; i < 32; ++i) { const int kk = 2 * i + (lane >> 5); scr[kk * 33 + (lane & 31)] = W[(size_t)(k0 + kk) * ldw + src_col0 + (lane & 31)]; }
    LDS_WAIT(); asm volatile("" ::: "memory");
    const int c = lane & 7;
#pragma unroll
    for (int j = 0; j < 4; ++j) { const int n = (lane >> 3) + 8 * j; const LAS float* s = scr + (8 * c) * 33 + n;
        v4u o; o.x = pk2(s[0 * 33], s[1 * 33]); o.y = pk2(s[2 * 33], s[3 * 33]); o.z = pk2(s[4 * 33], s[5 * 33]); o.w = pk2(s[6 * 33], s[7 * 33]);
        *(GAS v4u*)(WT + (size_t)(dst_row0 + n) * K + k0 + 8 * c) = o; }
    LDS_WAIT(); asm volatile("" ::: "memory");
}

struct Ptrs {
    const float *x, *sc_w_in, *sc_conv_w, *sc_w_out, *dn_w_in, *dn_conv_w, *dn_a_log, *dn_dt_bias, *dn_norm_w, *dn_w_out, *ffn_gu, *ffn_down, *ln_gain, *ln_bias;
    float* out; unsigned char* ws;
};

__device__ __forceinline__ void p0_prologue(const Ptrs& P, LAS unsigned char* lds, int gw, int NGW, int wave, int lane) {
    LAS float* scr = (LAS float*)(lds + RING_OFF + wave * 16384);
    constexpr int I_SCIN = 32 * 192, I_SCOUT = 32 * 64, I_DNIN = 32 * 384, I_BA = 32 * 2, I_DNOUT = 64 * 64, I_GU = 32 * 352, I_DOWN = 88 * 64;
    constexpr int NITEMS = 2 * (I_SCIN + I_SCOUT + I_DNIN + I_BA + I_DNOUT) + 4 * (I_GU + I_DOWN);
    for (int it = gw; it < NITEMS; it += NGW) {
        int r = it; const float* W; int ldw, K, nblk, mode; bf16* WT; int layer;
        if (r < 2 * I_SCIN) { layer = r / I_SCIN; r -= layer * I_SCIN; W = P.sc_w_in + (size_t)layer * DM * 3 * DM; ldw = 3 * DM; K = DM; nblk = 192; mode = 1; WT = (bf16*)(P.ws + WS_W_SCIN) + (size_t)layer * 3 * DM * DM; }
        else { r -= 2 * I_SCIN;
        if (r < 2 * I_SCOUT) { layer = r / I_SCOUT; r -= layer * I_SCOUT; W = P.sc_w_out + (size_t)layer * DM * DM; ldw = DM; K = DM; nblk = 64; mode = 0; WT = (bf16*)(P.ws + WS_W_SCOUT) + (size_t)layer * DM * DM; }
        else { r -= 2 * I_SCOUT;
        if (r < 2 * I_DNIN) { layer = r / I_DNIN; r -= layer * I_DNIN; W = P.dn_w_in + (size_t)layer * DM * DNP; ldw = DNP; K = DM; nblk = 384; mode = 0; WT = (bf16*)(P.ws + WS_W_DNIN) + (size_t)layer * DNP_MAIN * DM; }
        else { r -= 2 * I_DNIN;
        if (r < 2 * I_BA) { layer = r / I_BA; r -= layer * I_BA; W = P.dn_w_in + (size_t)layer * DM * DNP; ldw = DNP; K = DM; nblk = 2; mode = 3; WT = (bf16*)(P.ws + WS_W_BA) + (size_t)layer * 64 * DM; }
        else { r -= 2 * I_BA;
        if (r < 2 * I_DNOUT) { layer = r / I_DNOUT; r -= layer * I_DNOUT; W = P.dn_w_out + (size_t)layer * VDIM * DM; ldw = DM; K = VDIM; nblk = 64; mode = 0; WT = (bf16*)(P.ws + WS_W_DNOUT) + (size_t)layer * DM * VDIM; }
        else { r -= 2 * I_DNOUT;
        if (r < 4 * I_GU) { layer = r / I_GU; r -= layer * I_GU; W = P.ffn_gu + (size_t)layer * DM * 2 * FF; ldw = 2 * FF; K = DM; nblk = 352; mode = 2; WT = (bf16*)(P.ws + WS_W_GU) + (size_t)layer * 2 * FF * DM; }
        else { r -= 4 * I_GU; layer = r / I_DOWN; r -= layer * I_DOWN; W = P.ffn_down + (size_t)layer * FF * DM; ldw = DM; K = FF; nblk = 64; mode = 0; WT = (bf16*)(P.ws + WS_W_DOWN) + (size_t)layer * DM * FF; } } } } } }
        const int kb = r / nblk, nb = r % nblk, n0 = 32 * nb;
        int src;
        if (mode == 0) src = n0;
        else if (mode == 1) { if (n0 < DM) src = n0; else { const int n2 = n0 - DM; src = DM + ((n2 >> 7) & 1) * DM + (n2 >> 8) * 128 + (n2 & 127); } }
        else if (mode == 2) src = ((n0 >> 7) & 1) * FF + (n0 >> 8) * 128 + (n0 & 127);
        else src = DNP_MAIN + n0;
        p0_transpose_item(W, ldw, src, WT, K, n0, 64 * kb, scr, lane);
    }
    bf16* XB = (bf16*)(P.ws + WS_XB);
    for (int m = gw; m < M; m += NGW) {
        const GAS f32x4* xr = (const GAS f32x4*)(P.x + (size_t)m * DM) + lane;
        GAS v2u* o8 = (GAS v2u*)(XB + (size_t)m * DM) + lane;
#pragma unroll
        for (int j = 0; j < 8; ++j) { const f32x4 v = xr[64 * j]; v2u o; o.x = pk2(v.x, v.y); o.y = pk2(v.z, v.w); o8[64 * j] = o; }
    }
}

__device__ __forceinline__ void ln_phase(const float* xin, const bf16* H, const float* gain, const float* bias, float* xout, bf16* XB, int gw, int NGW, int lane) {
    f32x4 g[8], bb[8];
#pragma unroll
    for (int j = 0; j < 8; ++j) { g[j] = ((const GAS f32x4*)gain)[lane + 64 * j]; bb[j] = ((const GAS f32x4*)bias)[lane + 64 * j]; }
    for (int m = gw; m < M; m += NGW) {
        const GAS f32x4* xr = (const GAS f32x4*)(xin + (size_t)m * DM) + lane;
        const GAS v2u* hr = (const GAS v2u*)(H + (size_t)m * DM) + lane;
        f32x4 v[8]; float s = 0.f;
#pragma unroll
        for (int j = 0; j < 8; ++j) { const f32x4 xv = xr[64 * j]; const v2u hv = hr[64 * j];
            v[j].x = ALPHA * xv.x + bf_lo(hv.x); v[j].y = ALPHA * xv.y + bf_hi(hv.x); v[j].z = ALPHA * xv.z + bf_lo(hv.y); v[j].w = ALPHA * xv.w + bf_hi(hv.y);
            s += (v[j].x + v[j].y) + (v[j].z + v[j].w); }
        const float mean = wave_sum(s) * (1.f / DM); float s2 = 0.f;
#pragma unroll
        for (int j = 0; j < 8; ++j) { v[j] = v[j] - mean; s2 += (v[j].x * v[j].x + v[j].y * v[j].y) + (v[j].z * v[j].z + v[j].w * v[j].w); }
        const float rstd = 1.f / sqrtf(wave_sum(s2) * (1.f / DM) + LN_EPS);
        GAS f32x4* xo = (GAS f32x4*)(xout + (size_t)m * DM) + lane;
        GAS v2u* bo = (GAS v2u*)(XB + (size_t)m * DM) + lane;
#pragma unroll
        for (int j = 0; j < 8; ++j) { const f32x4 o = v[j] * rstd * g[j] + bb[j]; xo[64 * j] = o; v2u w; w.x = pk2(o.x, o.y); w.y = pk2(o.z, o.w); bo[64 * j] = w; }
    }
}

__device__ __forceinline__ void sc_conv_phase(const bf16* GB, const bf16* CU, const float* cw  , bf16* A2, int gt, int NGT) {
    constexpr int RB = 16, NCG = DM / 8, NITEMS = (M / RB) * NCG;
    for (int it = gt; it < NITEMS; it += NGT) {
        const int cgp = it % NCG, rb = it / NCG, c0 = cgp * 8, r0 = rb * RB;
        float w0[8], w1[8], w2[8];
#pragma unroll
        for (int e = 0; e < 8; e += 4) { const f32x4 a = *(const GAS f32x4*)(cw + c0 + e), b = *(const GAS f32x4*)(cw + DM + c0 + e), c = *(const GAS f32x4*)(cw + 2 * DM + c0 + e);
            w0[e] = a.x; w0[e + 1] = a.y; w0[e + 2] = a.z; w0[e + 3] = a.w; w1[e] = b.x; w1[e + 1] = b.y; w1[e + 2] = b.z; w1[e + 3] = b.w; w2[e] = c.x; w2[e + 1] = c.y; w2[e + 2] = c.z; w2[e + 3] = c.w; }
        float um2[8], um1[8];
        const bool first = (r0 % SEQ) == 0;
        if (first) {
#pragma unroll
            for (int e = 0; e < 8; ++e) { um2[e] = 0.f; um1[e] = 0.f; } }
        else { unpack8(*(const GAS v4u*)(CU + (size_t)(r0 - 2) * DM + c0), um2); unpack8(*(const GAS v4u*)(CU + (size_t)(r0 - 1) * DM + c0), um1); }
#pragma unroll 4
        for (int r = 0; r < RB; ++r) {
            float u0[8], gb[8], o[8];
            unpack8(*(const GAS v4u*)(CU + (size_t)(r0 + r) * DM + c0), u0);
            unpack8(*(const GAS v4u*)(GB + (size_t)(r0 + r) * DM + c0), gb);
#pragma unroll
            for (int e = 0; e < 8; ++e) { o[e] = gb[e] * (w0[e] * um2[e] + w1[e] * um1[e] + w2[e] * u0[e]); um2[e] = um1[e]; um1[e] = u0[e]; }
            *(GAS v4u*)(A2 + (size_t)(r0 + r) * DM + c0) = pack8(o);
        }
    }
}

__device__ __forceinline__ void dn_pre_phase(const bf16* QKVr, const float* cw  , bf16* QC, bf16* KC, bf16* VC, const float* BA, const float* a_log, const float* dt_bias, float* BETA, float* DEC,
                                             int gw, int NGW, int lane, int gt, int NGT) {
    constexpr int RB = 8, NCG = QKV / 512, NITEMS = (M / RB) * NCG;
    for (int it = gw; it < NITEMS; it += NGW) {
        const int cgp = it % NCG, rb = it / NCG, c0 = cgp * 512 + lane * 8, r0 = rb * RB;
        float w[4][8];
#pragma unroll
        for (int j = 0; j < 4; ++j)
#pragma unroll
            for (int e = 0; e < 8; e += 4) { const f32x4 a = *(const GAS f32x4*)(cw + (size_t)j * QKV + c0 + e); w[j][e] = a.x; w[j][e + 1] = a.y; w[j][e + 2] = a.z; w[j][e + 3] = a.w; }
        float h3[8], h2[8], h1[8];
        const bool first = (r0 % SEQ) == 0;
        if (first) {
#pragma unroll
            for (int e = 0; e < 8; ++e) { h3[e] = 0.f; h2[e] = 0.f; h1[e] = 0.f; } }
        else { unpack8(*(const GAS v4u*)(QKVr + (size_t)(r0 - 3) * QKV + c0), h3); unpack8(*(const GAS v4u*)(QKVr + (size_t)(r0 - 2) * QKV + c0), h2); unpack8(*(const GAS v4u*)(QKVr + (size_t)(r0 - 1) * QKV + c0), h1); }
        bf16* dst; int ldd, cd; float qs = 1.f; bool norm;
        if (c0 < KDIM) { dst = QC; ldd = KDIM; cd = c0; norm = true; qs = 0.08838834764831845f; }
        else if (c0 < 2 * KDIM) { dst = KC; ldd = KDIM; cd = c0 - KDIM; norm = true; }
        else { dst = VC; ldd = VDIM; cd = c0 - 2 * KDIM; norm = false; }
#pragma unroll 2
        for (int r = 0; r < RB; ++r) {
            float u0[8], o[8]; float ss = 0.f;
            unpack8(*(const GAS v4u*)(QKVr + (size_t)(r0 + r) * QKV + c0), u0);
#pragma unroll
            for (int e = 0; e < 8; ++e) { const float c = w[0][e] * h3[e] + w[1][e] * h2[e] + w[2][e] * h1[e] + w[3][e] * u0[e]; o[e] = silu_f(c); ss += o[e] * o[e]; h3[e] = h2[e]; h2[e] = h1[e]; h1[e] = u0[e]; }
            if (norm) { ss = sum16(ss); const float sc = qs / sqrtf(ss + RMS_EPS);
#pragma unroll
                for (int e = 0; e < 8; ++e) o[e] *= sc; }
            *(GAS v4u*)(dst + (size_t)(r0 + r) * ldd + cd) = pack8(o);
        }
    }
    for (int i = gt; i < M * HV; i += NGT) {
        const int hv = i & (HV - 1), row = i >> 5;
        const float br = BA[(size_t)row * 64 + hv], ar = BA[(size_t)row * 64 + HV + hv];
        const float xx = ar + dt_bias[hv];
        const float sp = fmaxf(xx, 0.f) + log1pf(__expf(-fabsf(xx)));
        const float gg = -__expf(a_log[hv]) * sp;
        BETA[i] = 1.f / (1.f + __expf(-br));
        DEC[i] = __expf(gg);
    }
}

__device__ __forceinline__ void ba_phase(const bf16* XB, const bf16* Wba, float* BA, LAS unsigned char* lds, int unit, int wave, int lane) {
    const int mt = wave & 1, nt = (wave >> 1) & 1, kh = wave >> 2, r = lane & 31, h = lane >> 5;
    const bf16* ap = XB + (size_t)(unit * 64 + mt * 32 + r) * DM + kh * 1024 + 8 * h;
    const bf16* bp = Wba + (size_t)(nt * 32 + r) * DM + kh * 1024 + 8 * h;
    f32x16 acc = {};
#pragma unroll 8
    for (int ks = 0; ks < 64; ++ks) {
        const bf16x8 a = *(const GAS bf16x8*)(ap + ks * 16), b = *(const GAS bf16x8*)(bp + ks * 16);
        acc = __builtin_amdgcn_mfma_f32_32x32x16_bf16(a, b, acc, 0, 0, 0);
    }
    LAS float* red = (LAS float*)(lds + RING_OFF);
    if (kh == 1) {
#pragma unroll
        for (int i = 0; i < 16; ++i) red[((wave - 4) * 16 + i) * 64 + lane] = acc[i]; }
    __syncthreads();
    if (kh == 0) {
#pragma unroll
        for (int i = 0; i < 16; ++i) { const float v = acc[i] + red[(wave * 16 + i) * 64 + lane];
            const int row = unit * 64 + mt * 32 + (i & 3) + 8 * (i >> 2) + 4 * h;
            BA[(size_t)row * 64 + nt * 32 + r] = v; } }
    __syncthreads();
}

__device__ __forceinline__ void dn_naive_phase(const bf16* QC, const bf16* KC, const bf16* VC, const float* BETA, const float* DEC, float* O, LAS unsigned char* lds, int unit, int tid) {
    constexpr int CT = 32, NCH = SEQ / CT;
    constexpr int BUF = 16384 + 16384 + 4096 + 256;
    const int bh = unit >> 2, vq = unit & 3, b = bh >> 5, hv = bh & 31, hk = hv >> 1;
    const int vl = tid >> 4, p = tid & 15;
    LAS float* ob = (LAS float*)(lds + 2 * BUF);
    const size_t row0 = (size_t)b * SEQ;
    const int lr = tid >> 4, lp = tid & 15;
    const bf16* qsrc = QC + (row0 + lr) * KDIM + hk * HD + lp * 8;
    const bf16* ksrc = KC + (row0 + lr) * KDIM + hk * HD + lp * 8;
    const int vr = (tid & 127) >> 2, vp = tid & 3;
    const bf16* vsrc = VC + (row0 + vr) * VDIM + hv * HD + vq * 32 + vp * 8;
    const float* gsrc = (tid < 32 ? BETA : DEC) + (row0 + (tid & 31)) * HV + hv;
    v4u rq, rk, rv = {0u, 0u, 0u, 0u}; float rg = 0.f;
    rq = *(const GAS v4u*)qsrc; rk = *(const GAS v4u*)ksrc; if (tid < 128) rv = *(const GAS v4u*)vsrc; if (tid < 64) rg = *gsrc;
    float S[8];
#pragma unroll
    for (int i = 0; i < 8; ++i) S[i] = 0.f;
    for (int c = 0; c < NCH; ++c) {
        LAS unsigned char* buf = lds + (c & 1) * BUF;
        { float f[8]; unpack8(rq, f); LAS f32x4* d = (LAS f32x4*)(buf + (lr * 128 + lp * 8) * 4); d[0] = (f32x4){f[0], f[1], f[2], f[3]}; d[1] = (f32x4){f[4], f[5], f[6], f[7]};
          unpack8(rk, f); d = (LAS f32x4*)(buf + 16384 + (lr * 128 + lp * 8) * 4); d[0] = (f32x4){f[0], f[1], f[2], f[3]}; d[1] = (f32x4){f[4], f[5], f[6], f[7]};
          if (tid < 128) { unpack8(rv, f); d = (LAS f32x4*)(buf + 32768 + (vr * 32 + vp * 8) * 4); d[0] = (f32x4){f[0], f[1], f[2], f[3]}; d[1] = (f32x4){f[4], f[5], f[6], f[7]}; }
          if (tid < 64) ((LAS float*)(buf + 36864))[tid] = rg; }
        __syncthreads();
        if (c + 1 < NCH) { const size_t adv = (size_t)(c + 1) * CT;
            rq = *(const GAS v4u*)(qsrc + adv * KDIM); rk = *(const GAS v4u*)(ksrc + adv * KDIM); if (tid < 128) rv = *(const GAS v4u*)(vsrc + adv * VDIM); if (tid < 64) rg = gsrc[adv * HV]; }
        const LAS float* qf = (const LAS float*)buf; const LAS float* kf = (const LAS float*)(buf + 16384); const LAS float* vf = (const LAS float*)(buf + 32768); const LAS float* gf = (const LAS float*)(buf + 36864);
#pragma unroll 4
        for (int tt = 0; tt < CT; ++tt) {
            const f32x4 k0 = *(const LAS f32x4*)(kf + tt * 128 + 8 * p), k1 = *(const LAS f32x4*)(kf + tt * 128 + 8 * p + 4);
            const f32x4 q0 = *(const LAS f32x4*)(qf + tt * 128 + 8 * p), q1 = *(const LAS f32x4*)(qf + tt * 128 + 8 * p + 4);
            const float vt = vf[tt * 32 + vl], bt = gf[tt], at = gf[32 + tt];
            float pred = (S[0] * k0.x + S[1] * k0.y) + (S[2] * k0.z + S[3] * k0.w) + (S[4] * k1.x + S[5] * k1.y) + (S[6] * k1.z + S[7] * k1.w);
            pred = rowsum16(pred);
            const float delta = bt * (vt - at * pred);
            S[0] = at * S[0] + k0.x * delta; S[1] = at * S[1] + k0.y * delta; S[2] = at * S[2] + k0.z * delta; S[3] = at * S[3] + k0.w * delta;
            S[4] = at * S[4] + k1.x * delta; S[5] = at * S[5] + k1.y * delta; S[6] = at * S[6] + k1.z * delta; S[7] = at * S[7] + k1.w * delta;
            float o = (S[0] * q0.x + S[1] * q0.y) + (S[2] * q0.z + S[3] * q0.w) + (S[4] * q1.x + S[5] * q1.y) + (S[6] * q1.z + S[7] * q1.w);
            o = rowsum16(o);
            if (p == 0) ob[tt * 32 + vl] = o;
        }
        __syncthreads();
        if (tid < 256) { const int orow = tid >> 3, oc = (tid & 7) * 4; const f32x4 v = *(const LAS f32x4*)(ob + orow * 32 + oc);
            *(GAS f32x4*)(O + (row0 + (size_t)c * CT + orow) * VDIM + hv * HD + vq * 32 + oc) = v; }
    }
    __syncthreads();
}

__device__ __forceinline__ void dn_gnorm_phase(const float* O, const bf16* Z, const float* nw, bf16* A3, int gw, int NGW, int lane) {
    constexpr int NCG = VDIM / 512, NITEMS = M * NCG;
    float wv[8];
    { const f32x4 a = *(const GAS f32x4*)(nw + (lane & 15) * 8), b = *(const GAS f32x4*)(nw + (lane & 15) * 8 + 4); wv[0] = a.x; wv[1] = a.y; wv[2] = a.z; wv[3] = a.w; wv[4] = b.x; wv[5] = b.y; wv[6] = b.z; wv[7] = b.w; }
    for (int it = gw; it < NITEMS; it += NGW) {
        const int cgp = it % NCG, row = it / NCG, c0 = cgp * 512 + lane * 8;
        const f32x4 a = *(const GAS f32x4*)(O + (size_t)row * VDIM + c0), b = *(const GAS f32x4*)(O + (size_t)row * VDIM + c0 + 4);
        float z[8]; unpack8(*(const GAS v4u*)(Z + (size_t)row * VDIM + c0), z);
        float o[8] = {a.x, a.y, a.z, a.w, b.x, b.y, b.z, b.w};
        float ss = 0.f;
#pragma unroll
        for (int e = 0; e < 8; ++e) ss += o[e] * o[e];
        ss = sum16(ss);
        const float rs = 1.f / sqrtf(ss * (1.f / HD) + RMS_EPS);
#pragma unroll
        for (int e = 0; e < 8; ++e) o[e] = o[e] * rs * wv[e] * silu_f(z[e]);
        *(GAS v4u*)(A3 + (size_t)row * VDIM + c0) = pack8(o);
    }
}

struct Args { const float* in[14]; float* out; unsigned char* ws; int ph_lo, ph_hi, li, pad; };
__device__ __forceinline__ unsigned long long ptab_get(LAS unsigned char* lds, int i) {
    volatile LAS unsigned* p = (volatile LAS unsigned*)(lds + PTAB_OFF) + 2 * i;
    const unsigned lo = __builtin_amdgcn_readfirstlane(p[0]), hi = __builtin_amdgcn_readfirstlane(p[1]);
    return ((unsigned long long)hi << 32) | lo;
}
#define PIN(i) ((const float*)ptab_get(lds, (i)))
#define POUT ((float*)ptab_get(lds, 14))
#define PWS ((unsigned char*)ptab_get(lds, 15))
#define LOCAL_IDS int tid = threadIdx.x; asm volatile("" : "+v"(tid)); const int lane = tid & 63, wave = __builtin_amdgcn_readfirstlane(tid >> 6); const int G = gridDim.x, bx = blockIdx.x; \
    const int vcu = (G % 8 == 0) ? (bx % 8) * (G / 8) + bx / 8 : bx; const int gw = vcu * NWAVES + wave, NGW = G * NWAVES, gt = vcu * (NWAVES * 64) + tid, NGT = G * NWAVES * 64; \
    unsigned char* const ws = PWS; (void)lane; (void)gw; (void)NGW; (void)gt; (void)NGT; (void)ws
__global__ void __launch_bounds__(NWAVES * 64, 2) fwd(Args args) {
    extern __shared__ __attribute__((aligned(16))) unsigned char lds_raw[];
    LAS unsigned char* lds = (LAS unsigned char*)lds_raw;
    volatile LAS unsigned* MISC = (volatile LAS unsigned*)(lds + MISC_OFF);
    for (int u = threadIdx.x; u < (LDS_BYTES - LDSCTL_OFF) / 4; u += NWAVES * 64) ((LAS unsigned*)(lds + LDSCTL_OFF))[u] = 0u;
    __syncthreads();
    if (threadIdx.x == 0) {
        LAS unsigned long long* pt = (LAS unsigned long long*)(lds + PTAB_OFF);
#pragma unroll
        for (int i = 0; i < 14; ++i) pt[i] = (unsigned long long)args.in[i];
        pt[14] = (unsigned long long)args.out; pt[15] = (unsigned long long)args.ws;
    }
    __syncthreads();
    if (threadIdx.x == 0) { LAS unsigned* pw = (LAS unsigned*)(lds + PTAB_OFF) + 32; pw[0] = (unsigned)args.ph_lo; pw[1] = (unsigned)args.ph_hi; }
    if (!MK_PER_PHASE) (void)xcd_barrier_post((unsigned*)(args.ws + WS_CTL) + CW_BAR, MISC + 8);
    __syncthreads();
#define PH_LO ((int)__builtin_amdgcn_readfirstlane(((volatile LAS unsigned*)(lds + PTAB_OFF))[32]))
#define PH_HI ((int)__builtin_amdgcn_readfirstlane(((volatile LAS unsigned*)(lds + PTAB_OFF))[33]))
#define IN(k) (PH_LO <= (k) && (k) < PH_HI)
#define SEAM(k) do { if (!MK_PER_PHASE) { if (IN(k) && IN((k) + 1)) { XcdBarrier bar_; bar_.bar = (unsigned*)(PWS + WS_CTL) + CW_BAR; bar_.x = xb_xcc_id(); bar_.st = MISC + 8; xcd_barrier(bar_); } } } while (0)

    if (IN(0)) { LOCAL_IDS; Ptrs P; P.x = PIN(0); P.sc_w_in = PIN(1); P.sc_w_out = PIN(3); P.dn_w_in = PIN(4); P.dn_w_out = PIN(9); P.ffn_gu = PIN(10); P.ffn_down = PIN(11); P.ws = ws;
        p0_prologue(P, lds, gw, NGW, wave, lane); }
    SEAM(0);

    for (int L = 0; L < DEPTH; ++L) {
        const int j = L >> 1;
        const int pb = 1 + 16 * j + ((L & 1) ? 7 : 0);
        int fb;
        if ((L & 1) == 0) {
            if (IN(pb + 0)) {
                LOCAL_IDS;
                pg8::Gemm g{(const bf16*)(ws + WS_XB), (const bf16*)(ws + WS_W_SCIN) + (size_t)j * 3 * DM * DM, M, 3 * DM, DM}; pg8::StaticOrder S; S.init(M, 3 * DM, G, bx);
                pg8::EpiGate<0> E{(bf16*)(ws + WS_GB), DM, (bf16*)(ws + WS_CU), DM, DM / 256};
                pg8::gemm_phase<pg8::EpiGate<0>, pg8::StaticOrder, PG8_ALIGN, PG8_SP2>(lds + RING_OFF, g, S, E);
            }
            SEAM(pb + 0);
            if (IN(pb + 1)) { LOCAL_IDS; sc_conv_phase((const bf16*)(ws + WS_GB), (const bf16*)(ws + WS_CU), PIN(2) + (size_t)j * 3 * DM, (bf16*)(ws + WS_A2), gt, NGT); }
            SEAM(pb + 1);
            if (IN(pb + 2)) {
                LOCAL_IDS;
                pg8::Gemm g{(const bf16*)(ws + WS_A2), (const bf16*)(ws + WS_W_SCOUT) + (size_t)j * DM * DM, M, DM, DM}; pg8::StaticOrder S; S.init(M, DM, G, bx);
                pg8::EpiStore2 E{(bf16*)(ws + WS_H1), DM, (bf16*)(ws + WS_H1), DM, 1 << 30};
                pg8::gemm_phase<pg8::EpiStore2, pg8::StaticOrder, PG8_ALIGN, PG8_SP2>(lds + RING_OFF, g, S, E);
            }
            SEAM(pb + 2);
            if (IN(pb + 3)) { LOCAL_IDS; ln_phase((L == 0) ? PIN(0) : (const float*)POUT, (const bf16*)(ws + WS_H1), PIN(12) + (size_t)(L * 2) * DM, PIN(13) + (size_t)(L * 2) * DM, POUT, (bf16*)(ws + WS_XB), gw, NGW, lane); }
            SEAM(pb + 3);
            fb = pb + 4;
        } else {
            if (IN(pb + 0)) {
                LOCAL_IDS;
                pg8::Gemm g{(const bf16*)(ws + WS_XB), (const bf16*)(ws + WS_W_DNIN) + (size_t)j * DNP_MAIN * DM, M, DNP_MAIN, DM}; pg8::StaticOrder S; S.init(M, DNP_MAIN, G, bx);
                pg8::EpiStore2 E{(bf16*)(ws + WS_QKV), QKV, (bf16*)(ws + WS_Z), VDIM, QKV};
                pg8::gemm_phase<pg8::EpiStore2, pg8::StaticOrder, PG8_ALIGN, PG8_SP2>(lds + RING_OFF, g, S, E);
            }
            if (IN(pb + 0)) {
                LOCAL_IDS;
                for (int u = bx; u < M / 64; u += G) ba_phase((const bf16*)(ws + WS_XB), (const bf16*)(ws + WS_W_BA) + (size_t)j * 64 * DM, (float*)(ws + WS_BA), lds, u, wave, lane);
            }
            SEAM(pb + 0);
            if (IN(pb + 1)) { LOCAL_IDS; dn_pre_phase((const bf16*)(ws + WS_QKV), PIN(5) + (size_t)j * 4 * QKV, (bf16*)(ws + WS_QC), (bf16*)(ws + WS_KC), (bf16*)(ws + WS_VC), (const float*)(ws + WS_BA), PIN(6) + j * HV, PIN(7) + j * HV,
                                                       (float*)(ws + WS_BETA), (float*)(ws + WS_DEC), gw, NGW, lane, gt, NGT); }
            SEAM(pb + 1);
            if (IN(pb + 2)) { LOCAL_IDS; for (int u = vcu; u < BATCH * HV * 4; u += G) dn_naive_phase((const bf16*)(ws + WS_QC), (const bf16*)(ws + WS_KC), (const bf16*)(ws + WS_VC), (const float*)(ws + WS_BETA), (const float*)(ws + WS_DEC), (float*)(ws + WS_O), lds, u, tid); }
            SEAM(pb + 2);
            if (IN(pb + 3)) { LOCAL_IDS; dn_gnorm_phase((const float*)(ws + WS_O), (const bf16*)(ws + WS_Z), PIN(8) + j * HD, (bf16*)(ws + WS_A3), gw, NGW, lane); }
            SEAM(pb + 3);
            if (IN(pb + 4)) {
                LOCAL_IDS;
                pg8::Gemm g{(const bf16*)(ws + WS_A3), (const bf16*)(ws + WS_W_DNOUT) + (size_t)j * DM * VDIM, M, DM, VDIM}; pg8::StaticOrder S; S.init(M, DM, G, bx);
                pg8::EpiStore2 E{(bf16*)(ws + WS_H1), DM, (bf16*)(ws + WS_H1), DM, 1 << 30};
                pg8::gemm_phase<pg8::EpiStore2, pg8::StaticOrder, PG8_ALIGN, PG8_SP2>(lds + RING_OFF, g, S, E);
            }
            SEAM(pb + 4);
            if (IN(pb + 5)) { LOCAL_IDS; ln_phase((const float*)POUT, (const bf16*)(ws + WS_H1), PIN(12) + (size_t)(L * 2) * DM, PIN(13) + (size_t)(L * 2) * DM, POUT, (bf16*)(ws + WS_XB), gw, NGW, lane); }
            SEAM(pb + 5);
            fb = pb + 6;
        }
        if (IN(fb + 0)) {
            LOCAL_IDS;
            pg8::Gemm g{(const bf16*)(ws + WS_XB), (const bf16*)(ws + WS_W_GU) + (size_t)L * 2 * FF * DM, M, 2 * FF, DM}; pg8::StaticOrder S; S.init(M, 2 * FF, G, bx);
            pg8::EpiGate<1> E{(bf16*)(ws + WS_HID), FF, (bf16*)(ws + WS_HID), FF, 0};
            pg8::gemm_phase<pg8::EpiGate<1>, pg8::StaticOrder, PG8_ALIGN, PG8_SP2>(lds + RING_OFF, g, S, E);
        }
        SEAM(fb + 0);
        if (IN(fb + 1)) {
            LOCAL_IDS;
            pg8::Gemm g{(const bf16*)(ws + WS_HID), (const bf16*)(ws + WS_W_DOWN) + (size_t)L * DM * FF, M, DM, FF}; pg8::StaticOrder S; S.init(M, DM, G, bx);
            pg8::EpiStore2 E{(bf16*)(ws + WS_H1), DM, (bf16*)(ws + WS_H1), DM, 1 << 30};
            pg8::gemm_phase<pg8::EpiStore2, pg8::StaticOrder, PG8_ALIGN, PG8_SP2>(lds + RING_OFF, g, S, E);
        }
        SEAM(fb + 1);
        if (IN(fb + 2)) { LOCAL_IDS; ln_phase((const float*)POUT, (const bf16*)(ws + WS_H1), PIN(12) + (size_t)(L * 2 + 1) * DM, PIN(13) + (size_t)(L * 2 + 1) * DM, POUT, (bf16*)(ws + WS_XB), gw, NGW, lane); }
        SEAM(fb + 2);
    }
#undef IN
#undef SEAM
}

extern "C" void kernel_launch(void* const* d_in, const int* in_sizes, int n_in, void* d_out, int out_size, void* d_ws, size_t ws_size, hipStream_t stream) {
    static int grid = 0;
    if (grid == 0) {
        if (n_in != 14 || in_sizes[0] != M * DM || out_size != M * DM || ws_size < WS_END) { fprintf(stderr, "kernel_launch: unexpected shapes (n_in %d, in0 %d, out %d, ws %zu < %zu); nothing launched\n", n_in, n_in > 0 ? in_sizes[0] : -1, out_size, ws_size, (size_t)WS_END); grid = -1; return; }
        int dev = 0, cus = 0, per_cu = 0;
        if (hipGetDevice(&dev) != hipSuccess || hipDeviceGetAttribute(&cus, hipDeviceAttributeMultiprocessorCount, dev) != hipSuccess) { grid = -1; return; }
        if (hipFuncSetAttribute((const void*)fwd, hipFuncAttributeMaxDynamicSharedMemorySize, LDS_BYTES) != hipSuccess) { fprintf(stderr, "kernel_launch: hipFuncSetAttribute failed\n"); grid = -1; return; }
        if (hipOccupancyMaxActiveBlocksPerMultiprocessor(&per_cu, (const void*)fwd, NWAVES * 64, LDS_BYTES) != hipSuccess || per_cu < 1) fprintf(stderr, "kernel_launch: occupancy query reports %d\n", per_cu);
        (void)hipGetLastError();
        grid = cus;
        if (grid > 256) grid = 256;
    }
    if (grid < 0) return;
    if (hipMemsetAsync((char*)d_ws + WS_CTL, 0, CTL_ZERO_BYTES, stream) != hipSuccess) return;
    Args a{};
    for (int i = 0; i < 14; ++i) a.in[i] = (const float*)d_in[i];
    a.out = (float*)d_out; a.ws = (unsigned char*)d_ws;
#if MK_PER_PHASE
    for (int p = 0; p < N_PHASES; ++p) { a.ph_lo = p; a.ph_hi = p + 1; a.li = p; hipLaunchKernelGGL(fwd, dim3(grid), dim3(NWAVES * 64), LDS_BYTES, stream, a); }
#else
    a.ph_lo = 0; a.ph_hi = N_PHASES; a.li = 0;
    hipLaunchKernelGGL(fwd, dim3(grid), dim3(NWAVES * 64), LDS_BYTES, stream, a);
#endif
}
```

```cpp
#include <hip/hip_runtime.h>
#include <cstdio>
#include <cstdint>
namespace pg8 {
#define PG8_LAS __attribute__((address_space(3)))
typedef unsigned short bf16_t;
typedef short bf16x8 __attribute__((ext_vector_type(8)));
typedef float f32x4 __attribute__((ext_vector_type(4)));
typedef unsigned u32x4 __attribute__((ext_vector_type(4)));
constexpr int BM = 256, BK = 64, HALF = 128, HTB = HALF * BK * 2  , STAGE_BYTES = 8 * HTB, NXCD = 8, WGM = 8;

__host__ __device__ __forceinline__ int lds_byte(int r, int c) { const int st = (r >> 4) * 2 + (c >> 5), rr = r & 15, cc = c & 31, ob = rr * 64 + cc * 2; return st * 1024 + (ob ^ (((ob >> 9) & 1) << 5)); }
__host__ __device__ __forceinline__ void stage_rc(int b, int& R, int& C) { const int st = b / 1024, sb = b % 1024, swz = sb ^ (((sb >> 9) & 1) << 5); R = (st >> 1) * 16 + swz / 64; C = (st & 1) * 32 + (swz % 64) / 2; }
__host__ __device__ __forceinline__ int perm32(int rho) { const int n = rho >> 4, i = rho & 15; return 8 * (i >> 2) + 4 * n + (i & 3); }

struct Unit { int pm, pn; };
struct Gemm { const bf16_t* A; const bf16_t* Bt; int M, N, K; };

struct StaticOrder {
    int nM, nN, nwg, G, c;
    __host__ __device__ void init(int M, int N, int G_, int c_) { nM = M / BM; nN = N / BM; nwg = nM * nN; G = G_; c = c_; }
    __host__ __device__ bool next(int i, Unit& u) const {
        const long L = (long)i * G + c; if (L >= nwg) return false;
        int wgid = (int)L; { const int q = nwg / NXCD, r = nwg % NXCD, xcd = wgid % NXCD, off = wgid / NXCD; wgid = (xcd < r ? xcd * (q + 1) : r * (q + 1) + (xcd - r) * q) + off; }
        const int nig = WGM * nN, gid = wgid / nig, fm = gid * WGM, gsz = (nM - fm) < WGM ? (nM - fm) : WGM;
        u.pm = fm + ((wgid % nig) % gsz); u.pn = (wgid % nig) / gsz; return true;
    }
    __device__ __forceinline__ void a_ready(const Unit&) const {}
    __device__ __forceinline__ void done(const Unit&) const {}
};


typedef float f32x2_t __attribute__((ext_vector_type(2)));
typedef __bf16 bf16x2_t __attribute__((ext_vector_type(2)));
__device__ __forceinline__ unsigned cvt_pk_bf16(float lo, float hi) { f32x2_t v = {lo, hi}; bf16x2_t b = __builtin_convertvector(v, bf16x2_t); return __builtin_bit_cast(unsigned, b); }
__device__ __forceinline__ float silu_f(float v) { return v * __builtin_amdgcn_rcpf(1.0f + __expf(-v)); }

struct EpiStore2 {
    static constexpr bool PERM = true, AFTER_DRAIN = false;
    bf16_t* O0; int ld0; bf16_t* O1; int ld1; int split;
    __device__ __forceinline__ void operator()(const f32x4 (&acc)[2][2][4][2], const Unit& u, int wr, int wc, int fr, int fq) const {
        int colt = u.pn * BM; bf16_t* base = O0; int ld = ld0;
        if (colt >= split) { base = O1; ld = ld1; colt -= split; }
        const int row0 = u.pm * BM + wr * 64 + fr, col0 = colt + wc * 32 + 8 * fq;
#pragma unroll
        for (int ai = 0; ai < 2; ++ai)
#pragma unroll
            for (int m = 0; m < 4; ++m) { bf16_t* rowp = base + (size_t)(row0 + ai * HALF + m * 16) * ld + col0;
#pragma unroll
                for (int bj = 0; bj < 2; ++bj) { const f32x4 v0 = acc[ai][bj][m][0], v1 = acc[ai][bj][m][1];
                    u32x4 w; w.x = cvt_pk_bf16(v0[0], v0[1]); w.y = cvt_pk_bf16(v0[2], v0[3]); w.z = cvt_pk_bf16(v1[0], v1[1]); w.w = cvt_pk_bf16(v1[2], v1[3]);
                    *(u32x4*)(rowp + bj * HALF) = w; } }
    }
};
template <int ACT> struct EpiGate {
    static constexpr bool PERM = true, AFTER_DRAIN = false;
    bf16_t* P; int ldp; bf16_t* G; int ldg; int pn_plain;
    __device__ __forceinline__ void operator()(const f32x4 (&acc)[2][2][4][2], const Unit& u, int wr, int wc, int fr, int fq) const {
        const int row0 = u.pm * BM + wr * 64 + fr;
        if (u.pn < pn_plain) {
            const int col0 = u.pn * BM + wc * 32 + 8 * fq;
#pragma unroll
            for (int ai = 0; ai < 2; ++ai)
#pragma unroll
                for (int m = 0; m < 4; ++m) { bf16_t* rowp = P + (size_t)(row0 + ai * HALF + m * 16) * ldp + col0;
#pragma unroll
                    for (int bj = 0; bj < 2; ++bj) { const f32x4 v0 = acc[ai][bj][m][0], v1 = acc[ai][bj][m][1];
                        u32x4 w; w.x = cvt_pk_bf16(v0[0], v0[1]); w.y = cvt_pk_bf16(v0[2], v0[3]); w.z = cvt_pk_bf16(v1[0], v1[1]); w.w = cvt_pk_bf16(v1[2], v1[3]);
                        *(u32x4*)(rowp + bj * HALF) = w; } }
        } else {
            const int col0 = (u.pn - pn_plain) * HALF + wc * 32 + 8 * fq;
#pragma unroll
            for (int ai = 0; ai < 2; ++ai)
#pragma unroll
                for (int m = 0; m < 4; ++m) { bf16_t* rowp = G + (size_t)(row0 + ai * HALF + m * 16) * ldg + col0;
                    f32x4 a0 = acc[ai][0][m][0], a1 = acc[ai][0][m][1]; const f32x4 b0 = acc[ai][1][m][0], b1 = acc[ai][1][m][1];
                    if (ACT == 1) {
#pragma unroll
                        for (int e = 0; e < 4; ++e) { a0[e] = silu_f(a0[e]); a1[e] = silu_f(a1[e]); } }
                    a0 = a0 * b0; a1 = a1 * b1;
                    u32x4 w; w.x = cvt_pk_bf16(a0[0], a0[1]); w.y = cvt_pk_bf16(a0[2], a0[3]); w.z = cvt_pk_bf16(a1[0], a1[1]); w.w = cvt_pk_bf16(a1[2], a1[3]);
                    *(u32x4*)rowp = w; }
        }
    }
};

template <class Epi, class Sched, bool ALIGN_EPI = false, bool SP2 = false>
__device__ __forceinline__ void gemm_phase(PG8_LAS unsigned char* lds, const Gemm g, const Sched& S, const Epi& E) {
    int tid_o = threadIdx.x; asm volatile("" : "+v"(tid_o));
    const int tid = tid_o, wid = __builtin_amdgcn_readfirstlane(tid >> 6), lane = tid & 63, wr = wid >> 2, wc = wid & 3, fr = lane & 15, fq = lane >> 4;
    const int K = g.K, nt = K / BK;
    unsigned voffA[2], voffB[2];
#pragma unroll
    for (int i = 0; i < 2; ++i) { int R, C; stage_rc(tid * 16 + i * 8192, R, C); const int Rb = Epi::PERM ? ((R & ~31) + perm32(R & 31)) : R;
        voffA[i] = (unsigned)(R * K + C) * 2u; voffB[i] = (unsigned)(Rb * K + C) * 2u; }
    const size_t kstep = (size_t)(BK * 2);
    const size_t hstep = (size_t)HALF * K * 2;
    const size_t tstep = 2 * hstep;
    const unsigned ldsw = (unsigned)wid * 1024u;
    const int aoff = lds_byte(wr * 64 + fr, fq * 8), boff = lds_byte(wc * 32 + fr, fq * 8);
#define PG8_SA(b, h) (((b) * 2 + (h)) * HTB)
#define PG8_SB(b, h) ((4 + (b) * 2 + (h)) * HTB)
#define PG8_STAGE(bufoff, gbase, voff) do { _Pragma("unroll") for (int _i = 0; _i < 2; ++_i) \
        __builtin_amdgcn_global_load_lds((const unsigned*)((const char*)(gbase) + (voff)[_i]), (PG8_LAS unsigned*)(lds + (bufoff) + ldsw + _i * 8192), 16, 0, 0); } while (0)
#define PG8_LDA(dst, b, h) do { _Pragma("unroll") for (int m = 0; m < 4; ++m) _Pragma("unroll") for (int k = 0; k < 2; ++k) dst[m][k] = *(const PG8_LAS bf16x8*)(lds + PG8_SA(b, h) + aoff + m * 2048 + k * 1024); } while (0)
#define PG8_LDB(dst, b, h) do { _Pragma("unroll") for (int n = 0; n < 2; ++n) _Pragma("unroll") for (int k = 0; k < 2; ++k) dst[n][k] = *(const PG8_LAS bf16x8*)(lds + PG8_SB(b, h) + boff + n * 2048 + k * 1024); } while (0)
#define PG8_MMA(ai, bj, At, Bt) do { __builtin_amdgcn_s_setprio(1); _Pragma("unroll") for (int m = 0; m < 4; ++m) _Pragma("unroll") for (int n = 0; n < 2; ++n) _Pragma("unroll") for (int k = 0; k < 2; ++k) \
        acc[ai][bj][m][n] = __builtin_amdgcn_mfma_f32_16x16x32_bf16(Bt[n][k], At[m][k], acc[ai][bj][m][n], 0, 0, 0); __builtin_amdgcn_s_setprio(0); } while (0)
#define PG8_WAIT_V(n) asm volatile("s_waitcnt vmcnt(" #n ")" ::: "memory")
#define PG8_WAIT_L(n) asm volatile("s_waitcnt lgkmcnt(" #n ")" ::: "memory")
#define PG8_BAR __builtin_amdgcn_s_barrier()
#define PG8_SCHED __builtin_amdgcn_sched_barrier(0)
    Unit cur, nxt; int ui = 0;
    if (!S.next(0, cur)) return;
    f32x4 acc[2][2][4][2];
#pragma unroll
    for (int a = 0; a < 2; ++a)
#pragma unroll
        for (int b = 0; b < 2; ++b)
#pragma unroll
            for (int m = 0; m < 4; ++m)
#pragma unroll
                for (int n = 0; n < 2; ++n) acc[a][b][m][n] = (f32x4){0.f, 0.f, 0.f, 0.f};
    bf16x8 At[4][2], B0[2][2], B1[2][2];
    const char* cA = (const char*)g.A + (size_t)cur.pm * tstep; const char* cB = (const char*)g.Bt + (size_t)cur.pn * tstep;
    S.a_ready(cur);
    if constexpr (SP2) {
        PG8_STAGE(PG8_SB(0, 0), cB, voffB); PG8_STAGE(PG8_SB(0, 1), cB + hstep, voffB); PG8_STAGE(PG8_SA(0, 0), cA, voffA); PG8_STAGE(PG8_SA(0, 1), cA + hstep, voffA);
        if (wr == 1) PG8_BAR;
        PG8_WAIT_V(2); PG8_BAR;
        PG8_STAGE(PG8_SB(1, 0), cB + kstep, voffB); PG8_STAGE(PG8_SA(1, 0), cA + kstep, voffA); PG8_STAGE(PG8_SB(1, 1), cB + hstep + kstep, voffB);
        PG8_WAIT_V(6); PG8_BAR;
    } else {
        PG8_STAGE(PG8_SB(0, 0), cB, voffB); PG8_STAGE(PG8_SA(0, 0), cA, voffA); PG8_STAGE(PG8_SB(0, 1), cB + hstep, voffB); PG8_STAGE(PG8_SA(0, 1), cA + hstep, voffA);
        if (wr == 1) PG8_BAR;
        PG8_WAIT_V(4); PG8_BAR;
        PG8_STAGE(PG8_SB(1, 0), cB + kstep, voffB); PG8_STAGE(PG8_SA(1, 0), cA + kstep, voffA); PG8_STAGE(PG8_SB(1, 1), cB + hstep + kstep, voffB);
        PG8_WAIT_V(6); PG8_BAR;
    }
    for (;;) {
        const bool has_next = S.next(ui + 1, nxt);
        const char* nA = has_next ? (const char*)g.A + (size_t)nxt.pm * tstep : cA; const char* nB = has_next ? (const char*)g.Bt + (size_t)nxt.pn * tstep : cB;
        for (int t = 0; t < nt; t += 2) {
            const bool last = (t == nt - 2);
            const char* a1 = cA + (size_t)(t + 1) * kstep;
            const char* a2 = last ? nA : cA + (size_t)(t + 2) * kstep; const char* b2 = last ? nB : cB + (size_t)(t + 2) * kstep;
            const char* a3 = a2 + kstep; const char* b3 = b2 + kstep;
            if (last && has_next) S.a_ready(nxt);
            if constexpr (SP2) {
            PG8_LDB(B0, 0, 0); PG8_LDB(B1, 0, 1); PG8_SCHED; PG8_LDA(At, 0, 0); PG8_STAGE(PG8_SA(1, 1), a1 + hstep, voffA);
            PG8_WAIT_V(8); PG8_WAIT_L(0); PG8_BAR; PG8_MMA(0, 0, At, B0); PG8_MMA(0, 1, At, B1); PG8_BAR; PG8_SCHED;
            PG8_LDA(At, 0, 1); PG8_STAGE(PG8_SB(0, 0), b2, voffB); PG8_STAGE(PG8_SB(0, 1), b2 + hstep, voffB); PG8_STAGE(PG8_SA(0, 0), a2, voffA);
            PG8_WAIT_V(8); PG8_WAIT_L(0); PG8_BAR; PG8_MMA(1, 0, At, B0); PG8_MMA(1, 1, At, B1); PG8_BAR; PG8_SCHED;
            PG8_LDB(B0, 1, 0); PG8_LDB(B1, 1, 1); PG8_SCHED; PG8_LDA(At, 1, 0); PG8_STAGE(PG8_SA(0, 1), a2 + hstep, voffA);
            PG8_WAIT_V(8); PG8_WAIT_L(0); PG8_BAR; PG8_MMA(0, 0, At, B0); PG8_MMA(0, 1, At, B1); PG8_BAR; PG8_SCHED;
            PG8_LDA(At, 1, 1); PG8_STAGE(PG8_SB(1, 0), b3, voffB); PG8_STAGE(PG8_SB(1, 1), b3 + hstep, voffB); PG8_STAGE(PG8_SA(1, 0), a3, voffA);
            PG8_WAIT_V(8); PG8_WAIT_L(0); PG8_BAR; PG8_MMA(1, 0, At, B0); PG8_MMA(1, 1, At, B1); PG8_BAR; PG8_SCHED;
            } else {
            PG8_LDB(B0, 0, 0); PG8_SCHED; PG8_LDA(At, 0, 0); PG8_STAGE(PG8_SA(1, 1), a1 + hstep, voffA);
            PG8_WAIT_L(8); PG8_BAR; PG8_WAIT_L(0); PG8_MMA(0, 0, At, B0); PG8_BAR; PG8_SCHED;
            PG8_LDB(B1, 0, 1); PG8_STAGE(PG8_SB(0, 0), b2, voffB);
            PG8_BAR; PG8_WAIT_L(0); PG8_MMA(0, 1, At, B1); PG8_BAR;
            PG8_LDA(At, 0, 1); PG8_STAGE(PG8_SA(0, 0), a2, voffA);
            PG8_BAR; PG8_WAIT_L(0); PG8_MMA(1, 0, At, B0); PG8_BAR; PG8_SCHED;
            PG8_STAGE(PG8_SB(0, 1), b2 + hstep, voffB);
            PG8_WAIT_V(6); PG8_BAR; PG8_MMA(1, 1, At, B1); PG8_BAR;
            PG8_LDB(B0, 1, 0); PG8_SCHED; PG8_LDA(At, 1, 0); PG8_STAGE(PG8_SA(0, 1), a2 + hstep, voffA);
            PG8_WAIT_L(8); PG8_BAR; PG8_WAIT_L(0); PG8_MMA(0, 0, At, B0); PG8_BAR; PG8_SCHED;
            PG8_LDB(B1, 1, 1); PG8_STAGE(PG8_SB(1, 0), b3, voffB);
            PG8_BAR; PG8_WAIT_L(0); PG8_MMA(0, 1, At, B1); PG8_BAR;
            PG8_LDA(At, 1, 1); PG8_STAGE(PG8_SA(1, 0), a3, voffA);
            PG8_BAR; PG8_WAIT_L(0); PG8_MMA(1, 0, At, B0); PG8_BAR; PG8_SCHED;
            PG8_STAGE(PG8_SB(1, 1), b3 + hstep, voffB);
            PG8_WAIT_V(6); PG8_BAR; PG8_MMA(1, 1, At, B1); PG8_BAR;
            }
        }
        if constexpr (ALIGN_EPI) { if (wr == 0) PG8_BAR; }
        if constexpr (!Epi::AFTER_DRAIN) { E(acc, cur, wr, wc, fr, fq); S.done(cur); }
        if (!has_next) break;
#pragma unroll
        for (int a = 0; a < 2; ++a)
#pragma unroll
            for (int b = 0; b < 2; ++b)
#pragma unroll
                for (int m = 0; m < 4; ++m)
#pragma unroll
                    for (int n = 0; n < 2; ++n) acc[a][b][m][n] = (f32x4){0.f, 0.f, 0.f, 0.f};
        cur = nxt; cA = nA; cB = nB; ++ui;
        if constexpr (ALIGN_EPI) { if (wr == 1) PG8_BAR; }
    }
    PG8_WAIT_V(0);
    if constexpr (!ALIGN_EPI) { if (wr == 0) PG8_BAR; }
    PG8_BAR;
    if constexpr (Epi::AFTER_DRAIN) { E.fused(acc, cur, wr, wc, fr, fq, lds, wid, lane); S.done(cur); }
#undef PG8_SA
#undef PG8_SB
#undef PG8_STAGE
#undef PG8_LDA
#undef PG8_LDB
#undef PG8_MMA
#undef PG8_WAIT_V
#undef PG8_WAIT_L
#undef PG8_BAR
#undef PG8_SCHED
}
}

#ifndef PG8_SP2
#define PG8_SP2 true
#endif
#ifndef PG8_ALIGN
#define PG8_ALIGN true
#endif
#ifndef MK_PER_PHASE
#define MK_PER_PHASE 0
#endif

constexpr int NWAVES = 8;
constexpr int DM = 2048, BATCH = 2, SEQ = 8192, M = BATCH * SEQ, DEPTH = 4;
constexpr int HD = 128, HK = 16, HV = 32, KDIM = 2048, VDIM = 4096, QKV = 8192;
constexpr int DNP = 12352, DNP_MAIN = 12288;
constexpr int FF = 5632;
constexpr float LN_EPS = 1e-5f, RMS_EPS = 1e-6f;
constexpr float ALPHA = 1.6817928305074290f;
#ifndef DN_CHUNKED
#define DN_CHUNKED 1
#endif
constexpr int N_PHASES = 35;

constexpr size_t MiB = 1u << 20;
constexpr size_t WS_CTL = 0, CTL_ZERO_BYTES = 1 * MiB;
constexpr size_t WS_W_SCIN = 1 * MiB;
constexpr size_t WS_W_SCOUT = WS_W_SCIN + 48 * MiB;
constexpr size_t WS_W_DNIN = WS_W_SCOUT + 16 * MiB;
constexpr size_t WS_W_BA = WS_W_DNIN + 96 * MiB;
constexpr size_t WS_W_DNOUT = WS_W_BA + 1 * MiB;
constexpr size_t WS_W_GU = WS_W_DNOUT + 32 * MiB;
constexpr size_t WS_W_DOWN = WS_W_GU + 176 * MiB;
constexpr size_t WS_XB = WS_W_DOWN + 88 * MiB;
constexpr size_t WS_BIGA = WS_XB + 64 * MiB;
constexpr size_t WS_QKV = WS_BIGA, WS_Z = WS_BIGA + 256 * MiB, WS_O = WS_BIGA;
constexpr size_t WS_GB = WS_BIGA, WS_CU = WS_BIGA + 64 * MiB, WS_A2 = WS_BIGA + 128 * MiB, WS_HID = WS_BIGA;
constexpr size_t WS_BIGB = WS_BIGA + 384 * MiB;
constexpr size_t WS_QC = WS_BIGB, WS_KC = WS_BIGB + 64 * MiB, WS_VC = WS_BIGB + 128 * MiB, WS_A3 = WS_BIGB + 256 * MiB, WS_H1 = WS_BIGB;
constexpr size_t WS_BA = WS_BIGB + 384 * MiB;
constexpr size_t WS_BETA = WS_BA + 4 * MiB, WS_DEC = WS_BETA + 2 * MiB;
constexpr size_t WS_GL = WS_DEC + 2 * MiB;
constexpr size_t WS_KF = WS_GL + 2 * MiB;
constexpr size_t WS_SC = WS_KF + 64 * MiB;
constexpr size_t WS_END = WS_SC + 8 * MiB;
constexpr size_t WS_WF = WS_BIGA, WS_UF = WS_BIGA + 128 * MiB, WS_QF = WS_BIGB + 256 * MiB, WS_AQKF = WS_BIGB + 320 * MiB;
constexpr size_t WS_O2 = WS_BIGB;
static_assert(WS_END <= (size_t)1476395008ull, "d_ws map exceeds the guaranteed workspace");
constexpr int CW_BAR = 4096;

constexpr int RING_OFF = 0, RING_BYTES = 131072;
constexpr int LDSCTL_OFF = RING_BYTES, MISC_OFF = LDSCTL_OFF + 320, PTAB_OFF = LDSCTL_OFF + 1024;
constexpr int LDS_BYTES = 147456;

#define GAS __attribute__((address_space(1)))
#define LAS __attribute__((address_space(3)))
typedef unsigned short bf16;
typedef unsigned v4u __attribute__((ext_vector_type(4)));
typedef unsigned v2u __attribute__((ext_vector_type(2)));
typedef float f32x4 __attribute__((ext_vector_type(4)));
typedef float f32x16 __attribute__((ext_vector_type(16)));
typedef short bf16x8 __attribute__((ext_vector_type(8)));
typedef GAS unsigned gu32;
#define RLX_AGENT __ATOMIC_RELAXED, __HIP_MEMORY_SCOPE_AGENT
#define LDS_WAIT() asm volatile("s_waitcnt lgkmcnt(0)" ::: "memory")
#define VM_WAIT() asm volatile("s_waitcnt vmcnt(0)" ::: "memory")
__device__ __forceinline__ unsigned pk2(float lo, float hi) { return pg8::cvt_pk_bf16(lo, hi); }
__device__ __forceinline__ float bf_lo(unsigned w) { return __uint_as_float(w << 16); }
__device__ __forceinline__ float bf_hi(unsigned w) { return __uint_as_float(w & 0xffff0000u); }
__device__ __forceinline__ float silu_f(float v) { return v * __builtin_amdgcn_rcpf(1.0f + __expf(-v)); }
#define XB_TMO      128
#define XB_XCNT(j)  (256  + 64 * (j))
#define XB_XSUB(j)  (1280 + 64 * (j))
#define XB_XGEN(j)  (2304 + 64 * (j))
#define XB_TOP      3328
#define XB_TOPGEN   3392
#define XCD_BAR_WORDS 3456
#define XB_SPIN_CAP (1u << 21)

__device__ __forceinline__ unsigned xb_ld(unsigned* p)              { return __hip_atomic_load(p, __ATOMIC_RELAXED, __HIP_MEMORY_SCOPE_AGENT); }
__device__ __forceinline__ unsigned xb_add(unsigned* p, unsigned v) { return __hip_atomic_fetch_add(p, v, __ATOMIC_RELAXED, __HIP_MEMORY_SCOPE_AGENT); }
__device__ __forceinline__ unsigned xb_xcc_id() { return (unsigned)__builtin_amdgcn_s_getreg((3 << 11) | 20) & 0xFu; }
#define XB_SPIN(cond, bar) do { unsigned _sp = 0; while (cond) { __builtin_amdgcn_s_sleep(1); \
    if ((++_sp & 255u) == 0u) { if (xb_ld(&(bar)[XB_TMO])) break; if (_sp > XB_SPIN_CAP) { atomicAdd(&(bar)[XB_TMO], 1u); break; } } } } while (0)

struct XcdBarrier {
    unsigned* bar; unsigned x;
    volatile LAS unsigned* st;
};

__device__ __forceinline__ XcdBarrier xcd_barrier_post(unsigned* bar, volatile LAS unsigned* st) {
    XcdBarrier b; b.bar = bar; b.x = xb_xcc_id(); b.st = st;
    if (threadIdx.x == 0) (void)xb_add(&bar[XB_XCNT(b.x)], 1u);
    return b;
}
__device__ __forceinline__ void xcd_barrier_complete(unsigned* bar, unsigned x, unsigned& nloc, unsigned& nx) {
    const unsigned G = gridDim.x * gridDim.y * gridDim.z;
    unsigned sum, cnt, mine, sp = 0u;
    for (;;) {
        sum = 0u; cnt = 0u; mine = 0u;
#pragma unroll
        for (unsigned j = 0; j < 16; ++j) { const unsigned c = xb_ld(&bar[XB_XCNT(j)]); sum += c; cnt += (c > 0u) ? 1u : 0u; mine = (j == x) ? c : mine; }
        if (sum == G) break;
        __builtin_amdgcn_s_sleep(1);
        if ((++sp & 255u) == 0u) { if (xb_ld(&bar[XB_TMO])) break; if (sp > XB_SPIN_CAP) { atomicAdd(&bar[XB_TMO], 1u); break; } }
    }
    nloc = mine > 0u ? mine : 1u; nx = cnt > 0u ? cnt : 1u;
}

__device__ __forceinline__ void xcd_barrier(const XcdBarrier& b) {
    asm volatile("s_waitcnt vmcnt(0)" ::: "memory");
    __syncthreads();
    if (threadIdx.x == 0) {
        unsigned* bar = b.bar;
        __builtin_amdgcn_s_waitcnt(0);
        unsigned nloc = b.st[0], nx = b.st[1];
        if (nloc == 0u) { xcd_barrier_complete(bar, b.x, nloc, nx); b.st[0] = nloc; b.st[1] = nx; }
        const unsigned old = xb_add(&bar[XB_XSUB(b.x)], 1u);
        const unsigned gen = old / nloc;
        if (old + 1u == (gen + 1u) * nloc) {
            __builtin_amdgcn_fence(__ATOMIC_RELEASE, "agent");
            asm volatile("s_waitcnt vmcnt(0)" ::: "memory");
            const unsigned og = xb_add(&bar[XB_TOP], 1u);
            const unsigned tg = og / nx;
            if (og + 1u == (tg + 1u) * nx) xb_add(&bar[XB_TOPGEN], 1u);
            else XB_SPIN(xb_ld(&bar[XB_TOPGEN]) == tg, bar);
            __builtin_amdgcn_fence(__ATOMIC_ACQUIRE, "agent");
            xb_add(&bar[XB_XGEN(b.x)], 1u);
            asm volatile("s_waitcnt vmcnt(0)" ::: "memory");
        } else {
            XB_SPIN(xb_ld(&bar[XB_XGEN(b.x)]) == gen, bar);
            __builtin_amdgcn_fence(__ATOMIC_ACQUIRE, "agent");
            asm volatile("s_waitcnt vmcnt(0)" ::: "memory");
        }
    }
    __syncthreads();
}

__device__ __forceinline__ float wave_sum(float v) {
#pragma unroll
    for (int o = 1; o < 64; o <<= 1) v += __shfl_xor(v, o);
    return v;
}
__device__ __forceinline__ float sum16(float v) {
    v += __shfl_xor(v, 1); v += __shfl_xor(v, 2); v += __shfl_xor(v, 4); v += __shfl_xor(v, 8);
    return v;
}
template <int CTRL> __device__ __forceinline__ float dppf(float v) { return __builtin_bit_cast(float, __builtin_amdgcn_update_dpp(0, __builtin_bit_cast(int, v), CTRL, 0xF, 0xF, false)); }
__device__ __forceinline__ float rowsum16(float v) {
    v += dppf<0x128>(v); v += dppf<0x124>(v); v += dppf<0x122>(v); v += dppf<0x121>(v);
    return v;
}
__device__ __forceinline__ void unpack8(const v4u w, float (&f)[8]) {
    f[0] = bf_lo(w.x); f[1] = bf_hi(w.x); f[2] = bf_lo(w.y); f[3] = bf_hi(w.y); f[4] = bf_lo(w.z); f[5] = bf_hi(w.z); f[6] = bf_lo(w.w); f[7] = bf_hi(w.w);
}
__device__ __forceinline__ v4u pack8(const float (&f)[8]) { v4u o; o.x = pk2(f[0], f[1]); o.y = pk2(f[2], f[3]); o.z = pk2(f[4], f[5]); o.w = pk2(f[6], f[7]); return o; }

__device__ __forceinline__ void p0_transpose_item(const float* W, int ldw, int src_col0, bf16* WT, int K, int dst_row0, int k0, LAS float* scr, int lane) {
#pragma unroll 8
    for (int i = 0; i < 32; ++i) { const int kk = 2 * i + (lane >> 5); scr[kk * 33 + (lane & 31)] = W[(size_t)(k0 + kk) * ldw + src_col0 + (lane & 31)]; }
    LDS_WAIT(); asm volatile("" ::: "memory");
    const int c = lane & 7;
#pragma unroll
    for (int j = 0; j < 4; ++j) { const int n = (lane >> 3) + 8 * j; const LAS float* s = scr + (8 * c) * 33 + n;
        v4u o; o.x = pk2(s[0 * 33], s[1 * 33]); o.y = pk2(s[2 * 33], s[3 * 33]); o.z = pk2(s[4 * 33], s[5 * 33]); o.w = pk2(s[6 * 33], s[7 * 33]);
        *(GAS v4u*)(WT + (size_t)(dst_row0 + n) * K + k0 + 8 * c) = o; }
    LDS_WAIT(); asm volatile("" ::: "memory");
}

struct Ptrs {
    const float *x, *sc_w_in, *sc_conv_w, *sc_w_out, *dn_w_in, *dn_conv_w, *dn_a_log, *dn_dt_bias, *dn_norm_w, *dn_w_out, *ffn_gu, *ffn_down, *ln_gain, *ln_bias;
    float* out; unsigned char* ws;
};

__device__ __forceinline__ void p0_prologue(const Ptrs& P, LAS unsigned char* lds, int gw, int NGW, int wave, int lane) {
    LAS float* scr = (LAS float*)(lds + RING_OFF + wave * 16384);
    constexpr int I_SCIN = 32 * 192, I_SCOUT = 32 * 64, I_DNIN = 32 * 384, I_BA = 32 * 2, I_DNOUT = 64 * 64, I_GU = 32 * 352, I_DOWN = 88 * 64;
    constexpr int NITEMS = 2 * (I_SCIN + I_SCOUT + I_DNIN + I_BA + I_DNOUT) + 4 * (I_GU + I_DOWN);
    for (int it = gw; it < NITEMS; it += NGW) {
        int r = it; const float* W; int ldw, K, nblk, mode; bf16* WT; int layer;
        if (r < 2 * I_SCIN) { layer = r / I_SCIN; r -= layer * I_SCIN; W = P.sc_w_in + (size_t)layer * DM * 3 * DM; ldw = 3 * DM; K = DM; nblk = 192; mode = 1; WT = (bf16*)(P.ws + WS_W_SCIN) + (size_t)layer * 3 * DM * DM; }
        else { r -= 2 * I_SCIN;
        if (r < 2 * I_SCOUT) { layer = r / I_SCOUT; r -= layer * I_SCOUT; W = P.sc_w_out + (size_t)layer * DM * DM; ldw = DM; K = DM; nblk = 64; mode = 0; WT = (bf16*)(P.ws + WS_W_SCOUT) + (size_t)layer * DM * DM; }
        else { r -= 2 * I_SCOUT;
        if (r < 2 * I_DNIN) { layer = r / I_DNIN; r -= layer * I_DNIN; W = P.dn_w_in + (size_t)layer * DM * DNP; ldw = DNP; K = DM; nblk = 384; mode = 0; WT = (bf16*)(P.ws + WS_W_DNIN) + (size_t)layer * DNP_MAIN * DM; }
        else { r -= 2 * I_DNIN;
        if (r < 2 * I_BA) { layer = r / I_BA; r -= layer * I_BA; W = P.dn_w_in + (size_t)layer * DM * DNP; ldw = DNP; K = DM; nblk = 2; mode = 3; WT = (bf16*)(P.ws + WS_W_BA) + (size_t)layer * 64 * DM; }
        else { r -= 2 * I_BA;
        if (r < 2 * I_DNOUT) { layer = r / I_DNOUT; r -= layer * I_DNOUT; W = P.dn_w_out + (size_t)layer * VDIM * DM; ldw = DM; K = VDIM; nblk = 64; mode = 0; WT = (bf16*)(P.ws + WS_W_DNOUT) + (size_t)layer * DM * VDIM; }
        else { r -= 2 * I_DNOUT;
        if (r < 4 * I_GU) { layer = r / I_GU; r -= layer * I_GU; W = P.ffn_gu + (size_t)layer * DM * 2 * FF; ldw = 2 * FF; K = DM; nblk = 352; mode = 2; WT = (bf16*)(P.ws + WS_W_GU) + (size_t)layer * 2 * FF * DM; }
        else { r -= 4 * I_GU; layer = r / I_DOWN; r -= layer * I_DOWN; W = P.ffn_down + (size_t)layer * FF * DM; ldw = DM; K = FF; nblk = 64; mode = 0; WT = (bf16*)(P.ws + WS_W_DOWN) + (size_t)layer * DM * FF; } } } } } }
        const int kb = r / nblk, nb = r % nblk, n0 = 32 * nb;
        int src;
        if (mode == 0) src = n0;
        else if (mode == 1) { if (n0 < DM) src = n0; else { const int n2 = n0 - DM; src = DM + ((n2 >> 7) & 1) * DM + (n2 >> 8) * 128 + (n2 & 127); } }
        else if (mode == 2) src = ((n0 >> 7) & 1) * FF + (n0 >> 8) * 128 + (n0 & 127);
        else src = DNP_MAIN + n0;
        p0_transpose_item(W, ldw, src, WT, K, n0, 64 * kb, scr, lane);
    }
    bf16* XB = (bf16*)(P.ws + WS_XB);
    for (int m = gw; m < M; m += NGW) {
        const GAS f32x4* xr = (const GAS f32x4*)(P.x + (size_t)m * DM) + lane;
        GAS v2u* o8 = (GAS v2u*)(XB + (size_t)m * DM) + lane;
#pragma unroll
        for (int j = 0; j < 8; ++j) { const f32x4 v = xr[64 * j]; v2u o; o.x = pk2(v.x, v.y); o.y = pk2(v.z, v.w); o8[64 * j] = o; }
    }
}

__device__ __forceinline__ void ln_phase(const float* xin, const bf16* H, const float* gain, const float* bias, float* xout, bf16* XB, int gw, int NGW, int lane) {
    f32x4 g[8], bb[8];
#pragma unroll
    for (int j = 0; j < 8; ++j) { g[j] = ((const GAS f32x4*)gain)[lane + 64 * j]; bb[j] = ((const GAS f32x4*)bias)[lane + 64 * j]; }
    for (int m = gw; m < M; m += NGW) {
        const GAS f32x4* xr = (const GAS f32x4*)(xin + (size_t)m * DM) + lane;
        const GAS v2u* hr = (const GAS v2u*)(H + (size_t)m * DM) + lane;
        f32x4 v[8]; float s = 0.f;
#pragma unroll
        for (int j = 0; j < 8; ++j) { const f32x4 xv = xr[64 * j]; const v2u hv = hr[64 * j];
            v[j].x = ALPHA * xv.x + bf_lo(hv.x); v[j].y = ALPHA * xv.y + bf_hi(hv.x); v[j].z = ALPHA * xv.z + bf_lo(hv.y); v[j].w = ALPHA * xv.w + bf_hi(hv.y);
            s += (v[j].x + v[j].y) + (v[j].z + v[j].w); }
        const float mean = wave_sum(s) * (1.f / DM); float s2 = 0.f;
#pragma unroll
        for (int j = 0; j < 8; ++j) { v[j] = v[j] - mean; s2 += (v[j].x * v[j].x + v[j].y * v[j].y) + (v[j].z * v[j].z + v[j].w * v[j].w); }
        const float rstd = 1.f / sqrtf(wave_sum(s2) * (1.f / DM) + LN_EPS);
        GAS f32x4* xo = (GAS f32x4*)(xout + (size_t)m * DM) + lane;
        GAS v2u* bo = (GAS v2u*)(XB + (size_t)m * DM) + lane;
#pragma unroll
        for (int j = 0; j < 8; ++j) { const f32x4 o = v[j] * rstd * g[j] + bb[j]; xo[64 * j] = o; v2u w; w.x = pk2(o.x, o.y); w.y = pk2(o.z, o.w); bo[64 * j] = w; }
    }
}

__device__ __forceinline__ void sc_conv_phase(const bf16* GB, const bf16* CU, const float* cw  , bf16* A2, int gt, int NGT) {
    constexpr int RB = 16, NCG = DM / 8, NITEMS = (M / RB) * NCG;
    for (int it = gt; it < NITEMS; it += NGT) {
        const int cgp = it % NCG, rb = it / NCG, c0 = cgp * 8, r0 = rb * RB;
        float w0[8], w1[8], w2[8];
#pragma unroll
        for (int e = 0; e < 8; e += 4) { const f32x4 a = *(const GAS f32x4*)(cw + c0 + e), b = *(const GAS f32x4*)(cw + DM + c0 + e), c = *(const GAS f32x4*)(cw + 2 * DM + c0 + e);
            w0[e] = a.x; w0[e + 1] = a.y; w0[e + 2] = a.z; w0[e + 3] = a.w; w1[e] = b.x; w1[e + 1] = b.y; w1[e + 2] = b.z; w1[e + 3] = b.w; w2[e] = c.x; w2[e + 1] = c.y; w2[e + 2] = c.z; w2[e + 3] = c.w; }
        float um2[8], um1[8];
        const bool first = (r0 % SEQ) == 0;
        if (first) {
#pragma unroll
            for (int e = 0; e < 8; ++e) { um2[e] = 0.f; um1[e] = 0.f; } }
        else { unpack8(*(const GAS v4u*)(CU + (size_t)(r0 - 2) * DM + c0), um2); unpack8(*(const GAS v4u*)(CU + (size_t)(r0 - 1) * DM + c0), um1); }
#pragma unroll 4
        for (int r = 0; r < RB; ++r) {
            float u0[8], gb[8], o[8];
            unpack8(*(const GAS v4u*)(CU + (size_t)(r0 + r) * DM + c0), u0);
            unpack8(*(const GAS v4u*)(GB + (size_t)(r0 + r) * DM + c0), gb);
#pragma unroll
            for (int e = 0; e < 8; ++e) { o[e] = gb[e] * (w0[e] * um2[e] + w1[e] * um1[e] + w2[e] * u0[e]); um2[e] = um1[e]; um1[e] = u0[e]; }
            *(GAS v4u*)(A2 + (size_t)(r0 + r) * DM + c0) = pack8(o);
        }
    }
}

__device__ __forceinline__ void dn_pre_phase(const bf16* QKVr, const float* cw  , bf16* QC, bf16* KC, bf16* VC, const float* BA, const float* a_log, const float* dt_bias, float* BETA, float* DEC, float* GL,
                                             int gw, int NGW, int lane, int gt, int NGT) {
    constexpr int RB = 8, NCG = QKV / 512, NITEMS = (M / RB) * NCG;
    for (int it = gw; it < NITEMS; it += NGW) {
        const int cgp = it % NCG, rb = it / NCG, c0 = cgp * 512 + lane * 8, r0 = rb * RB;
        float w[4][8];
#pragma unroll
        for (int j = 0; j < 4; ++j)
#pragma unroll
            for (int e = 0; e < 8; e += 4) { const f32x4 a = *(const GAS f32x4*)(cw + (size_t)j * QKV + c0 + e); w[j][e] = a.x; w[j][e + 1] = a.y; w[j][e + 2] = a.z; w[j][e + 3] = a.w; }
        float h3[8], h2[8], h1[8];
        const bool first = (r0 % SEQ) == 0;
        if (first) {
#pragma unroll
            for (int e = 0; e < 8; ++e) { h3[e] = 0.f; h2[e] = 0.f; h1[e] = 0.f; } }
        else { unpack8(*(const GAS v4u*)(QKVr + (size_t)(r0 - 3) * QKV + c0), h3); unpack8(*(const GAS v4u*)(QKVr + (size_t)(r0 - 2) * QKV + c0), h2); unpack8(*(const GAS v4u*)(QKVr + (size_t)(r0 - 1) * QKV + c0), h1); }
        bf16* dst; int ldd, cd; float qs = 1.f; bool norm;
        if (c0 < KDIM) { dst = QC; ldd = KDIM; cd = c0; norm = true; qs = 0.08838834764831845f; }
        else if (c0 < 2 * KDIM) { dst = KC; ldd = KDIM; cd = c0 - KDIM; norm = true; }
        else { dst = VC; ldd = VDIM; cd = c0 - 2 * KDIM; norm = false; }
#pragma unroll 2
        for (int r = 0; r < RB; ++r) {
            float u0[8], o[8]; float ss = 0.f;
            unpack8(*(const GAS v4u*)(QKVr + (size_t)(r0 + r) * QKV + c0), u0);
#pragma unroll
            for (int e = 0; e < 8; ++e) { const float c = w[0][e] * h3[e] + w[1][e] * h2[e] + w[2][e] * h1[e] + w[3][e] * u0[e]; o[e] = silu_f(c); ss += o[e] * o[e]; h3[e] = h2[e]; h2[e] = h1[e]; h1[e] = u0[e]; }
            if (norm) { ss = sum16(ss); const float sc = qs / sqrtf(ss + RMS_EPS);
#pragma unroll
                for (int e = 0; e < 8; ++e) o[e] *= sc; }
            *(GAS v4u*)(dst + (size_t)(r0 + r) * ldd + cd) = pack8(o);
        }
    }
    for (int i = gt; i < M * HV; i += NGT) {
        const int hv = i & (HV - 1), row = i >> 5;
        const float br = BA[(size_t)row * 64 + hv], ar = BA[(size_t)row * 64 + HV + hv];
        const float xx = ar + dt_bias[hv];
        const float sp = fmaxf(xx, 0.f) + log1pf(__expf(-fabsf(xx)));
        const float gg = -__expf(a_log[hv]) * sp;
        BETA[i] = 1.f / (1.f + __expf(-br));
        DEC[i] = __expf(gg);
        GL[i] = gg;
    }
}

__device__ __forceinline__ void ba_phase(const bf16* XB, const bf16* Wba, float* BA, LAS unsigned char* lds, int unit, int wave, int lane) {
    const int mt = wave & 1, nt = (wave >> 1) & 1, kh = wave >> 2, r = lane & 31, h = lane >> 5;
    const bf16* ap = XB + (size_t)(unit * 64 + mt * 32 + r) * DM + kh * 1024 + 8 * h;
    const bf16* bp = Wba + (size_t)(nt * 32 + r) * DM + kh * 1024 + 8 * h;
    f32x16 acc = {};
#pragma unroll 8
    for (int ks = 0; ks < 64; ++ks) {
        const bf16x8 a = *(const GAS bf16x8*)(ap + ks * 16), b = *(const GAS bf16x8*)(bp + ks * 16);
        acc = __builtin_amdgcn_mfma_f32_32x32x16_bf16(a, b, acc, 0, 0, 0);
    }
    LAS float* red = (LAS float*)(lds + RING_OFF);
    if (kh == 1) {
#pragma unroll
        for (int i = 0; i < 16; ++i) red[((wave - 4) * 16 + i) * 64 + lane] = acc[i]; }
    __syncthreads();
    if (kh == 0) {
#pragma unroll
        for (int i = 0; i < 16; ++i) { const float v = acc[i] + red[(wave * 16 + i) * 64 + lane];
            const int row = unit * 64 + mt * 32 + (i & 3) + 8 * (i >> 2) + 4 * h;
            BA[(size_t)row * 64 + nt * 32 + r] = v; } }
    __syncthreads();
}

__device__ __forceinline__ void dn_naive_phase(const bf16* QC, const bf16* KC, const bf16* VC, const float* BETA, const float* DEC, float* O, LAS unsigned char* lds, int unit, int tid) {
    constexpr int CT = 32, NCH = SEQ / CT;
    constexpr int BUF = 16384 + 16384 + 4096 + 256;
    const int bh = unit >> 2, vq = unit & 3, b = bh >> 5, hv = bh & 31, hk = hv >> 1;
    const int vl = tid >> 4, p = tid & 15;
    LAS float* ob = (LAS float*)(lds + 2 * BUF);
    const size_t row0 = (size_t)b * SEQ;
    const int lr = tid >> 4, lp = tid & 15;
    const bf16* qsrc = QC + (row0 + lr) * KDIM + hk * HD + lp * 8;
    const bf16* ksrc = KC + (row0 + lr) * KDIM + hk * HD + lp * 8;
    const int vr = (tid & 127) >> 2, vp = tid & 3;
    const bf16* vsrc = VC + (row0 + vr) * VDIM + hv * HD + vq * 32 + vp * 8;
    const float* gsrc = (tid < 32 ? BETA : DEC) + (row0 + (tid & 31)) * HV + hv;
    v4u rq, rk, rv = {0u, 0u, 0u, 0u}; float rg = 0.f;
    rq = *(const GAS v4u*)qsrc; rk = *(const GAS v4u*)ksrc; if (tid < 128) rv = *(const GAS v4u*)vsrc; if (tid < 64) rg = *gsrc;
    float S[8];
#pragma unroll
    for (int i = 0; i < 8; ++i) S[i] = 0.f;
    for (int c = 0; c < NCH; ++c) {
        LAS unsigned char* buf = lds + (c & 1) * BUF;
        { float f[8]; unpack8(rq, f); LAS f32x4* d = (LAS f32x4*)(buf + (lr * 128 + lp * 8) * 4); d[0] = (f32x4){f[0], f[1], f[2], f[3]}; d[1] = (f32x4){f[4], f[5], f[6], f[7]};
          unpack8(rk, f); d = (LAS f32x4*)(buf + 16384 + (lr * 128 + lp * 8) * 4); d[0] = (f32x4){f[0], f[1], f[2], f[3]}; d[1] = (f32x4){f[4], f[5], f[6], f[7]};
          if (tid < 128) { unpack8(rv, f); d = (LAS f32x4*)(buf + 32768 + (vr * 32 + vp * 8) * 4); d[0] = (f32x4){f[0], f[1], f[2], f[3]}; d[1] = (f32x4){f[4], f[5], f[6], f[7]}; }
          if (tid < 64) ((LAS float*)(buf + 36864))[tid] = rg; }
        __syncthreads();
        if (c + 1 < NCH) { const size_t adv = (size_t)(c + 1) * CT;
            rq = *(const GAS v4u*)(qsrc + adv * KDIM); rk = *(const GAS v4u*)(ksrc + adv * KDIM); if (tid < 128) rv = *(const GAS v4u*)(vsrc + adv * VDIM); if (tid < 64) rg = gsrc[adv * HV]; }
        const LAS float* qf = (const LAS float*)buf; const LAS float* kf = (const LAS float*)(buf + 16384); const LAS float* vf = (const LAS float*)(buf + 32768); const LAS float* gf = (const LAS float*)(buf + 36864);
#pragma unroll 4
        for (int tt = 0; tt < CT; ++tt) {
            const f32x4 k0 = *(const LAS f32x4*)(kf + tt * 128 + 8 * p), k1 = *(const LAS f32x4*)(kf + tt * 128 + 8 * p + 4);
            const f32x4 q0 = *(const LAS f32x4*)(qf + tt * 128 + 8 * p), q1 = *(const LAS f32x4*)(qf + tt * 128 + 8 * p + 4);
            const float vt = vf[tt * 32 + vl], bt = gf[tt], at = gf[32 + tt];
            float pred = (S[0] * k0.x + S[1] * k0.y) + (S[2] * k0.z + S[3] * k0.w) + (S[4] * k1.x + S[5] * k1.y) + (S[6] * k1.z + S[7] * k1.w);
            pred = rowsum16(pred);
            const float delta = bt * (vt - at * pred);
            S[0] = at * S[0] + k0.x * delta; S[1] = at * S[1] + k0.y * delta; S[2] = at * S[2] + k0.z * delta; S[3] = at * S[3] + k0.w * delta;
            S[4] = at * S[4] + k1.x * delta; S[5] = at * S[5] + k1.y * delta; S[6] = at * S[6] + k1.z * delta; S[7] = at * S[7] + k1.w * delta;
            float o = (S[0] * q0.x + S[1] * q0.y) + (S[2] * q0.z + S[3] * q0.w) + (S[4] * q1.x + S[5] * q1.y) + (S[6] * q1.z + S[7] * q1.w);
            o = rowsum16(o);
            if (p == 0) ob[tt * 32 + vl] = o;
        }
        __syncthreads();
        if (tid < 256) { const int orow = tid >> 3, oc = (tid & 7) * 4; const f32x4 v = *(const LAS f32x4*)(ob + orow * 32 + oc);
            *(GAS f32x4*)(O + (row0 + (size_t)c * CT + orow) * VDIM + hv * HD + vq * 32 + oc) = v; }
    }
    __syncthreads();
}


constexpr int PL_Q = 0, PL_KT = 16384, PL_K = 32768, PL_V = 49152, PL_A = 81920, PL_SM = 114688, PL_WST = 0;
__device__ __forceinline__ int rm_addr(int row, int col) { return row * 256 + (((col >> 3) ^ (row & 15)) << 4) + (col & 7) * 2; }
__device__ __forceinline__ int kt_addr(int d, int c) { return d * 128 + (((c >> 2) ^ (d & 15)) << 3) + (c & 3) * 2; }
__device__ __forceinline__ int rowof(int rho, int h) { return (rho & 3) + 8 * (rho >> 2) + 4 * h; }
__device__ __forceinline__ unsigned short bf1(float v) { return (unsigned short)(pk2(v, v) & 0xffffu); }

__device__ __forceinline__ void dn_prep_item(const bf16* QC, const bf16* KC, const bf16* VC, const float* BETA, const float* GL, bf16* Wf, bf16* Qf, bf16* Kf, bf16* AQKf, bf16* Uf, float* SC,
                                             LAS unsigned char* lds, int item, int tid, int wave, int lane) {
    asm volatile("" : "+v"(tid), "+v"(lane));
    const int chunk = item & 127, bk = item >> 7, hk = bk & 15, b = bk >> 4;
    const size_t tok0 = (size_t)b * SEQ + (size_t)chunk * 64;
    const size_t ki = (size_t)item;
    const int r = lane & 31, h = lane >> 5;
    LAS float* betl = (LAS float*)(lds + PL_SM);
    LAS float* gcl_ = (LAS float*)(lds + PL_SM + 512);
    LAS float* facl = (LAS float*)(lds + PL_SM + 1024);
#pragma unroll
    for (int e = 0; e < 2; ++e) { const int id = tid + 512 * e, row = id >> 4, p = id & 15;
        const v4u qv = *(const GAS v4u*)(QC + (tok0 + row) * KDIM + hk * HD + p * 8);
        const v4u kv = *(const GAS v4u*)(KC + (tok0 + row) * KDIM + hk * HD + p * 8);
        *(LAS v4u*)(lds + PL_Q + rm_addr(row, p * 8)) = qv;
        *(LAS v4u*)(lds + PL_K + rm_addr(row, p * 8)) = kv;
        const unsigned kw[4] = {kv.x, kv.y, kv.z, kv.w};
#pragma unroll
        for (int e2 = 0; e2 < 8; ++e2) *(LAS unsigned short*)(lds + PL_KT + kt_addr(p * 8 + e2, row)) = (unsigned short)((kw[e2 >> 1] >> ((e2 & 1) * 16)) & 0xffffu); }
#pragma unroll
    for (int e = 0; e < 4; ++e) { const int id = tid + 512 * e, row = id >> 5, p = id & 31;
        const v4u vv = *(const GAS v4u*)(VC + (tok0 + row) * VDIM + hk * 2 * HD + p * 8);
        *(LAS v4u*)(lds + PL_V + (p >> 4) * 16384 + row * 256 + (p & 15) * 16) = vv; }
    if (wave < 2) { const int hv = 2 * hk + wave; const size_t gi = (tok0 + lane) * HV + hv; const float bt = BETA[gi]; float gc = GL[gi];
#pragma unroll
        for (int o = 1; o < 64; o <<= 1) { const float t = __shfl_up(gc, o); if (lane >= o) gc += t; }
        const float gl = __shfl(gc, 63);
        betl[wave * 64 + lane] = bt; gcl_[wave * 64 + lane] = gc; const float eg = __expf(gc);
        facl[(wave * 2 + 0) * 64 + lane] = bt; facl[(wave * 2 + 1) * 64 + lane] = bt * eg;
        float* sc = SC + ((size_t)(b * HV + hv) * 128 + chunk) * 256;
        sc[lane] = eg; sc[64 + lane] = __expf(gl - gc); if (lane == 0) sc[128] = __expf(gl); }
    LDS_WAIT(); __syncthreads();
    {   f32x16 acc = {};
        if (wave < 4) { const int tc = wave >> 1, tm = wave & 1;
#pragma unroll
            for (int ks = 0; ks < 8; ++ks) { const bf16x8 a = *(const LAS bf16x8*)(lds + PL_K + rm_addr(32 * tc + r, 16 * ks + 8 * h)), bb = *(const LAS bf16x8*)(lds + PL_K + rm_addr(32 * tm + r, 16 * ks + 8 * h));
                acc = __builtin_amdgcn_mfma_f32_32x32x16_bf16(a, bb, acc, 0, 0, 0); }
#pragma unroll
            for (int hvl = 0; hvl < 2; ++hvl) { const int m = 32 * tm + r; const float gm = gcl_[hvl * 64 + m];
#pragma unroll
                for (int rho = 0; rho < 16; ++rho) { const int c = 32 * tc + rowof(rho, h); const float e = __expf(fminf(gcl_[hvl * 64 + c] - gm, 0.f));
                    const float val = (c > m) ? betl[hvl * 64 + c] * acc[rho] * e : 0.f;
                    *(LAS float*)(lds + PL_A + hvl * 16384 + (c * 64 + m) * 4) = val; } }
        } else { const int tm = (wave - 4) >> 1, tcp = (wave - 4) & 1;
#pragma unroll
            for (int ks = 0; ks < 8; ++ks) { const bf16x8 a = *(const LAS bf16x8*)(lds + PL_K + rm_addr(32 * tm + r, 16 * ks + 8 * h)), bb = *(const LAS bf16x8*)(lds + PL_Q + rm_addr(32 * tcp + r, 16 * ks + 8 * h));
                acc = __builtin_amdgcn_mfma_f32_32x32x16_bf16(a, bb, acc, 0, 0, 0); }
#pragma unroll
            for (int hvl = 0; hvl < 2; ++hvl) { const int cp = 32 * tcp + r; const float gp = gcl_[hvl * 64 + cp]; float val[16];
#pragma unroll
                for (int rho = 0; rho < 16; ++rho) { const int m = 32 * tm + rowof(rho, h); const float e = __expf(fminf(gp - gcl_[hvl * 64 + m], 0.f)); val[rho] = (cp >= m) ? acc[rho] * e : 0.f; }
                bf16* dst = AQKf + ((size_t)(b * HV + 2 * hk + hvl) * 128 + chunk) * 4096 + ((tcp * 2 + tm) * 2) * 512 + lane * 8;
                v4u w0, w1; w0.x = pk2(val[0], val[1]); w0.y = pk2(val[2], val[3]); w0.z = pk2(val[4], val[5]); w0.w = pk2(val[6], val[7]);
                w1.x = pk2(val[8], val[9]); w1.y = pk2(val[10], val[11]); w1.z = pk2(val[12], val[13]); w1.w = pk2(val[14], val[15]);
                *(GAS v4u*)dst = w0; *(GAS v4u*)(dst + 512) = w1; } }
#pragma unroll
        for (int e = 0; e < 2; ++e) { const int f = 2 * wave + e;
            { const int t = f >> 3, i = (f >> 1) & 3, s = f & 1, row = 32 * t + r, col0 = 32 * i + 16 * s + 4 * h;
              const v2u lo = *(const LAS v2u*)(lds + PL_Q + rm_addr(row, col0)), hi = *(const LAS v2u*)(lds + PL_Q + rm_addr(row, col0 + 8));
              *(GAS v4u*)(Qf + ki * 8192 + f * 512 + lane * 8) = (v4u){lo.x, lo.y, hi.x, hi.y}; }
            { const int i = f >> 2, t = (f >> 1) & 1, s = f & 1, d = 32 * i + r, c0 = 32 * t + 16 * s + 4 * h;
              const v2u lo = *(const LAS v2u*)(lds + PL_KT + kt_addr(d, c0)), hi = *(const LAS v2u*)(lds + PL_KT + kt_addr(d, c0 + 8));
              *(GAS v4u*)(Kf + ki * 8192 + f * 512 + lane * 8) = (v4u){lo.x, lo.y, hi.x, hi.y}; } }
    }
    LDS_WAIT(); __syncthreads();
    {   const int hvl = wave >> 2, q4 = wave & 3; const bool isw = q4 >= 2; const int col = 64 * (q4 & 1) + lane;
        const LAS float* Am = (const LAS float*)(lds + PL_A + hvl * 16384);
        const LAS float* fc = facl + (hvl * 2 + (isw ? 1 : 0)) * 64;
        float X[64];
#pragma unroll
        for (int i = 0; i < 64; ++i) {
            const int sa = isw ? (PL_K + rm_addr(i, col)) : (PL_V + hvl * 16384 + i * 256 + col * 2);
            float acc = fc[i] * __uint_as_float((unsigned)(*(const LAS unsigned short*)(lds + sa)) << 16);
#pragma unroll
            for (int j0 = 0; j0 < i; j0 += 4) { const f32x4 a = *(const LAS f32x4*)(Am + i * 64 + j0);
                acc -= a.x * X[j0]; if (j0 + 1 < i) acc -= a.y * X[j0 + 1]; if (j0 + 2 < i) acc -= a.z * X[j0 + 2]; if (j0 + 3 < i) acc -= a.w * X[j0 + 3]; }
            X[i] = acc; }
        const size_t ci = (size_t)(b * HV + 2 * hk + hvl) * 128 + chunk;
        if (!isw) { const int jd = col >> 5, dl = col & 31;
#pragma unroll
            for (int t = 0; t < 2; ++t)
#pragma unroll
                for (int hh = 0; hh < 2; ++hh) { v4u w0, w1;
                    w0.x = pk2(X[32 * t + rowof(0, hh)], X[32 * t + rowof(1, hh)]); w0.y = pk2(X[32 * t + rowof(2, hh)], X[32 * t + rowof(3, hh)]); w0.z = pk2(X[32 * t + rowof(4, hh)], X[32 * t + rowof(5, hh)]); w0.w = pk2(X[32 * t + rowof(6, hh)], X[32 * t + rowof(7, hh)]);
                    w1.x = pk2(X[32 * t + rowof(8, hh)], X[32 * t + rowof(9, hh)]); w1.y = pk2(X[32 * t + rowof(10, hh)], X[32 * t + rowof(11, hh)]); w1.z = pk2(X[32 * t + rowof(12, hh)], X[32 * t + rowof(13, hh)]); w1.w = pk2(X[32 * t + rowof(14, hh)], X[32 * t + rowof(15, hh)]);
                    bf16* dst = Uf + ci * 8192 + (size_t)(((jd * 2 + t) * 64 + hh * 32 + dl) * 16);
                    *(GAS v4u*)dst = w0; *(GAS v4u*)(dst + 8) = w1; }
        } else {
#pragma unroll
            for (int i = 0; i < 64; ++i) *(LAS unsigned short*)(lds + PL_WST + hvl * 16384 + rm_addr(i, col)) = bf1(X[i]);
        }
    }
    LDS_WAIT(); __syncthreads();
#pragma unroll
    for (int e = 0; e < 4; ++e) { const int idx = wave * 4 + e, hvl = idx >> 4, f = idx & 15, t = f >> 3, i = (f >> 1) & 3, s = f & 1, row = 32 * t + r, col0 = 32 * i + 16 * s + 4 * h;
        const v2u lo = *(const LAS v2u*)(lds + PL_WST + hvl * 16384 + rm_addr(row, col0)), hi = *(const LAS v2u*)(lds + PL_WST + hvl * 16384 + rm_addr(row, col0 + 8));
        *(GAS v4u*)(Wf + ((size_t)(b * HV + 2 * hk + hvl) * 128 + chunk) * 8192 + f * 512 + lane * 8) = (v4u){lo.x, lo.y, hi.x, hi.y}; }
    LDS_WAIT(); __syncthreads();
}

__device__ __forceinline__ void dn_scan_phase(const bf16* Wf, const bf16* Qf, const bf16* Kf, const bf16* AQKf, const bf16* Uf, const float* SC, float* O, LAS unsigned char* lds, int unit, int wave, int lane) {
    constexpr int BUFB = 58368, NST = SEQ / 64;
    const int bh = unit >> 2, jd = unit & 3, b = bh >> 5, hv = bh & 31, hk = hv >> 1;
    const size_t ci0 = (size_t)(b * HV + hv) * 128, ki0 = (size_t)(b * HK + hk) * 128;
    const int r = lane & 31, h = lane >> 5;
    if (wave > 0) {
        const bf16* src; size_t stride;
        if (wave <= 2) { src = Wf + ci0 * 8192 + (wave - 1) * 4096; stride = 8192; }
        else if (wave <= 4) { src = Qf + ki0 * 8192 + (wave - 3) * 4096; stride = 8192; }
        else if (wave <= 6) { src = Kf + ki0 * 8192 + (wave - 5) * 4096; stride = 8192; }
        else { src = AQKf + ci0 * 4096; stride = 4096; }
        src += lane * 8;
        const float* ssrc = SC + ci0 * 256 + lane * 4;
        const int dofs = (wave - 1) * 8192 + lane * 16;
        v4u R[8]; f32x4 Rs = {0.f, 0.f, 0.f, 0.f};
#pragma unroll
        for (int e = 0; e < 8; ++e) R[e] = *(const GAS v4u*)(src + e * 512);
        if (wave == 1) Rs = *(const GAS f32x4*)ssrc;
#pragma unroll
        for (int e = 0; e < 8; ++e) *(LAS v4u*)(lds + dofs + e * 1024) = R[e];
        if (wave == 1) *(LAS f32x4*)(lds + 57344 + lane * 16) = Rs;
#pragma unroll
        for (int e = 0; e < 8; ++e) R[e] = *(const GAS v4u*)(src + stride + e * 512);
        if (wave == 1) Rs = *(const GAS f32x4*)(ssrc + 256);
        for (int n = 0; n < NST; ++n) {
            LDS_WAIT(); __builtin_amdgcn_s_barrier(); asm volatile("" ::: "memory");
            if (n + 1 < NST) { LAS unsigned char* bp = lds + ((n + 1) & 1) * BUFB;
#pragma unroll
                for (int e = 0; e < 8; ++e) *(LAS v4u*)(bp + dofs + e * 1024) = R[e];
                if (wave == 1) *(LAS f32x4*)(bp + 57344 + lane * 16) = Rs; }
            if (n + 2 < NST) { const bf16* sp = src + (size_t)(n + 2) * stride;
#pragma unroll
                for (int e = 0; e < 8; ++e) R[e] = *(const GAS v4u*)(sp + e * 512);
                if (wave == 1) Rs = *(const GAS f32x4*)(ssrc + (size_t)(n + 2) * 256); }
        }
    } else {
        f32x16 S0 = {}, S1 = {}, S2 = {}, S3 = {};
        const bf16* usrc = Uf + ci0 * 8192 + (size_t)((jd * 2) * 64 + lane) * 16;
        v4u un[4];
        un[0] = *(const GAS v4u*)usrc; un[1] = *(const GAS v4u*)(usrc + 8); un[2] = *(const GAS v4u*)(usrc + 1024); un[3] = *(const GAS v4u*)(usrc + 1032);
        float* obase = O + ((size_t)b * SEQ) * VDIM + hv * HD + jd * 32 + r;
#define MF(a, bq, c) __builtin_amdgcn_mfma_f32_32x32x16_bf16(a, bq, c, 0, 0, 0)
#define FRAG(off) (*(const LAS bf16x8*)(bp + (off) + lane * 16))
#define PK8(V, s) __builtin_bit_cast(bf16x8, (v4u){pk2(V[8 * (s) + 0], V[8 * (s) + 1]), pk2(V[8 * (s) + 2], V[8 * (s) + 3]), pk2(V[8 * (s) + 4], V[8 * (s) + 5]), pk2(V[8 * (s) + 6], V[8 * (s) + 7])})
        for (int n = 0; n < NST; ++n) {
            LDS_WAIT(); __builtin_amdgcn_s_barrier(); asm volatile("" ::: "memory");
            const LAS unsigned char* bp = lds + (n & 1) * BUFB;
            const v4u u0 = un[0], u1 = un[1], u2 = un[2], u3 = un[3];
            if (n + 1 < NST) { const bf16* up = usrc + (size_t)(n + 1) * 8192; un[0] = *(const GAS v4u*)up; un[1] = *(const GAS v4u*)(up + 8); un[2] = *(const GAS v4u*)(up + 1024); un[3] = *(const GAS v4u*)(up + 1032); }
            const bf16x8 Sb00 = PK8(S0, 0), Sb01 = PK8(S0, 1), Sb10 = PK8(S1, 0), Sb11 = PK8(S1, 1), Sb20 = PK8(S2, 0), Sb21 = PK8(S2, 1), Sb30 = PK8(S3, 0), Sb31 = PK8(S3, 1);
            f32x16 P0 = {}, P1 = {};
            P0 = MF(FRAG(0 * 1024), Sb00, P0); P1 = MF(FRAG(8 * 1024), Sb00, P1);
            P0 = MF(FRAG(1 * 1024), Sb01, P0); P1 = MF(FRAG(9 * 1024), Sb01, P1);
            P0 = MF(FRAG(2 * 1024), Sb10, P0); P1 = MF(FRAG(10 * 1024), Sb10, P1);
            P0 = MF(FRAG(3 * 1024), Sb11, P0); P1 = MF(FRAG(11 * 1024), Sb11, P1);
            P0 = MF(FRAG(4 * 1024), Sb20, P0); P1 = MF(FRAG(12 * 1024), Sb20, P1);
            P0 = MF(FRAG(5 * 1024), Sb21, P0); P1 = MF(FRAG(13 * 1024), Sb21, P1);
            P0 = MF(FRAG(6 * 1024), Sb30, P0); P1 = MF(FRAG(14 * 1024), Sb30, P1);
            P0 = MF(FRAG(7 * 1024), Sb31, P0); P1 = MF(FRAG(15 * 1024), Sb31, P1);
            float V0[16], V1[16], E0[16], E1[16];
            { float uu[8]; unpack8(u0, uu);
#pragma unroll
              for (int e = 0; e < 8; ++e) V0[e] = uu[e] - P0[e];
              unpack8(u1, uu);
#pragma unroll
              for (int e = 0; e < 8; ++e) V0[8 + e] = uu[e] - P0[8 + e];
              unpack8(u2, uu);
#pragma unroll
              for (int e = 0; e < 8; ++e) V1[e] = uu[e] - P1[e];
              unpack8(u3, uu);
#pragma unroll
              for (int e = 0; e < 8; ++e) V1[8 + e] = uu[e] - P1[8 + e]; }
            const LAS float* scl = (const LAS float*)(bp + 57344);
#pragma unroll
            for (int g = 0; g < 4; ++g) { const f32x4 k0 = *(const LAS f32x4*)(scl + 64 + 8 * g + 4 * h), k1 = *(const LAS f32x4*)(scl + 64 + 32 + 8 * g + 4 * h);
                E0[4 * g + 0] = V0[4 * g + 0] * k0.x; E0[4 * g + 1] = V0[4 * g + 1] * k0.y; E0[4 * g + 2] = V0[4 * g + 2] * k0.z; E0[4 * g + 3] = V0[4 * g + 3] * k0.w;
                E1[4 * g + 0] = V1[4 * g + 0] * k1.x; E1[4 * g + 1] = V1[4 * g + 1] * k1.y; E1[4 * g + 2] = V1[4 * g + 2] * k1.z; E1[4 * g + 3] = V1[4 * g + 3] * k1.w; }
            const bf16x8 Vb00 = PK8(V0, 0), Vb01 = PK8(V0, 1), Vb10 = PK8(V1, 0), Vb11 = PK8(V1, 1);
            const bf16x8 Ve00 = PK8(E0, 0), Ve01 = PK8(E0, 1), Ve10 = PK8(E1, 0), Ve11 = PK8(E1, 1);
            const size_t orow = (size_t)n * 64;
#pragma unroll
            for (int tp = 0; tp < 2; ++tp) {
                f32x16 oa = {};
                oa = MF(FRAG(16384 + (tp * 8 + 0) * 1024), Sb00, oa); oa = MF(FRAG(16384 + (tp * 8 + 1) * 1024), Sb01, oa);
                oa = MF(FRAG(16384 + (tp * 8 + 2) * 1024), Sb10, oa); oa = MF(FRAG(16384 + (tp * 8 + 3) * 1024), Sb11, oa);
                oa = MF(FRAG(16384 + (tp * 8 + 4) * 1024), Sb20, oa); oa = MF(FRAG(16384 + (tp * 8 + 5) * 1024), Sb21, oa);
                oa = MF(FRAG(16384 + (tp * 8 + 6) * 1024), Sb30, oa); oa = MF(FRAG(16384 + (tp * 8 + 7) * 1024), Sb31, oa);
#pragma unroll
                for (int g = 0; g < 4; ++g) { const f32x4 e4 = *(const LAS f32x4*)(scl + 32 * tp + 8 * g + 4 * h);
                    oa[4 * g + 0] *= e4.x; oa[4 * g + 1] *= e4.y; oa[4 * g + 2] *= e4.z; oa[4 * g + 3] *= e4.w; }
                oa = MF(FRAG(49152 + (tp * 4 + 0) * 1024), Vb00, oa); oa = MF(FRAG(49152 + (tp * 4 + 1) * 1024), Vb01, oa);
                if (tp == 1) { oa = MF(FRAG(49152 + (tp * 4 + 2) * 1024), Vb10, oa); oa = MF(FRAG(49152 + (tp * 4 + 3) * 1024), Vb11, oa); }
#pragma unroll
                for (int rho = 0; rho < 16; ++rho) obase[(orow + 32 * tp + rowof(rho, h)) * VDIM] = oa[rho];
            }
            const float cd = scl[128];
            S0 = S0 * cd; S1 = S1 * cd; S2 = S2 * cd; S3 = S3 * cd;
            S0 = MF(FRAG(32768 + 0 * 1024), Ve00, S0); S0 = MF(FRAG(32768 + 1 * 1024), Ve01, S0); S0 = MF(FRAG(32768 + 2 * 1024), Ve10, S0); S0 = MF(FRAG(32768 + 3 * 1024), Ve11, S0);
            S1 = MF(FRAG(32768 + 4 * 1024), Ve00, S1); S1 = MF(FRAG(32768 + 5 * 1024), Ve01, S1); S1 = MF(FRAG(32768 + 6 * 1024), Ve10, S1); S1 = MF(FRAG(32768 + 7 * 1024), Ve11, S1);
            S2 = MF(FRAG(32768 + 8 * 1024), Ve00, S2); S2 = MF(FRAG(32768 + 9 * 1024), Ve01, S2); S2 = MF(FRAG(32768 + 10 * 1024), Ve10, S2); S2 = MF(FRAG(32768 + 11 * 1024), Ve11, S2);
            S3 = MF(FRAG(32768 + 12 * 1024), Ve00, S3); S3 = MF(FRAG(32768 + 13 * 1024), Ve01, S3); S3 = MF(FRAG(32768 + 14 * 1024), Ve10, S3); S3 = MF(FRAG(32768 + 15 * 1024), Ve11, S3);
        }
#undef MF
#undef FRAG
#undef PK8
    }
    LDS_WAIT(); __syncthreads();
}

__device__ __forceinline__ void dn_gnorm_phase(const float* O, const bf16* Z, const float* nw, bf16* A3, int gw, int NGW, int lane) {
    constexpr int NCG = VDIM / 512, NITEMS = M * NCG;
    float wv[8];
    { const f32x4 a = *(const GAS f32x4*)(nw + (lane & 15) * 8), b = *(const GAS f32x4*)(nw + (lane & 15) * 8 + 4); wv[0] = a.x; wv[1] = a.y; wv[2] = a.z; wv[3] = a.w; wv[4] = b.x; wv[5] = b.y; wv[6] = b.z; wv[7] = b.w; }
    for (int it = gw; it < NITEMS; it += NGW) {
        const int cgp = it % NCG, row = it / NCG, c0 = cgp * 512 + lane * 8;
        const f32x4 a = *(const GAS f32x4*)(O + (size_t)row * VDIM + c0), b = *(const GAS f32x4*)(O + (size_t)row * VDIM + c0 + 4);
        float z[8]; unpack8(*(const GAS v4u*)(Z + (size_t)row * VDIM + c0), z);
        float o[8] = {a.x, a.y, a.z, a.w, b.x, b.y, b.z, b.w};
        float ss = 0.f;
#pragma unroll
        for (int e = 0; e < 8; ++e) ss += o[e] * o[e];
        ss = sum16(ss);
        const float rs = 1.f / sqrtf(ss * (1.f / HD) + RMS_EPS);
#pragma unroll
        for (int e = 0; e < 8; ++e) o[e] = o[e] * rs * wv[e] * silu_f(z[e]);
        *(GAS v4u*)(A3 + (size_t)row * VDIM + c0) = pack8(o);
    }
}

struct Args { const float* in[14]; float* out; unsigned char* ws; int ph_lo, ph_hi, li, pad; };
__device__ __forceinline__ unsigned long long ptab_get(LAS unsigned char* lds, int i) {
    volatile LAS unsigned* p = (volatile LAS unsigned*)(lds + PTAB_OFF) + 2 * i;
    const unsigned lo = __builtin_amdgcn_readfirstlane(p[0]), hi = __builtin_amdgcn_readfirstlane(p[1]);
    return ((unsigned long long)hi << 32) | lo;
}
#ifndef REP_MASK
#define REP_MASK 0
#endif
#define REPS(t) for (int rep_ = 0; rep_ < 1 + ((REP_MASK >> (t)) & 1); ++rep_)
#define PIN(i) ((const float*)ptab_get(lds, (i)))
#define POUT ((float*)ptab_get(lds, 14))
#define PWS ((unsigned char*)ptab_get(lds, 15))
#define LOCAL_IDS int tid = threadIdx.x; asm volatile("" : "+v"(tid)); const int lane = tid & 63, wave = __builtin_amdgcn_readfirstlane(tid >> 6); const int G = gridDim.x, bx = blockIdx.x; \
    const int vcu = (G % 8 == 0) ? (bx % 8) * (G / 8) + bx / 8 : bx; const int gw = vcu * NWAVES + wave, NGW = G * NWAVES, gt = vcu * (NWAVES * 64) + tid, NGT = G * NWAVES * 64; \
    unsigned char* const ws = PWS; (void)lane; (void)gw; (void)NGW; (void)gt; (void)NGT; (void)ws
__global__ void __launch_bounds__(NWAVES * 64, 2) fwd(Args args) {
    extern __shared__ __attribute__((aligned(16))) unsigned char lds_raw[];
    LAS unsigned char* lds = (LAS unsigned char*)lds_raw;
    volatile LAS unsigned* MISC = (volatile LAS unsigned*)(lds + MISC_OFF);
    for (int u = threadIdx.x; u < (LDS_BYTES - LDSCTL_OFF) / 4; u += NWAVES * 64) ((LAS unsigned*)(lds + LDSCTL_OFF))[u] = 0u;
    __syncthreads();
    if (threadIdx.x == 0) {
        LAS unsigned long long* pt = (LAS unsigned long long*)(lds + PTAB_OFF);
#pragma unroll
        for (int i = 0; i < 14; ++i) pt[i] = (unsigned long long)args.in[i];
        pt[14] = (unsigned long long)args.out; pt[15] = (unsigned long long)args.ws;
    }
    __syncthreads();
    if (threadIdx.x == 0) { LAS unsigned* pw = (LAS unsigned*)(lds + PTAB_OFF) + 32; pw[0] = (unsigned)args.ph_lo; pw[1] = (unsigned)args.ph_hi; }
    if (!MK_PER_PHASE) (void)xcd_barrier_post((unsigned*)(args.ws + WS_CTL) + CW_BAR, MISC + 8);
    __syncthreads();
#define PH_LO ((int)__builtin_amdgcn_readfirstlane(((volatile LAS unsigned*)(lds + PTAB_OFF))[32]))
#define PH_HI ((int)__builtin_amdgcn_readfirstlane(((volatile LAS unsigned*)(lds + PTAB_OFF))[33]))
#define IN(k) (PH_LO <= (k) && (k) < PH_HI)
#define SEAM(k) do { if (!MK_PER_PHASE) { if (IN(k) && IN((k) + 1)) { XcdBarrier bar_; bar_.bar = (unsigned*)(PWS + WS_CTL) + CW_BAR; bar_.x = xb_xcc_id(); bar_.st = MISC + 8; xcd_barrier(bar_); } } } while (0)

    if (IN(0)) REPS(0) { LOCAL_IDS; Ptrs P; P.x = PIN(0); P.sc_w_in = PIN(1); P.sc_w_out = PIN(3); P.dn_w_in = PIN(4); P.dn_w_out = PIN(9); P.ffn_gu = PIN(10); P.ffn_down = PIN(11); P.ws = ws;
        p0_prologue(P, lds, gw, NGW, wave, lane); }
    SEAM(0);

    for (int L = 0; L < DEPTH; ++L) {
        const int j = L >> 1;
        const int pb = 1 + 17 * j + ((L & 1) ? 7 : 0);
        int fb;
        if ((L & 1) == 0) {
            if (IN(pb + 0)) REPS(1) {
                LOCAL_IDS;
                pg8::Gemm g{(const bf16*)(ws + WS_XB), (const bf16*)(ws + WS_W_SCIN) + (size_t)j * 3 * DM * DM, M, 3 * DM, DM}; pg8::StaticOrder S; S.init(M, 3 * DM, G, bx);
                pg8::EpiGate<0> E{(bf16*)(ws + WS_GB), DM, (bf16*)(ws + WS_CU), DM, DM / 256};
                pg8::gemm_phase<pg8::EpiGate<0>, pg8::StaticOrder, PG8_ALIGN, PG8_SP2>(lds + RING_OFF, g, S, E);
            }
            SEAM(pb + 0);
            if (IN(pb + 1)) REPS(2) { LOCAL_IDS; sc_conv_phase((const bf16*)(ws + WS_GB), (const bf16*)(ws + WS_CU), PIN(2) + (size_t)j * 3 * DM, (bf16*)(ws + WS_A2), gt, NGT); }
            SEAM(pb + 1);
            if (IN(pb + 2)) REPS(3) {
                LOCAL_IDS;
                pg8::Gemm g{(const bf16*)(ws + WS_A2), (const bf16*)(ws + WS_W_SCOUT) + (size_t)j * DM * DM, M, DM, DM}; pg8::StaticOrder S; S.init(M, DM, G, bx);
                pg8::EpiStore2 E{(bf16*)(ws + WS_H1), DM, (bf16*)(ws + WS_H1), DM, 1 << 30};
                pg8::gemm_phase<pg8::EpiStore2, pg8::StaticOrder, PG8_ALIGN, PG8_SP2>(lds + RING_OFF, g, S, E);
            }
            SEAM(pb + 2);
            if (IN(pb + 3)) { LOCAL_IDS; ln_phase((L == 0) ? PIN(0) : (const float*)POUT, (const bf16*)(ws + WS_H1), PIN(12) + (size_t)(L * 2) * DM, PIN(13) + (size_t)(L * 2) * DM, POUT, (bf16*)(ws + WS_XB), gw, NGW, lane); }
            SEAM(pb + 3);
            fb = pb + 4;
        } else {
            if (IN(pb + 0)) REPS(5) {
                LOCAL_IDS;
                pg8::Gemm g{(const bf16*)(ws + WS_XB), (const bf16*)(ws + WS_W_DNIN) + (size_t)j * DNP_MAIN * DM, M, DNP_MAIN, DM}; pg8::StaticOrder S; S.init(M, DNP_MAIN, G, bx);
                pg8::EpiStore2 E{(bf16*)(ws + WS_QKV), QKV, (bf16*)(ws + WS_Z), VDIM, QKV};
                pg8::gemm_phase<pg8::EpiStore2, pg8::StaticOrder, PG8_ALIGN, PG8_SP2>(lds + RING_OFF, g, S, E);
            }
            if (IN(pb + 0)) {
                LOCAL_IDS;
                for (int u = bx; u < M / 64; u += G) ba_phase((const bf16*)(ws + WS_XB), (const bf16*)(ws + WS_W_BA) + (size_t)j * 64 * DM, (float*)(ws + WS_BA), lds, u, wave, lane);
            }
            SEAM(pb + 0);
            if (IN(pb + 1)) REPS(6) { LOCAL_IDS; dn_pre_phase((const bf16*)(ws + WS_QKV), PIN(5) + (size_t)j * 4 * QKV, (bf16*)(ws + WS_QC), (bf16*)(ws + WS_KC), (bf16*)(ws + WS_VC), (const float*)(ws + WS_BA), PIN(6) + j * HV, PIN(7) + j * HV,
                                                       (float*)(ws + WS_BETA), (float*)(ws + WS_DEC), (float*)(ws + WS_GL), gw, NGW, lane, gt, NGT); }
            SEAM(pb + 1);
#if DN_CHUNKED
            if (IN(pb + 2)) REPS(7) { LOCAL_IDS; for (int it = vcu; it < BATCH * HK * (SEQ / 64); it += G)
                dn_prep_item((const bf16*)(ws + WS_QC), (const bf16*)(ws + WS_KC), (const bf16*)(ws + WS_VC), (const float*)(ws + WS_BETA), (const float*)(ws + WS_GL),
                             (bf16*)(ws + WS_WF), (bf16*)(ws + WS_QF), (bf16*)(ws + WS_KF), (bf16*)(ws + WS_AQKF), (bf16*)(ws + WS_UF), (float*)(ws + WS_SC), lds, it, tid, wave, lane); }
            SEAM(pb + 2);
            if (IN(pb + 3)) REPS(12) { LOCAL_IDS; for (int u = vcu; u < BATCH * HV * 4; u += G)
                dn_scan_phase((const bf16*)(ws + WS_WF), (const bf16*)(ws + WS_QF), (const bf16*)(ws + WS_KF), (const bf16*)(ws + WS_AQKF), (const bf16*)(ws + WS_UF), (const float*)(ws + WS_SC), (float*)(ws + WS_O2), lds, u, wave, lane); }
            SEAM(pb + 3);
            if (IN(pb + 4)) REPS(8) { LOCAL_IDS; dn_gnorm_phase((const float*)(ws + WS_O2), (const bf16*)(ws + WS_Z), PIN(8) + j * HD, (bf16*)(ws + WS_A3), gw, NGW, lane); }
#else
            if (IN(pb + 2)) REPS(7) { LOCAL_IDS; for (int u = vcu; u < BATCH * HV * 4; u += G) dn_naive_phase((const bf16*)(ws + WS_QC), (const bf16*)(ws + WS_KC), (const bf16*)(ws + WS_VC), (const float*)(ws + WS_BETA), (const float*)(ws + WS_DEC), (float*)(ws + WS_O), lds, u, tid); }
            SEAM(pb + 2);
            SEAM(pb + 3);
            if (IN(pb + 4)) REPS(8) { LOCAL_IDS; dn_gnorm_phase((const float*)(ws + WS_O), (const bf16*)(ws + WS_Z), PIN(8) + j * HD, (bf16*)(ws + WS_A3), gw, NGW, lane); }
#endif
            SEAM(pb + 4);
            if (IN(pb + 5)) REPS(9) {
                LOCAL_IDS;
                pg8::Gemm g{(const bf16*)(ws + WS_A3), (const bf16*)(ws + WS_W_DNOUT) + (size_t)j * DM * VDIM, M, DM, VDIM}; pg8::StaticOrder S; S.init(M, DM, G, bx);
                pg8::EpiStore2 E{(bf16*)(ws + WS_H1), DM, (bf16*)(ws + WS_H1), DM, 1 << 30};
                pg8::gemm_phase<pg8::EpiStore2, pg8::StaticOrder, PG8_ALIGN, PG8_SP2>(lds + RING_OFF, g, S, E);
            }
            SEAM(pb + 5);
            if (IN(pb + 6)) { LOCAL_IDS; ln_phase((const float*)POUT, (const bf16*)(ws + WS_H1), PIN(12) + (size_t)(L * 2) * DM, PIN(13) + (size_t)(L * 2) * DM, POUT, (bf16*)(ws + WS_XB), gw, NGW, lane); }
            SEAM(pb + 6);
            fb = pb + 7;
        }
        if (IN(fb + 0)) REPS(10) {
            LOCAL_IDS;
            pg8::Gemm g{(const bf16*)(ws + WS_XB), (const bf16*)(ws + WS_W_GU) + (size_t)L * 2 * FF * DM, M, 2 * FF, DM}; pg8::StaticOrder S; S.init(M, 2 * FF, G, bx);
            pg8::EpiGate<1> E{(bf16*)(ws + WS_HID), FF, (bf16*)(ws + WS_HID), FF, 0};
            pg8::gemm_phase<pg8::EpiGate<1>, pg8::StaticOrder, PG8_ALIGN, PG8_SP2>(lds + RING_OFF, g, S, E);
        }
        SEAM(fb + 0);
        if (IN(fb + 1)) REPS(11) {
            LOCAL_IDS;
            pg8::Gemm g{(const bf16*)(ws + WS_HID), (const bf16*)(ws + WS_W_DOWN) + (size_t)L * DM * FF, M, DM, FF}; pg8::StaticOrder S; S.init(M, DM, G, bx);
            pg8::EpiStore2 E{(bf16*)(ws + WS_H1), DM, (bf16*)(ws + WS_H1), DM, 1 << 30};
            pg8::gemm_phase<pg8::EpiStore2, pg8::StaticOrder, PG8_ALIGN, PG8_SP2>(lds + RING_OFF, g, S, E);
        }
        SEAM(fb + 1);
        if (IN(fb + 2)) { LOCAL_IDS; ln_phase((const float*)POUT, (const bf16*)(ws + WS_H1), PIN(12) + (size_t)(L * 2 + 1) * DM, PIN(13) + (size_t)(L * 2 + 1) * DM, POUT, (bf16*)(ws + WS_XB), gw, NGW, lane); }
        SEAM(fb + 2);
    }
#undef IN
#undef SEAM
}

extern "C" void kernel_launch(void* const* d_in, const int* in_sizes, int n_in, void* d_out, int out_size, void* d_ws, size_t ws_size, hipStream_t stream) {
    static int grid = 0;
    if (grid == 0) {
        if (n_in != 14 || in_sizes[0] != M * DM || out_size != M * DM || ws_size < WS_END) { fprintf(stderr, "kernel_launch: unexpected shapes (n_in %d, in0 %d, out %d, ws %zu < %zu); nothing launched\n", n_in, n_in > 0 ? in_sizes[0] : -1, out_size, ws_size, (size_t)WS_END); grid = -1; return; }
        int dev = 0, cus = 0, per_cu = 0;
        if (hipGetDevice(&dev) != hipSuccess || hipDeviceGetAttribute(&cus, hipDeviceAttributeMultiprocessorCount, dev) != hipSuccess) { grid = -1; return; }
        if (hipFuncSetAttribute((const void*)fwd, hipFuncAttributeMaxDynamicSharedMemorySize, LDS_BYTES) != hipSuccess) { fprintf(stderr, "kernel_launch: hipFuncSetAttribute failed\n"); grid = -1; return; }
        if (hipOccupancyMaxActiveBlocksPerMultiprocessor(&per_cu, (const void*)fwd, NWAVES * 64, LDS_BYTES) != hipSuccess || per_cu < 1) fprintf(stderr, "kernel_launch: occupancy query reports %d\n", per_cu);
        (void)hipGetLastError();
        grid = cus;
        if (grid > 256) grid = 256;
    }
    if (grid < 0) return;
    if (hipMemsetAsync((char*)d_ws + WS_CTL, 0, CTL_ZERO_BYTES, stream) != hipSuccess) return;
    Args a{};
    for (int i = 0; i < 14; ++i) a.in[i] = (const float*)d_in[i];
    a.out = (float*)d_out; a.ws = (unsigned char*)d_ws;
#if MK_PER_PHASE
    for (int p = 0; p < N_PHASES; ++p) { a.ph_lo = p; a.ph_hi = p + 1; a.li = p; hipLaunchKernelGGL(fwd, dim3(grid), dim3(NWAVES * 64), LDS_BYTES, stream, a); }
#else
    a.ph_lo = 0; a.ph_hi = N_PHASES; a.li = 0;
    hipLaunchKernelGGL(fwd, dim3(grid), dim3(NWAVES * 64), LDS_BYTES, stream, a);
#endif
}
```

```cpp
#include <hip/hip_runtime.h>
#include <cstdio>
#include <cstdint>
namespace pg8 {
#define PG8_LAS __attribute__((address_space(3)))
typedef unsigned short bf16_t;
typedef short bf16x8 __attribute__((ext_vector_type(8)));
typedef float f32x4 __attribute__((ext_vector_type(4)));
typedef unsigned u32x4 __attribute__((ext_vector_type(4)));
constexpr int BM = 256, BK = 64, HALF = 128, HTB = HALF * BK * 2  , STAGE_BYTES = 8 * HTB, NXCD = 8, WGM = 8;

__host__ __device__ __forceinline__ int lds_byte(int r, int c) { const int st = (r >> 4) * 2 + (c >> 5), rr = r & 15, cc = c & 31, ob = rr * 64 + cc * 2; return st * 1024 + (ob ^ (((ob >> 9) & 1) << 5)); }
__host__ __device__ __forceinline__ void stage_rc(int b, int& R, int& C) { const int st = b / 1024, sb = b % 1024, swz = sb ^ (((sb >> 9) & 1) << 5); R = (st >> 1) * 16 + swz / 64; C = (st & 1) * 32 + (swz % 64) / 2; }
__host__ __device__ __forceinline__ int perm32(int rho) { const int n = rho >> 4, i = rho & 15; return 8 * (i >> 2) + 4 * n + (i & 3); }

struct Unit { int pm, pn; };
struct Gemm { const bf16_t* A; const bf16_t* Bt; int M, N, K; };

struct StaticOrder {
    int nM, nN, nwg, G, c;
    __host__ __device__ void init(int M, int N, int G_, int c_) { nM = M / BM; nN = N / BM; nwg = nM * nN; G = G_; c = c_; }
    __host__ __device__ bool next(int i, Unit& u) const {
        const long L = (long)i * G + c; if (L >= nwg) return false;
        int wgid = (int)L; { const int q = nwg / NXCD, r = nwg % NXCD, xcd = wgid % NXCD, off = wgid / NXCD; wgid = (xcd < r ? xcd * (q + 1) : r * (q + 1) + (xcd - r) * q) + off; }
        const int nig = WGM * nN, gid = wgid / nig, fm = gid * WGM, gsz = (nM - fm) < WGM ? (nM - fm) : WGM;
        u.pm = fm + ((wgid % nig) % gsz); u.pn = (wgid % nig) / gsz; return true;
    }
    __device__ __forceinline__ void a_ready(const Unit&) const {}
    __device__ __forceinline__ void done(const Unit&) const {}
};


typedef float f32x2_t __attribute__((ext_vector_type(2)));
typedef __bf16 bf16x2_t __attribute__((ext_vector_type(2)));
__device__ __forceinline__ unsigned cvt_pk_bf16(float lo, float hi) { f32x2_t v = {lo, hi}; bf16x2_t b = __builtin_convertvector(v, bf16x2_t); return __builtin_bit_cast(unsigned, b); }
__device__ __forceinline__ float silu_f(float v) { return v * __builtin_amdgcn_rcpf(1.0f + __expf(-v)); }

struct EpiStore2 {
    static constexpr bool PERM = true, AFTER_DRAIN = false;
    bf16_t* O0; int ld0; bf16_t* O1; int ld1; int split;
    __device__ __forceinline__ void operator()(const f32x4 (&acc)[2][2][4][2], const Unit& u, int wr, int wc, int fr, int fq) const {
        int colt = u.pn * BM; bf16_t* base = O0; int ld = ld0;
        if (colt >= split) { base = O1; ld = ld1; colt -= split; }
        const int row0 = u.pm * BM + wr * 64 + fr, col0 = colt + wc * 32 + 8 * fq;
#pragma unroll
        for (int ai = 0; ai < 2; ++ai)
#pragma unroll
            for (int m = 0; m < 4; ++m) { bf16_t* rowp = base + (size_t)(row0 + ai * HALF + m * 16) * ld + col0;
#pragma unroll
                for (int bj = 0; bj < 2; ++bj) { const f32x4 v0 = acc[ai][bj][m][0], v1 = acc[ai][bj][m][1];
                    u32x4 w; w.x = cvt_pk_bf16(v0[0], v0[1]); w.y = cvt_pk_bf16(v0[2], v0[3]); w.z = cvt_pk_bf16(v1[0], v1[1]); w.w = cvt_pk_bf16(v1[2], v1[3]);
                    *(u32x4*)(rowp + bj * HALF) = w; } }
    }
};
template <int ACT> struct EpiGate {
    static constexpr bool PERM = true, AFTER_DRAIN = false;
    bf16_t* P; int ldp; bf16_t* G; int ldg; int pn_plain;
    __device__ __forceinline__ void operator()(const f32x4 (&acc)[2][2][4][2], const Unit& u, int wr, int wc, int fr, int fq) const {
        const int row0 = u.pm * BM + wr * 64 + fr;
        if (u.pn < pn_plain) {
            const int col0 = u.pn * BM + wc * 32 + 8 * fq;
#pragma unroll
            for (int ai = 0; ai < 2; ++ai)
#pragma unroll
                for (int m = 0; m < 4; ++m) { bf16_t* rowp = P + (size_t)(row0 + ai * HALF + m * 16) * ldp + col0;
#pragma unroll
                    for (int bj = 0; bj < 2; ++bj) { const f32x4 v0 = acc[ai][bj][m][0], v1 = acc[ai][bj][m][1];
                        u32x4 w; w.x = cvt_pk_bf16(v0[0], v0[1]); w.y = cvt_pk_bf16(v0[2], v0[3]); w.z = cvt_pk_bf16(v1[0], v1[1]); w.w = cvt_pk_bf16(v1[2], v1[3]);
                        *(u32x4*)(rowp + bj * HALF) = w; } }
        } else {
            const int col0 = (u.pn - pn_plain) * HALF + wc * 32 + 8 * fq;
#pragma unroll
            for (int ai = 0; ai < 2; ++ai)
#pragma unroll
                for (int m = 0; m < 4; ++m) { bf16_t* rowp = G + (size_t)(row0 + ai * HALF + m * 16) * ldg + col0;
                    f32x4 a0 = acc[ai][0][m][0], a1 = acc[ai][0][m][1]; const f32x4 b0 = acc[ai][1][m][0], b1 = acc[ai][1][m][1];
                    if (ACT == 1) {
#pragma unroll
                        for (int e = 0; e < 4; ++e) { a0[e] = silu_f(a0[e]); a1[e] = silu_f(a1[e]); } }
                    a0 = a0 * b0; a1 = a1 * b1;
                    u32x4 w; w.x = cvt_pk_bf16(a0[0], a0[1]); w.y = cvt_pk_bf16(a0[2], a0[3]); w.z = cvt_pk_bf16(a1[0], a1[1]); w.w = cvt_pk_bf16(a1[2], a1[3]);
                    *(u32x4*)rowp = w; }
        }
    }
};

template <class Epi, class Sched, bool ALIGN_EPI = false, bool SP2 = false>
__device__ __forceinline__ void gemm_phase(PG8_LAS unsigned char* lds, const Gemm g, const Sched& S, const Epi& E) {
    int tid_o = threadIdx.x; asm volatile("" : "+v"(tid_o));
    const int tid = tid_o, wid = __builtin_amdgcn_readfirstlane(tid >> 6), lane = tid & 63, wr = wid >> 2, wc = wid & 3, fr = lane & 15, fq = lane >> 4;
    const int K = g.K, nt = K / BK;
    unsigned voffA[2], voffB[2];
#pragma unroll
    for (int i = 0; i < 2; ++i) { int R, C; stage_rc(tid * 16 + i * 8192, R, C); const int Rb = Epi::PERM ? ((R & ~31) + perm32(R & 31)) : R;
        voffA[i] = (unsigned)(R * K + C) * 2u; voffB[i] = (unsigned)(Rb * K + C) * 2u; }
    const size_t kstep = (size_t)(BK * 2);
    const size_t hstep = (size_t)HALF * K * 2;
    const size_t tstep = 2 * hstep;
    const unsigned ldsw = (unsigned)wid * 1024u;
    const int aoff = lds_byte(wr * 64 + fr, fq * 8), boff = lds_byte(wc * 32 + fr, fq * 8);
#define PG8_SA(b, h) (((b) * 2 + (h)) * HTB)
#define PG8_SB(b, h) ((4 + (b) * 2 + (h)) * HTB)
#define PG8_STAGE(bufoff, gbase, voff) do { _Pragma("unroll") for (int _i = 0; _i < 2; ++_i) \
        __builtin_amdgcn_global_load_lds((const unsigned*)((const char*)(gbase) + (voff)[_i]), (PG8_LAS unsigned*)(lds + (bufoff) + ldsw + _i * 8192), 16, 0, 0); } while (0)
#define PG8_LDA(dst, b, h) do { _Pragma("unroll") for (int m = 0; m < 4; ++m) _Pragma("unroll") for (int k = 0; k < 2; ++k) dst[m][k] = *(const PG8_LAS bf16x8*)(lds + PG8_SA(b, h) + aoff + m * 2048 + k * 1024); } while (0)
#define PG8_LDB(dst, b, h) do { _Pragma("unroll") for (int n = 0; n < 2; ++n) _Pragma("unroll") for (int k = 0; k < 2; ++k) dst[n][k] = *(const PG8_LAS bf16x8*)(lds + PG8_SB(b, h) + boff + n * 2048 + k * 1024); } while (0)
#define PG8_MMA(ai, bj, At, Bt) do { __builtin_amdgcn_s_setprio(1); _Pragma("unroll") for (int m = 0; m < 4; ++m) _Pragma("unroll") for (int n = 0; n < 2; ++n) _Pragma("unroll") for (int k = 0; k < 2; ++k) \
        acc[ai][bj][m][n] = __builtin_amdgcn_mfma_f32_16x16x32_bf16(Bt[n][k], At[m][k], acc[ai][bj][m][n], 0, 0, 0); __builtin_amdgcn_s_setprio(0); } while (0)
#define PG8_WAIT_V(n) asm volatile("s_waitcnt vmcnt(" #n ")" ::: "memory")
#define PG8_WAIT_L(n) asm volatile("s_waitcnt lgkmcnt(" #n ")" ::: "memory")
#define PG8_BAR __builtin_amdgcn_s_barrier()
#define PG8_SCHED __builtin_amdgcn_sched_barrier(0)
    Unit cur, nxt; int ui = 0;
    if (!S.next(0, cur)) return;
    f32x4 acc[2][2][4][2];
#pragma unroll
    for (int a = 0; a < 2; ++a)
#pragma unroll
        for (int b = 0; b < 2; ++b)
#pragma unroll
            for (int m = 0; m < 4; ++m)
#pragma unroll
                for (int n = 0; n < 2; ++n) acc[a][b][m][n] = (f32x4){0.f, 0.f, 0.f, 0.f};
    bf16x8 At[4][2], B0[2][2], B1[2][2];
    const char* cA = (const char*)g.A + (size_t)cur.pm * tstep; const char* cB = (const char*)g.Bt + (size_t)cur.pn * tstep;
    S.a_ready(cur);
    if constexpr (SP2) {
        PG8_STAGE(PG8_SB(0, 0), cB, voffB); PG8_STAGE(PG8_SB(0, 1), cB + hstep, voffB); PG8_STAGE(PG8_SA(0, 0), cA, voffA); PG8_STAGE(PG8_SA(0, 1), cA + hstep, voffA);
        if (wr == 1) PG8_BAR;
        PG8_WAIT_V(2); PG8_BAR;
        PG8_STAGE(PG8_SB(1, 0), cB + kstep, voffB); PG8_STAGE(PG8_SA(1, 0), cA + kstep, voffA); PG8_STAGE(PG8_SB(1, 1), cB + hstep + kstep, voffB);
        PG8_WAIT_V(6); PG8_BAR;
    } else {
        PG8_STAGE(PG8_SB(0, 0), cB, voffB); PG8_STAGE(PG8_SA(0, 0), cA, voffA); PG8_STAGE(PG8_SB(0, 1), cB + hstep, voffB); PG8_STAGE(PG8_SA(0, 1), cA + hstep, voffA);
        if (wr == 1) PG8_BAR;
        PG8_WAIT_V(4); PG8_BAR;
        PG8_STAGE(PG8_SB(1, 0), cB + kstep, voffB); PG8_STAGE(PG8_SA(1, 0), cA + kstep, voffA); PG8_STAGE(PG8_SB(1, 1), cB + hstep + kstep, voffB);
        PG8_WAIT_V(6); PG8_BAR;
    }
    for (;;) {
        const bool has_next = S.next(ui + 1, nxt);
        const char* nA = has_next ? (const char*)g.A + (size_t)nxt.pm * tstep : cA; const char* nB = has_next ? (const char*)g.Bt + (size_t)nxt.pn * tstep : cB;
        for (int t = 0; t < nt; t += 2) {
            const bool last = (t == nt - 2);
            const char* a1 = cA + (size_t)(t + 1) * kstep;
            const char* a2 = last ? nA : cA + (size_t)(t + 2) * kstep; const char* b2 = last ? nB : cB + (size_t)(t + 2) * kstep;
            const char* a3 = a2 + kstep; const char* b3 = b2 + kstep;
            if (last && has_next) S.a_ready(nxt);
            if constexpr (SP2) {
            PG8_LDB(B0, 0, 0); PG8_LDB(B1, 0, 1); PG8_SCHED; PG8_LDA(At, 0, 0); PG8_STAGE(PG8_SA(1, 1), a1 + hstep, voffA);
            PG8_WAIT_V(8); PG8_WAIT_L(0); PG8_BAR; PG8_MMA(0, 0, At, B0); PG8_MMA(0, 1, At, B1); PG8_BAR; PG8_SCHED;
            PG8_LDA(At, 0, 1); PG8_STAGE(PG8_SB(0, 0), b2, voffB); PG8_STAGE(PG8_SB(0, 1), b2 + hstep, voffB); PG8_STAGE(PG8_SA(0, 0), a2, voffA);
            PG8_WAIT_V(8); PG8_WAIT_L(0); PG8_BAR; PG8_MMA(1, 0, At, B0); PG8_MMA(1, 1, At, B1); PG8_BAR; PG8_SCHED;
            PG8_LDB(B0, 1, 0); PG8_LDB(B1, 1, 1); PG8_SCHED; PG8_LDA(At, 1, 0); PG8_STAGE(PG8_SA(0, 1), a2 + hstep, voffA);
            PG8_WAIT_V(8); PG8_WAIT_L(0); PG8_BAR; PG8_MMA(0, 0, At, B0); PG8_MMA(0, 1, At, B1); PG8_BAR; PG8_SCHED;
            PG8_LDA(At, 1, 1); PG8_STAGE(PG8_SB(1, 0), b3, voffB); PG8_STAGE(PG8_SB(1, 1), b3 + hstep, voffB); PG8_STAGE(PG8_SA(1, 0), a3, voffA);
            PG8_WAIT_V(8); PG8_WAIT_L(0); PG8_BAR; PG8_MMA(1, 0, At, B0); PG8_MMA(1, 1, At, B1); PG8_BAR; PG8_SCHED;
            } else {
            PG8_LDB(B0, 0, 0); PG8_SCHED; PG8_LDA(At, 0, 0); PG8_STAGE(PG8_SA(1, 1), a1 + hstep, voffA);
            PG8_WAIT_L(8); PG8_BAR; PG8_WAIT_L(0); PG8_MMA(0, 0, At, B0); PG8_BAR; PG8_SCHED;
            PG8_LDB(B1, 0, 1); PG8_STAGE(PG8_SB(0, 0), b2, voffB);
            PG8_BAR; PG8_WAIT_L(0); PG8_MMA(0, 1, At, B1); PG8_BAR;
            PG8_LDA(At, 0, 1); PG8_STAGE(PG8_SA(0, 0), a2, voffA);
            PG8_BAR; PG8_WAIT_L(0); PG8_MMA(1, 0, At, B0); PG8_BAR; PG8_SCHED;
            PG8_STAGE(PG8_SB(0, 1), b2 + hstep, voffB);
            PG8_WAIT_V(6); PG8_BAR; PG8_MMA(1, 1, At, B1); PG8_BAR;
            PG8_LDB(B0, 1, 0); PG8_SCHED; PG8_LDA(At, 1, 0); PG8_STAGE(PG8_SA(0, 1), a2 + hstep, voffA);
            PG8_WAIT_L(8); PG8_BAR; PG8_WAIT_L(0); PG8_MMA(0, 0, At, B0); PG8_BAR; PG8_SCHED;
            PG8_LDB(B1, 1, 1); PG8_STAGE(PG8_SB(1, 0), b3, voffB);
            PG8_BAR; PG8_WAIT_L(0); PG8_MMA(0, 1, At, B1); PG8_BAR;
            PG8_LDA(At, 1, 1); PG8_STAGE(PG8_SA(1, 0), a3, voffA);
            PG8_BAR; PG8_WAIT_L(0); PG8_MMA(1, 0, At, B0); PG8_BAR; PG8_SCHED;
            PG8_STAGE(PG8_SB(1, 1), b3 + hstep, voffB);
            PG8_WAIT_V(6); PG8_BAR; PG8_MMA(1, 1, At, B1); PG8_BAR;
            }
        }
        if constexpr (ALIGN_EPI) { if (wr == 0) PG8_BAR; }
        if constexpr (!Epi::AFTER_DRAIN) { E(acc, cur, wr, wc, fr, fq); S.done(cur); }
        if (!has_next) break;
#pragma unroll
        for (int a = 0; a < 2; ++a)
#pragma unroll
            for (int b = 0; b < 2; ++b)
#pragma unroll
                for (int m = 0; m < 4; ++m)
#pragma unroll
                    for (int n = 0; n < 2; ++n) acc[a][b][m][n] = (f32x4){0.f, 0.f, 0.f, 0.f};
        cur = nxt; cA = nA; cB = nB; ++ui;
        if constexpr (ALIGN_EPI) { if (wr == 1) PG8_BAR; }
    }
    PG8_WAIT_V(0);
    if constexpr (!ALIGN_EPI) { if (wr == 0) PG8_BAR; }
    PG8_BAR;
    if constexpr (Epi::AFTER_DRAIN) { E.fused(acc, cur, wr, wc, fr, fq, lds, wid, lane); S.done(cur); }
#undef PG8_SA
#undef PG8_SB
#undef PG8_STAGE
#undef PG8_LDA
#undef PG8_LDB
#undef PG8_MMA
#undef PG8_WAIT_V
#undef PG8_WAIT_L
#undef PG8_BAR
#undef PG8_SCHED
}
}

#ifndef PG8_SP2
#define PG8_SP2 true
#endif
#ifndef PG8_ALIGN
#define PG8_ALIGN true
#endif
#ifndef MK_PER_PHASE
#define MK_PER_PHASE 0
#endif

constexpr int NWAVES = 8;
constexpr int DM = 2048, BATCH = 2, SEQ = 8192, M = BATCH * SEQ, DEPTH = 4;
constexpr int HD = 128, HK = 16, HV = 32, KDIM = 2048, VDIM = 4096, QKV = 8192;
constexpr int DNP = 12352, DNP_MAIN = 12288;
constexpr int FF = 5632;
constexpr float LN_EPS = 1e-5f, RMS_EPS = 1e-6f;
constexpr float ALPHA = 1.6817928305074290f;
#ifndef DN_CHUNKED
#define DN_CHUNKED 1
#endif
constexpr int N_PHASES = 35;

constexpr size_t MiB = 1u << 20;
constexpr size_t WS_CTL = 0, CTL_ZERO_BYTES = 1 * MiB;
constexpr size_t WS_W_SCIN = 1 * MiB;
constexpr size_t WS_W_SCOUT = WS_W_SCIN + 48 * MiB;
constexpr size_t WS_W_DNIN = WS_W_SCOUT + 16 * MiB;
constexpr size_t WS_W_BA = WS_W_DNIN + 96 * MiB;
constexpr size_t WS_W_DNOUT = WS_W_BA + 1 * MiB;
constexpr size_t WS_W_GU = WS_W_DNOUT + 32 * MiB;
constexpr size_t WS_W_DOWN = WS_W_GU + 176 * MiB;
constexpr size_t WS_XB = WS_W_DOWN + 88 * MiB;
constexpr size_t WS_BIGA = WS_XB + 64 * MiB;
constexpr size_t WS_QKV = WS_BIGA, WS_Z = WS_BIGA + 256 * MiB, WS_O = WS_BIGA;
constexpr size_t WS_GB = WS_BIGA, WS_CU = WS_BIGA + 64 * MiB, WS_A2 = WS_BIGA + 128 * MiB, WS_HID = WS_BIGA;
constexpr size_t WS_BIGB = WS_BIGA + 384 * MiB;
constexpr size_t WS_QC = WS_BIGB, WS_KC = WS_BIGB + 64 * MiB, WS_VC = WS_BIGB + 128 * MiB, WS_A3 = WS_BIGB + 256 * MiB, WS_H1 = WS_BIGB;
constexpr size_t WS_BA = WS_BIGB + 384 * MiB;
constexpr size_t WS_BETA = WS_BA + 4 * MiB, WS_DEC = WS_BETA + 2 * MiB;
constexpr size_t WS_GL = WS_DEC + 2 * MiB;
constexpr size_t WS_KF = WS_GL + 2 * MiB;
constexpr size_t WS_SC = WS_KF + 64 * MiB;
constexpr size_t WS_END = WS_SC + 8 * MiB;
constexpr size_t WS_WF = WS_BIGA, WS_UF = WS_BIGA + 128 * MiB, WS_QF = WS_BIGB + 256 * MiB, WS_AQKF = WS_BIGB + 320 * MiB;
constexpr size_t WS_O2 = WS_BIGB;
static_assert(WS_END <= (size_t)1476395008ull, "d_ws map exceeds the guaranteed workspace");
constexpr int CW_BAR = 4096;

constexpr int RING_OFF = 0, RING_BYTES = 131072;
constexpr int LDSCTL_OFF = RING_BYTES, MISC_OFF = LDSCTL_OFF + 320, PTAB_OFF = LDSCTL_OFF + 1024;
constexpr int LDS_BYTES = 147456;

#define GAS __attribute__((address_space(1)))
#define LAS __attribute__((address_space(3)))
typedef unsigned short bf16;
typedef unsigned v4u __attribute__((ext_vector_type(4)));
typedef unsigned v2u __attribute__((ext_vector_type(2)));
typedef float f32x4 __attribute__((ext_vector_type(4)));
typedef float f32x16 __attribute__((ext_vector_type(16)));
typedef short bf16x8 __attribute__((ext_vector_type(8)));
typedef GAS unsigned gu32;
#define RLX_AGENT __ATOMIC_RELAXED, __HIP_MEMORY_SCOPE_AGENT
#define LDS_WAIT() asm volatile("s_waitcnt lgkmcnt(0)" ::: "memory")
#define VM_WAIT() asm volatile("s_waitcnt vmcnt(0)" ::: "memory")
__device__ __forceinline__ unsigned pk2(float lo, float hi) { return pg8::cvt_pk_bf16(lo, hi); }
__device__ __forceinline__ float bf_lo(unsigned w) { return __uint_as_float(w << 16); }
__device__ __forceinline__ float bf_hi(unsigned w) { return __uint_as_float(w & 0xffff0000u); }
__device__ __forceinline__ float silu_f(float v) { return v * __builtin_amdgcn_rcpf(1.0f + __expf(-v)); }
#define XB_TMO      128
#define XB_XCNT(j)  (256  + 64 * (j))
#define XB_XSUB(j)  (1280 + 64 * (j))
#define XB_XGEN(j)  (2304 + 64 * (j))
#define XB_TOP      3328
#define XB_TOPGEN   3392
#define XCD_BAR_WORDS 3456
#define XB_SPIN_CAP (1u << 21)

__device__ __forceinline__ unsigned xb_ld(unsigned* p)              { return __hip_atomic_load(p, __ATOMIC_RELAXED, __HIP_MEMORY_SCOPE_AGENT); }
__device__ __forceinline__ unsigned xb_add(unsigned* p, unsigned v) { return __hip_atomic_fetch_add(p, v, __ATOMIC_RELAXED, __HIP_MEMORY_SCOPE_AGENT); }
__device__ __forceinline__ unsigned xb_xcc_id() { return (unsigned)__builtin_amdgcn_s_getreg((3 << 11) | 20) & 0xFu; }
#define XB_SPIN(cond, bar) do { unsigned _sp = 0; while (cond) { __builtin_amdgcn_s_sleep(1); \
    if ((++_sp & 255u) == 0u) { if (xb_ld(&(bar)[XB_TMO])) break; if (_sp > XB_SPIN_CAP) { atomicAdd(&(bar)[XB_TMO], 1u); break; } } } } while (0)

struct XcdBarrier {
    unsigned* bar; unsigned x;
    volatile LAS unsigned* st;
};

__device__ __forceinline__ XcdBarrier xcd_barrier_post(unsigned* bar, volatile LAS unsigned* st) {
    XcdBarrier b; b.bar = bar; b.x = xb_xcc_id(); b.st = st;
    if (threadIdx.x == 0) (void)xb_add(&bar[XB_XCNT(b.x)], 1u);
    return b;
}
__device__ __forceinline__ void xcd_barrier_complete(unsigned* bar, unsigned x, unsigned& nloc, unsigned& nx) {
    const unsigned G = gridDim.x * gridDim.y * gridDim.z;
    unsigned sum, cnt, mine, sp = 0u;
    for (;;) {
        sum = 0u; cnt = 0u; mine = 0u;
#pragma unroll
        for (unsigned j = 0; j < 16; ++j) { const unsigned c = xb_ld(&bar[XB_XCNT(j)]); sum += c; cnt += (c > 0u) ? 1u : 0u; mine = (j == x) ? c : mine; }
        if (sum == G) break;
        __builtin_amdgcn_s_sleep(1);
        if ((++sp & 255u) == 0u) { if (xb_ld(&bar[XB_TMO])) break; if (sp > XB_SPIN_CAP) { atomicAdd(&bar[XB_TMO], 1u); break; } }
    }
    nloc = mine > 0u ? mine : 1u; nx = cnt > 0u ? cnt : 1u;
}

__device__ __forceinline__ void xcd_barrier(const XcdBarrier& b) {
    asm volatile("s_waitcnt vmcnt(0)" ::: "memory");
    __syncthreads();
    if (threadIdx.x == 0) {
        unsigned* bar = b.bar;
        __builtin_amdgcn_s_waitcnt(0);
        unsigned nloc = b.st[0], nx = b.st[1];
        if (nloc == 0u) { xcd_barrier_complete(bar, b.x, nloc, nx); b.st[0] = nloc; b.st[1] = nx; }
        const unsigned old = xb_add(&bar[XB_XSUB(b.x)], 1u);
        const unsigned gen = old / nloc;
        if (old + 1u == (gen + 1u) * nloc) {
            __builtin_amdgcn_fence(__ATOMIC_RELEASE, "agent");
            asm volatile("s_waitcnt vmcnt(0)" ::: "memory");
            const unsigned og = xb_add(&bar[XB_TOP], 1u);
            const unsigned tg = og / nx;
            if (og + 1u == (tg + 1u) * nx) xb_add(&bar[XB_TOPGEN], 1u);
            else XB_SPIN(xb_ld(&bar[XB_TOPGEN]) == tg, bar);
            __builtin_amdgcn_fence(__ATOMIC_ACQUIRE, "agent");
            xb_add(&bar[XB_XGEN(b.x)], 1u);
            asm volatile("s_waitcnt vmcnt(0)" ::: "memory");
        } else {
            XB_SPIN(xb_ld(&bar[XB_XGEN(b.x)]) == gen, bar);
            __builtin_amdgcn_fence(__ATOMIC_ACQUIRE, "agent");
            asm volatile("s_waitcnt vmcnt(0)" ::: "memory");
        }
    }
    __syncthreads();
}

__device__ __forceinline__ float wave_sum(float v) {
#pragma unroll
    for (int o = 1; o < 64; o <<= 1) v += __shfl_xor(v, o);
    return v;
}
__device__ __forceinline__ float sum16(float v) {
    v += __shfl_xor(v, 1); v += __shfl_xor(v, 2); v += __shfl_xor(v, 4); v += __shfl_xor(v, 8);
    return v;
}
template <int CTRL> __device__ __forceinline__ float dppf(float v) { return __builtin_bit_cast(float, __builtin_amdgcn_update_dpp(0, __builtin_bit_cast(int, v), CTRL, 0xF, 0xF, false)); }
__device__ __forceinline__ float rowsum16(float v) {
    v += dppf<0x128>(v); v += dppf<0x124>(v); v += dppf<0x122>(v); v += dppf<0x121>(v);
    return v;
}
__device__ __forceinline__ void unpack8(const v4u w, float (&f)[8]) {
    f[0] = bf_lo(w.x); f[1] = bf_hi(w.x); f[2] = bf_lo(w.y); f[3] = bf_hi(w.y); f[4] = bf_lo(w.z); f[5] = bf_hi(w.z); f[6] = bf_lo(w.w); f[7] = bf_hi(w.w);
}
__device__ __forceinline__ v4u pack8(const float (&f)[8]) { v4u o; o.x = pk2(f[0], f[1]); o.y = pk2(f[2], f[3]); o.z = pk2(f[4], f[5]); o.w = pk2(f[6], f[7]); return o; }

__device__ __forceinline__ void p0_transpose_item(const float* W, int ldw, int src_col0, bf16* WT, int K, int dst_row0, int k0, LAS float* scr, int lane) {
    float tv[32];
#pragma unroll
    for (int i = 0; i < 32; ++i) tv[i] = W[(size_t)(k0 + 2 * i + (lane >> 5)) * ldw + src_col0 + (lane & 31)];
#pragma unroll
    for (int i = 0; i < 32; ++i) scr[(2 * i + (lane >> 5)) * 33 + (lane & 31)] = tv[i];
    LDS_WAIT(); asm volatile("" ::: "memory");
    const int c = lane & 7;
#pragma unroll
    for (int j = 0; j < 4; ++j) { const int n = (lane >> 3) + 8 * j; const LAS float* s = scr + (8 * c) * 33 + n;
        v4u o; o.x = pk2(s[0 * 33], s[1 * 33]); o.y = pk2(s[2 * 33], s[3 * 33]); o.z = pk2(s[4 * 33], s[5 * 33]); o.w = pk2(s[6 * 33], s[7 * 33]);
        *(GAS v4u*)(WT + (size_t)(dst_row0 + n) * K + k0 + 8 * c) = o; }
    LDS_WAIT(); asm volatile("" ::: "memory");
}

struct Ptrs {
    const float *x, *sc_w_in, *sc_conv_w, *sc_w_out, *dn_w_in, *dn_conv_w, *dn_a_log, *dn_dt_bias, *dn_norm_w, *dn_w_out, *ffn_gu, *ffn_down, *ln_gain, *ln_bias;
    float* out; unsigned char* ws;
};

__device__ __forceinline__ void p0_prologue(const Ptrs& P, LAS unsigned char* lds, int gw, int NGW, int wave, int lane) {
    LAS float* scr = (LAS float*)(lds + RING_OFF + wave * 16384);
    constexpr int I_SCIN = 32 * 192, I_SCOUT = 32 * 64, I_DNIN = 32 * 384, I_BA = 32 * 2, I_DNOUT = 64 * 64, I_GU = 32 * 352, I_DOWN = 88 * 64;
    constexpr int NITEMS = 2 * (I_SCIN + I_SCOUT + I_DNIN + I_BA + I_DNOUT) + 4 * (I_GU + I_DOWN);
    for (int it = gw; it < NITEMS; it += NGW) {
        int r = it; const float* W; int ldw, K, nblk, mode; bf16* WT; int layer;
        if (r < 2 * I_SCIN) { layer = r / I_SCIN; r -= layer * I_SCIN; W = P.sc_w_in + (size_t)layer * DM * 3 * DM; ldw = 3 * DM; K = DM; nblk = 192; mode = 1; WT = (bf16*)(P.ws + WS_W_SCIN) + (size_t)layer * 3 * DM * DM; }
        else { r -= 2 * I_SCIN;
        if (r < 2 * I_SCOUT) { layer = r / I_SCOUT; r -= layer * I_SCOUT; W = P.sc_w_out + (size_t)layer * DM * DM; ldw = DM; K = DM; nblk = 64; mode = 0; WT = (bf16*)(P.ws + WS_W_SCOUT) + (size_t)layer * DM * DM; }
        else { r -= 2 * I_SCOUT;
        if (r < 2 * I_DNIN) { layer = r / I_DNIN; r -= layer * I_DNIN; W = P.dn_w_in + (size_t)layer * DM * DNP; ldw = DNP; K = DM; nblk = 384; mode = 0; WT = (bf16*)(P.ws + WS_W_DNIN) + (size_t)layer * DNP_MAIN * DM; }
        else { r -= 2 * I_DNIN;
        if (r < 2 * I_BA) { layer = r / I_BA; r -= layer * I_BA; W = P.dn_w_in + (size_t)layer * DM * DNP; ldw = DNP; K = DM; nblk = 2; mode = 3; WT = (bf16*)(P.ws + WS_W_BA) + (size_t)layer * 64 * DM; }
        else { r -= 2 * I_BA;
        if (r < 2 * I_DNOUT) { layer = r / I_DNOUT; r -= layer * I_DNOUT; W = P.dn_w_out + (size_t)layer * VDIM * DM; ldw = DM; K = VDIM; nblk = 64; mode = 0; WT = (bf16*)(P.ws + WS_W_DNOUT) + (size_t)layer * DM * VDIM; }
        else { r -= 2 * I_DNOUT;
        if (r < 4 * I_GU) { layer = r / I_GU; r -= layer * I_GU; W = P.ffn_gu + (size_t)layer * DM * 2 * FF; ldw = 2 * FF; K = DM; nblk = 352; mode = 2; WT = (bf16*)(P.ws + WS_W_GU) + (size_t)layer * 2 * FF * DM; }
        else { r -= 4 * I_GU; layer = r / I_DOWN; r -= layer * I_DOWN; W = P.ffn_down + (size_t)layer * FF * DM; ldw = DM; K = FF; nblk = 64; mode = 0; WT = (bf16*)(P.ws + WS_W_DOWN) + (size_t)layer * DM * FF; } } } } } }
        const int kb = r / nblk, nb = r % nblk, n0 = 32 * nb;
        int src;
        if (mode == 0) src = n0;
        else if (mode == 1) { if (n0 < DM) src = n0; else { const int n2 = n0 - DM; src = DM + ((n2 >> 7) & 1) * DM + (n2 >> 8) * 128 + (n2 & 127); } }
        else if (mode == 2) src = ((n0 >> 7) & 1) * FF + (n0 >> 8) * 128 + (n0 & 127);
        else src = DNP_MAIN + n0;
        p0_transpose_item(W, ldw, src, WT, K, n0, 64 * kb, scr, lane);
    }
    bf16* XB = (bf16*)(P.ws + WS_XB);
    for (int m = gw; m < M; m += NGW) {
        const GAS f32x4* xr = (const GAS f32x4*)(P.x + (size_t)m * DM) + lane;
        GAS v2u* o8 = (GAS v2u*)(XB + (size_t)m * DM) + lane;
#pragma unroll
        for (int j = 0; j < 8; ++j) { const f32x4 v = xr[64 * j]; v2u o; o.x = pk2(v.x, v.y); o.y = pk2(v.z, v.w); o8[64 * j] = o; }
    }
}

__device__ __forceinline__ void ln_phase(const float* xin, const bf16* H, const float* gain, const float* bias, float* xout, bf16* XB, int gw, int NGW, int lane) {
    f32x4 g[8], bb[8];
#pragma unroll
    for (int j = 0; j < 8; ++j) { g[j] = ((const GAS f32x4*)gain)[lane + 64 * j]; bb[j] = ((const GAS f32x4*)bias)[lane + 64 * j]; }
    for (int m = gw; m < M; m += NGW) {
        const GAS f32x4* xr = (const GAS f32x4*)(xin + (size_t)m * DM) + lane;
        const GAS v2u* hr = (const GAS v2u*)(H + (size_t)m * DM) + lane;
        f32x4 v[8]; float s = 0.f;
#pragma unroll
        for (int j = 0; j < 8; ++j) { const f32x4 xv = xr[64 * j]; const v2u hv = hr[64 * j];
            v[j].x = ALPHA * xv.x + bf_lo(hv.x); v[j].y = ALPHA * xv.y + bf_hi(hv.x); v[j].z = ALPHA * xv.z + bf_lo(hv.y); v[j].w = ALPHA * xv.w + bf_hi(hv.y);
            s += (v[j].x + v[j].y) + (v[j].z + v[j].w); }
        const float mean = wave_sum(s) * (1.f / DM); float s2 = 0.f;
#pragma unroll
        for (int j = 0; j < 8; ++j) { v[j] = v[j] - mean; s2 += (v[j].x * v[j].x + v[j].y * v[j].y) + (v[j].z * v[j].z + v[j].w * v[j].w); }
        const float rstd = 1.f / sqrtf(wave_sum(s2) * (1.f / DM) + LN_EPS);
        GAS f32x4* xo = (GAS f32x4*)(xout + (size_t)m * DM) + lane;
        GAS v2u* bo = (GAS v2u*)(XB + (size_t)m * DM) + lane;
#pragma unroll
        for (int j = 0; j < 8; ++j) { const f32x4 o = v[j] * rstd * g[j] + bb[j]; xo[64 * j] = o; v2u w; w.x = pk2(o.x, o.y); w.y = pk2(o.z, o.w); bo[64 * j] = w; }
    }
}

__device__ __forceinline__ void sc_conv_phase(const bf16* GB, const bf16* CU, const float* cw  , bf16* A2, int gt, int NGT) {
    constexpr int RB = 16, NCG = DM / 8, NITEMS = (M / RB) * NCG;
    for (int it = gt; it < NITEMS; it += NGT) {
        const int cgp = it % NCG, rb = it / NCG, c0 = cgp * 8, r0 = rb * RB;
        float w0[8], w1[8], w2[8];
#pragma unroll
        for (int e = 0; e < 8; e += 4) { const f32x4 a = *(const GAS f32x4*)(cw + c0 + e), b = *(const GAS f32x4*)(cw + DM + c0 + e), c = *(const GAS f32x4*)(cw + 2 * DM + c0 + e);
            w0[e] = a.x; w0[e + 1] = a.y; w0[e + 2] = a.z; w0[e + 3] = a.w; w1[e] = b.x; w1[e + 1] = b.y; w1[e + 2] = b.z; w1[e + 3] = b.w; w2[e] = c.x; w2[e + 1] = c.y; w2[e + 2] = c.z; w2[e + 3] = c.w; }
        float um2[8], um1[8];
        const bool first = (r0 % SEQ) == 0;
        if (first) {
#pragma unroll
            for (int e = 0; e < 8; ++e) { um2[e] = 0.f; um1[e] = 0.f; } }
        else { unpack8(*(const GAS v4u*)(CU + (size_t)(r0 - 2) * DM + c0), um2); unpack8(*(const GAS v4u*)(CU + (size_t)(r0 - 1) * DM + c0), um1); }
#pragma unroll 4
        for (int r = 0; r < RB; ++r) {
            float u0[8], gb[8], o[8];
            unpack8(*(const GAS v4u*)(CU + (size_t)(r0 + r) * DM + c0), u0);
            unpack8(*(const GAS v4u*)(GB + (size_t)(r0 + r) * DM + c0), gb);
#pragma unroll
            for (int e = 0; e < 8; ++e) { o[e] = gb[e] * (w0[e] * um2[e] + w1[e] * um1[e] + w2[e] * u0[e]); um2[e] = um1[e]; um1[e] = u0[e]; }
            *(GAS v4u*)(A2 + (size_t)(r0 + r) * DM + c0) = pack8(o);
        }
    }
}

__device__ __forceinline__ void dn_pre_phase(const bf16* QKVr, const float* cw  , bf16* QC, bf16* KC, bf16* VC, const float* BA, const float* a_log, const float* dt_bias, float* BETA, float* DEC, float* GL,
                                             int gw, int NGW, int lane, int gt, int NGT) {
    constexpr int RB = 8, NCG = QKV / 512, NITEMS = (M / RB) * NCG;
    for (int it = gw; it < NITEMS; it += NGW) {
        const int cgp = it % NCG, rb = it / NCG, c0 = cgp * 512 + lane * 8, r0 = rb * RB;
        float w[4][8];
#pragma unroll
        for (int j = 0; j < 4; ++j)
#pragma unroll
            for (int e = 0; e < 8; e += 4) { const f32x4 a = *(const GAS f32x4*)(cw + (size_t)j * QKV + c0 + e); w[j][e] = a.x; w[j][e + 1] = a.y; w[j][e + 2] = a.z; w[j][e + 3] = a.w; }
        float h3[8], h2[8], h1[8];
        const bool first = (r0 % SEQ) == 0;
        if (first) {
#pragma unroll
            for (int e = 0; e < 8; ++e) { h3[e] = 0.f; h2[e] = 0.f; h1[e] = 0.f; } }
        else { unpack8(*(const GAS v4u*)(QKVr + (size_t)(r0 - 3) * QKV + c0), h3); unpack8(*(const GAS v4u*)(QKVr + (size_t)(r0 - 2) * QKV + c0), h2); unpack8(*(const GAS v4u*)(QKVr + (size_t)(r0 - 1) * QKV + c0), h1); }
        bf16* dst; int ldd, cd; float qs = 1.f; bool norm;
        if (c0 < KDIM) { dst = QC; ldd = KDIM; cd = c0; norm = true; qs = 0.08838834764831845f; }
        else if (c0 < 2 * KDIM) { dst = KC; ldd = KDIM; cd = c0 - KDIM; norm = true; }
        else { dst = VC; ldd = VDIM; cd = c0 - 2 * KDIM; norm = false; }
        v4u rowv[RB];
#pragma unroll
        for (int r = 0; r < RB; ++r) rowv[r] = *(const GAS v4u*)(QKVr + (size_t)(r0 + r) * QKV + c0);
#pragma unroll
        for (int r = 0; r < RB; ++r) {
            float u0[8], o[8]; float ss = 0.f;
            unpack8(rowv[r], u0);
#pragma unroll
            for (int e = 0; e < 8; ++e) { const float c = w[0][e] * h3[e] + w[1][e] * h2[e] + w[2][e] * h1[e] + w[3][e] * u0[e]; o[e] = silu_f(c); ss += o[e] * o[e]; h3[e] = h2[e]; h2[e] = h1[e]; h1[e] = u0[e]; }
            if (norm) { ss = sum16(ss); const float sc = qs / sqrtf(ss + RMS_EPS);
#pragma unroll
                for (int e = 0; e < 8; ++e) o[e] *= sc; }
            *(GAS v4u*)(dst + (size_t)(r0 + r) * ldd + cd) = pack8(o);
        }
    }
    for (int i = gt; i < M * HV; i += NGT) {
        const int hv = i & (HV - 1), row = i >> 5;
        const float br = BA[(size_t)row * 64 + hv], ar = BA[(size_t)row * 64 + HV + hv];
        const float xx = ar + dt_bias[hv];
        const float sp = fmaxf(xx, 0.f) + log1pf(__expf(-fabsf(xx)));
        const float gg = -__expf(a_log[hv]) * sp;
        BETA[i] = 1.f / (1.f + __expf(-br));
        DEC[i] = __expf(gg);
        GL[i] = gg;
    }
}

__device__ __forceinline__ void ba_phase(const bf16* XB, const bf16* Wba, float* BA, LAS unsigned char* lds, int unit, int wave, int lane) {
    const int mt = wave & 1, nt = (wave >> 1) & 1, kh = wave >> 2, r = lane & 31, h = lane >> 5;
    const bf16* ap = XB + (size_t)(unit * 64 + mt * 32 + r) * DM + kh * 1024 + 8 * h;
    const bf16* bp = Wba + (size_t)(nt * 32 + r) * DM + kh * 1024 + 8 * h;
    f32x16 acc = {};
#pragma unroll 8
    for (int ks = 0; ks < 64; ++ks) {
        const bf16x8 a = *(const GAS bf16x8*)(ap + ks * 16), b = *(const GAS bf16x8*)(bp + ks * 16);
        acc = __builtin_amdgcn_mfma_f32_32x32x16_bf16(a, b, acc, 0, 0, 0);
    }
    LAS float* red = (LAS float*)(lds + RING_OFF);
    if (kh == 1) {
#pragma unroll
        for (int i = 0; i < 16; ++i) red[((wave - 4) * 16 + i) * 64 + lane] = acc[i]; }
    __syncthreads();
    if (kh == 0) {
#pragma unroll
        for (int i = 0; i < 16; ++i) { const float v = acc[i] + red[(wave * 16 + i) * 64 + lane];
            const int row = unit * 64 + mt * 32 + (i & 3) + 8 * (i >> 2) + 4 * h;
            BA[(size_t)row * 64 + nt * 32 + r] = v; } }
    __syncthreads();
}

__device__ __forceinline__ void dn_naive_phase(const bf16* QC, const bf16* KC, const bf16* VC, const float* BETA, const float* DEC, float* O, LAS unsigned char* lds, int unit, int tid) {
    constexpr int CT = 32, NCH = SEQ / CT;
    constexpr int BUF = 16384 + 16384 + 4096 + 256;
    const int bh = unit >> 2, vq = unit & 3, b = bh >> 5, hv = bh & 31, hk = hv >> 1;
    const int vl = tid >> 4, p = tid & 15;
    LAS float* ob = (LAS float*)(lds + 2 * BUF);
    const size_t row0 = (size_t)b * SEQ;
    const int lr = tid >> 4, lp = tid & 15;
    const bf16* qsrc = QC + (row0 + lr) * KDIM + hk * HD + lp * 8;
    const bf16* ksrc = KC + (row0 + lr) * KDIM + hk * HD + lp * 8;
    const int vr = (tid & 127) >> 2, vp = tid & 3;
    const bf16* vsrc = VC + (row0 + vr) * VDIM + hv * HD + vq * 32 + vp * 8;
    const float* gsrc = (tid < 32 ? BETA : DEC) + (row0 + (tid & 31)) * HV + hv;
    v4u rq, rk, rv = {0u, 0u, 0u, 0u}; float rg = 0.f;
    rq = *(const GAS v4u*)qsrc; rk = *(const GAS v4u*)ksrc; if (tid < 128) rv = *(const GAS v4u*)vsrc; if (tid < 64) rg = *gsrc;
    float S[8];
#pragma unroll
    for (int i = 0; i < 8; ++i) S[i] = 0.f;
    for (int c = 0; c < NCH; ++c) {
        LAS unsigned char* buf = lds + (c & 1) * BUF;
        { float f[8]; unpack8(rq, f); LAS f32x4* d = (LAS f32x4*)(buf + (lr * 128 + lp * 8) * 4); d[0] = (f32x4){f[0], f[1], f[2], f[3]}; d[1] = (f32x4){f[4], f[5], f[6], f[7]};
          unpack8(rk, f); d = (LAS f32x4*)(buf + 16384 + (lr * 128 + lp * 8) * 4); d[0] = (f32x4){f[0], f[1], f[2], f[3]}; d[1] = (f32x4){f[4], f[5], f[6], f[7]};
          if (tid < 128) { unpack8(rv, f); d = (LAS f32x4*)(buf + 32768 + (vr * 32 + vp * 8) * 4); d[0] = (f32x4){f[0], f[1], f[2], f[3]}; d[1] = (f32x4){f[4], f[5], f[6], f[7]}; }
          if (tid < 64) ((LAS float*)(buf + 36864))[tid] = rg; }
        __syncthreads();
        if (c + 1 < NCH) { const size_t adv = (size_t)(c + 1) * CT;
            rq = *(const GAS v4u*)(qsrc + adv * KDIM); rk = *(const GAS v4u*)(ksrc + adv * KDIM); if (tid < 128) rv = *(const GAS v4u*)(vsrc + adv * VDIM); if (tid < 64) rg = gsrc[adv * HV]; }
        const LAS float* qf = (const LAS float*)buf; const LAS float* kf = (const LAS float*)(buf + 16384); const LAS float* vf = (const LAS float*)(buf + 32768); const LAS float* gf = (const LAS float*)(buf + 36864);
#pragma unroll 4
        for (int tt = 0; tt < CT; ++tt) {
            const f32x4 k0 = *(const LAS f32x4*)(kf + tt * 128 + 8 * p), k1 = *(const LAS f32x4*)(kf + tt * 128 + 8 * p + 4);
            const f32x4 q0 = *(const LAS f32x4*)(qf + tt * 128 + 8 * p), q1 = *(const LAS f32x4*)(qf + tt * 128 + 8 * p + 4);
            const float vt = vf[tt * 32 + vl], bt = gf[tt], at = gf[32 + tt];
            float pred = (S[0] * k0.x + S[1] * k0.y) + (S[2] * k0.z + S[3] * k0.w) + (S[4] * k1.x + S[5] * k1.y) + (S[6] * k1.z + S[7] * k1.w);
            pred = rowsum16(pred);
            const float delta = bt * (vt - at * pred);
            S[0] = at * S[0] + k0.x * delta; S[1] = at * S[1] + k0.y * delta; S[2] = at * S[2] + k0.z * delta; S[3] = at * S[3] + k0.w * delta;
            S[4] = at * S[4] + k1.x * delta; S[5] = at * S[5] + k1.y * delta; S[6] = at * S[6] + k1.z * delta; S[7] = at * S[7] + k1.w * delta;
            float o = (S[0] * q0.x + S[1] * q0.y) + (S[2] * q0.z + S[3] * q0.w) + (S[4] * q1.x + S[5] * q1.y) + (S[6] * q1.z + S[7] * q1.w);
            o = rowsum16(o);
            if (p == 0) ob[tt * 32 + vl] = o;
        }
        __syncthreads();
        if (tid < 256) { const int orow = tid >> 3, oc = (tid & 7) * 4; const f32x4 v = *(const LAS f32x4*)(ob + orow * 32 + oc);
            *(GAS f32x4*)(O + (row0 + (size_t)c * CT + orow) * VDIM + hv * HD + vq * 32 + oc) = v; }
    }
    __syncthreads();
}


constexpr int PL_Q = 0, PL_KT = 16384, PL_K = 32768, PL_V = 49152, PL_A = 81920, PL_SM = 114688, PL_WST = 0;
__device__ __forceinline__ int rm_addr(int row, int col) { return row * 256 + (((col >> 3) ^ (row & 15)) << 4) + (col & 7) * 2; }
__device__ __forceinline__ int kt_addr(int d, int c) { return d * 128 + (((c >> 2) ^ (d & 15)) << 3) + (c & 3) * 2; }
__device__ __forceinline__ int rowof(int rho, int h) { return (rho & 3) + 8 * (rho >> 2) + 4 * h; }
__device__ __forceinline__ unsigned short bf1(float v) { return (unsigned short)(pk2(v, v) & 0xffffu); }

__device__ __forceinline__ void dn_prep_item(const bf16* QC, const bf16* KC, const bf16* VC, const float* BETA, const float* GL, bf16* Wf, bf16* Qf, bf16* Kf, bf16* AQKf, bf16* Uf, float* SC,
                                             LAS unsigned char* lds, int item, int tid, int wave, int lane) {
    asm volatile("" : "+v"(tid), "+v"(lane));
    const int chunk = item & 127, bk = item >> 7, hk = bk & 15, b = bk >> 4;
    const size_t tok0 = (size_t)b * SEQ + (size_t)chunk * 64;
    const size_t ki = (size_t)item;
    const int r = lane & 31, h = lane >> 5;
    LAS float* betl = (LAS float*)(lds + PL_SM);
    LAS float* gcl_ = (LAS float*)(lds + PL_SM + 512);
    LAS float* facl = (LAS float*)(lds + PL_SM + 1024);
#pragma unroll
    for (int e = 0; e < 2; ++e) { const int id = tid + 512 * e, row = id >> 4, p = id & 15;
        const v4u qv = *(const GAS v4u*)(QC + (tok0 + row) * KDIM + hk * HD + p * 8);
        const v4u kv = *(const GAS v4u*)(KC + (tok0 + row) * KDIM + hk * HD + p * 8);
        *(LAS v4u*)(lds + PL_Q + rm_addr(row, p * 8)) = qv;
        *(LAS v4u*)(lds + PL_K + rm_addr(row, p * 8)) = kv;
        const unsigned kw[4] = {kv.x, kv.y, kv.z, kv.w};
#pragma unroll
        for (int e2 = 0; e2 < 8; ++e2) *(LAS unsigned short*)(lds + PL_KT + kt_addr(p * 8 + e2, row)) = (unsigned short)((kw[e2 >> 1] >> ((e2 & 1) * 16)) & 0xffffu); }
#pragma unroll
    for (int e = 0; e < 4; ++e) { const int id = tid + 512 * e, row = id >> 5, p = id & 31;
        const v4u vv = *(const GAS v4u*)(VC + (tok0 + row) * VDIM + hk * 2 * HD + p * 8);
        *(LAS v4u*)(lds + PL_V + (p >> 4) * 16384 + row * 256 + (p & 15) * 16) = vv; }
    if (wave < 2) { const int hv = 2 * hk + wave; const size_t gi = (tok0 + lane) * HV + hv; const float bt = BETA[gi]; float gc = GL[gi];
#pragma unroll
        for (int o = 1; o < 64; o <<= 1) { const float t = __shfl_up(gc, o); if (lane >= o) gc += t; }
        const float gl = __shfl(gc, 63);
        betl[wave * 64 + lane] = bt; gcl_[wave * 64 + lane] = gc; const float eg = __expf(gc);
        facl[(wave * 2 + 0) * 64 + lane] = bt; facl[(wave * 2 + 1) * 64 + lane] = bt * eg;
        float* sc = SC + ((size_t)(b * HV + hv) * 128 + chunk) * 256;
        sc[lane] = eg; sc[64 + lane] = __expf(gl - gc); if (lane == 0) sc[128] = __expf(gl); }
    LDS_WAIT(); __syncthreads();
    {   f32x16 acc = {};
        if (wave < 4) { const int tc = wave >> 1, tm = wave & 1;
#pragma unroll
            for (int ks = 0; ks < 8; ++ks) { const bf16x8 a = *(const LAS bf16x8*)(lds + PL_K + rm_addr(32 * tc + r, 16 * ks + 8 * h)), bb = *(const LAS bf16x8*)(lds + PL_K + rm_addr(32 * tm + r, 16 * ks + 8 * h));
                acc = __builtin_amdgcn_mfma_f32_32x32x16_bf16(a, bb, acc, 0, 0, 0); }
#pragma unroll
            for (int hvl = 0; hvl < 2; ++hvl) { const int m = 32 * tm + r; const float gm = gcl_[hvl * 64 + m];
#pragma unroll
                for (int rho = 0; rho < 16; ++rho) { const int c = 32 * tc + rowof(rho, h); const float e = __expf(fminf(gcl_[hvl * 64 + c] - gm, 0.f));
                    const float val = (c > m) ? betl[hvl * 64 + c] * acc[rho] * e : 0.f;
                    *(LAS float*)(lds + PL_A + hvl * 16384 + (c * 64 + m) * 4) = val; } }
        } else { const int tm = (wave - 4) >> 1, tcp = (wave - 4) & 1;
#pragma unroll
            for (int ks = 0; ks < 8; ++ks) { const bf16x8 a = *(const LAS bf16x8*)(lds + PL_K + rm_addr(32 * tm + r, 16 * ks + 8 * h)), bb = *(const LAS bf16x8*)(lds + PL_Q + rm_addr(32 * tcp + r, 16 * ks + 8 * h));
                acc = __builtin_amdgcn_mfma_f32_32x32x16_bf16(a, bb, acc, 0, 0, 0); }
#pragma unroll
            for (int hvl = 0; hvl < 2; ++hvl) { const int cp = 32 * tcp + r; const float gp = gcl_[hvl * 64 + cp]; float val[16];
#pragma unroll
                for (int rho = 0; rho < 16; ++rho) { const int m = 32 * tm + rowof(rho, h); const float e = __expf(fminf(gp - gcl_[hvl * 64 + m], 0.f)); val[rho] = (cp >= m) ? acc[rho] * e : 0.f; }
                bf16* dst = AQKf + ((size_t)(b * HV + 2 * hk + hvl) * 128 + chunk) * 4096 + ((tcp * 2 + tm) * 2) * 512 + lane * 8;
                v4u w0, w1; w0.x = pk2(val[0], val[1]); w0.y = pk2(val[2], val[3]); w0.z = pk2(val[4], val[5]); w0.w = pk2(val[6], val[7]);
                w1.x = pk2(val[8], val[9]); w1.y = pk2(val[10], val[11]); w1.z = pk2(val[12], val[13]); w1.w = pk2(val[14], val[15]);
                *(GAS v4u*)dst = w0; *(GAS v4u*)(dst + 512) = w1; } }
#pragma unroll
        for (int e = 0; e < 2; ++e) { const int f = 2 * wave + e;
            { const int t = f >> 3, i = (f >> 1) & 3, s = f & 1, row = 32 * t + r, col0 = 32 * i + 16 * s + 4 * h;
              const v2u lo = *(const LAS v2u*)(lds + PL_Q + rm_addr(row, col0)), hi = *(const LAS v2u*)(lds + PL_Q + rm_addr(row, col0 + 8));
              *(GAS v4u*)(Qf + ki * 8192 + f * 512 + lane * 8) = (v4u){lo.x, lo.y, hi.x, hi.y}; }
            { const int i = f >> 2, t = (f >> 1) & 1, s = f & 1, d = 32 * i + r, c0 = 32 * t + 16 * s + 4 * h;
              const v2u lo = *(const LAS v2u*)(lds + PL_KT + kt_addr(d, c0)), hi = *(const LAS v2u*)(lds + PL_KT + kt_addr(d, c0 + 8));
              *(GAS v4u*)(Kf + ki * 8192 + f * 512 + lane * 8) = (v4u){lo.x, lo.y, hi.x, hi.y}; } }
    }
    LDS_WAIT(); __syncthreads();
    {   const int hvl = wave >> 2, q4 = wave & 3; const bool isw = q4 >= 2; const int col = 64 * (q4 & 1) + lane;
        const LAS float* Am = (const LAS float*)(lds + PL_A + hvl * 16384);
        const LAS float* fc = facl + (hvl * 2 + (isw ? 1 : 0)) * 64;
        float X[64]; f32x4 ar[2][16];
        ar[1][0] = *(const LAS f32x4*)(Am + 64);
#pragma unroll
        for (int i = 0; i < 64; ++i) {
            const int sa = isw ? (PL_K + rm_addr(i, col)) : (PL_V + hvl * 16384 + i * 256 + col * 2);
            const float rv = __uint_as_float((unsigned)(*(const LAS unsigned short*)(lds + sa)) << 16), fv = fc[i];
            if (i + 1 < 64) {
#pragma unroll
                for (int c = 0; c < (i + 1 + 3) / 4; ++c) ar[(i + 1) & 1][c] = *(const LAS f32x4*)(Am + (i + 1) * 64 + 4 * c); }
            __builtin_amdgcn_sched_barrier(0);
            float acc = fv * rv, acc1 = 0.f, acc2 = 0.f, acc3 = 0.f;
#pragma unroll
            for (int j0 = 0; j0 < i; j0 += 4) { const f32x4 a = ar[i & 1][j0 >> 2];
                acc -= a.x * X[j0]; if (j0 + 1 < i) acc1 -= a.y * X[j0 + 1]; if (j0 + 2 < i) acc2 -= a.z * X[j0 + 2]; if (j0 + 3 < i) acc3 -= a.w * X[j0 + 3]; }
            X[i] = (acc + acc1) + (acc2 + acc3);
            __builtin_amdgcn_sched_barrier(0); }
        const size_t ci = (size_t)(b * HV + 2 * hk + hvl) * 128 + chunk;
        if (!isw) { const int jd = col >> 5, dl = col & 31;
#pragma unroll
            for (int t = 0; t < 2; ++t)
#pragma unroll
                for (int hh = 0; hh < 2; ++hh) { v4u w0, w1;
                    w0.x = pk2(X[32 * t + rowof(0, hh)], X[32 * t + rowof(1, hh)]); w0.y = pk2(X[32 * t + rowof(2, hh)], X[32 * t + rowof(3, hh)]); w0.z = pk2(X[32 * t + rowof(4, hh)], X[32 * t + rowof(5, hh)]); w0.w = pk2(X[32 * t + rowof(6, hh)], X[32 * t + rowof(7, hh)]);
                    w1.x = pk2(X[32 * t + rowof(8, hh)], X[32 * t + rowof(9, hh)]); w1.y = pk2(X[32 * t + rowof(10, hh)], X[32 * t + rowof(11, hh)]); w1.z = pk2(X[32 * t + rowof(12, hh)], X[32 * t + rowof(13, hh)]); w1.w = pk2(X[32 * t + rowof(14, hh)], X[32 * t + rowof(15, hh)]);
                    bf16* dst = Uf + ci * 8192 + (size_t)(((jd * 2 + t) * 64 + hh * 32 + dl) * 16);
                    *(GAS v4u*)dst = w0; *(GAS v4u*)(dst + 8) = w1; }
        } else {
#pragma unroll
            for (int i = 0; i < 64; ++i) *(LAS unsigned short*)(lds + PL_WST + hvl * 16384 + rm_addr(i, col)) = bf1(X[i]);
        }
    }
    LDS_WAIT(); __syncthreads();
#pragma unroll
    for (int e = 0; e < 4; ++e) { const int idx = wave * 4 + e, hvl = idx >> 4, f = idx & 15, t = f >> 3, i = (f >> 1) & 3, s = f & 1, row = 32 * t + r, col0 = 32 * i + 16 * s + 4 * h;
        const v2u lo = *(const LAS v2u*)(lds + PL_WST + hvl * 16384 + rm_addr(row, col0)), hi = *(const LAS v2u*)(lds + PL_WST + hvl * 16384 + rm_addr(row, col0 + 8));
        *(GAS v4u*)(Wf + ((size_t)(b * HV + 2 * hk + hvl) * 128 + chunk) * 8192 + f * 512 + lane * 8) = (v4u){lo.x, lo.y, hi.x, hi.y}; }
    LDS_WAIT(); __syncthreads();
}

__device__ __forceinline__ void dn_scan_phase(const bf16* Wf, const bf16* Qf, const bf16* Kf, const bf16* AQKf, const bf16* Uf, const float* SC, float* O, LAS unsigned char* lds, int unit, int wave, int lane) {
    constexpr int BUFB = 58368, NST = SEQ / 64;
    const int bh = unit >> 2, jd = unit & 3, b = bh >> 5, hv = bh & 31, hk = hv >> 1;
    const size_t ci0 = (size_t)(b * HV + hv) * 128, ki0 = (size_t)(b * HK + hk) * 128;
    const int r = lane & 31, h = lane >> 5;
    if (wave > 0) {
        const bf16* src; size_t stride;
        if (wave <= 2) { src = Wf + ci0 * 8192 + (wave - 1) * 4096; stride = 8192; }
        else if (wave <= 4) { src = Qf + ki0 * 8192 + (wave - 3) * 4096; stride = 8192; }
        else if (wave <= 6) { src = Kf + ki0 * 8192 + (wave - 5) * 4096; stride = 8192; }
        else { src = AQKf + ci0 * 4096; stride = 4096; }
        src += lane * 8;
        const float* ssrc = SC + ci0 * 256 + lane * 4;
        const int dofs = (wave - 1) * 8192 + lane * 16;
        v4u RA[8], RB[8]; f32x4 RsA = {0.f, 0.f, 0.f, 0.f}, RsB = {0.f, 0.f, 0.f, 0.f};
#define LD_SET(R, Rs, st) do { const bf16* sp_ = src + (size_t)(st) * stride; _Pragma("unroll") for (int e = 0; e < 8; ++e) R[e] = *(const GAS v4u*)(sp_ + e * 512); if (wave == 1) Rs = *(const GAS f32x4*)(ssrc + (size_t)(st) * 256); } while (0)
#define ST_SET(R, Rs, st) do { LAS unsigned char* bp_ = lds + ((st) & 1) * BUFB; _Pragma("unroll") for (int e = 0; e < 8; ++e) *(LAS v4u*)(bp_ + dofs + e * 1024) = R[e]; if (wave == 1) *(LAS f32x4*)(bp_ + 57344 + lane * 16) = Rs; } while (0)
        LD_SET(RA, RsA, 0); ST_SET(RA, RsA, 0);
        LD_SET(RA, RsA, 1); LD_SET(RB, RsB, 2);
        for (int n = 0; n < NST; n += 2) {
            LDS_WAIT(); __builtin_amdgcn_s_barrier(); asm volatile("" ::: "memory");
            if (n + 1 < NST) ST_SET(RA, RsA, n + 1);
            if (n + 3 < NST) LD_SET(RA, RsA, n + 3);
            LDS_WAIT(); __builtin_amdgcn_s_barrier(); asm volatile("" ::: "memory");
            if (n + 2 < NST) ST_SET(RB, RsB, n + 2);
            if (n + 4 < NST) LD_SET(RB, RsB, n + 4);
        }
#undef LD_SET
#undef ST_SET
    } else {
        f32x16 S0 = {}, S1 = {}, S2 = {}, S3 = {};
        const bf16* usrc = Uf + ci0 * 8192 + (size_t)((jd * 2) * 64 + lane) * 16;
        v4u un[4];
        un[0] = *(const GAS v4u*)usrc; un[1] = *(const GAS v4u*)(usrc + 8); un[2] = *(const GAS v4u*)(usrc + 1024); un[3] = *(const GAS v4u*)(usrc + 1032);
        GAS float* obase = (GAS float*)(O + ((size_t)b * SEQ) * VDIM + hv * HD + jd * 32 + r);
#define MF(a, bq, c) __builtin_amdgcn_mfma_f32_32x32x16_bf16(a, bq, c, 0, 0, 0)
#define FRAG(off) (*(const LAS bf16x8*)(bp + (off) + lane * 16))
#define PK8(V, s) __builtin_bit_cast(bf16x8, (v4u){pk2(V[8 * (s) + 0], V[8 * (s) + 1]), pk2(V[8 * (s) + 2], V[8 * (s) + 3]), pk2(V[8 * (s) + 4], V[8 * (s) + 5]), pk2(V[8 * (s) + 6], V[8 * (s) + 7])})
        for (int n = 0; n < NST; ++n) {
            LDS_WAIT(); __builtin_amdgcn_s_barrier(); asm volatile("" ::: "memory");
            const LAS unsigned char* bp = lds + (n & 1) * BUFB;
            const v4u u0 = un[0], u1 = un[1], u2 = un[2], u3 = un[3];
            if (n + 1 < NST) { const bf16* up = usrc + (size_t)(n + 1) * 8192; un[0] = *(const GAS v4u*)up; un[1] = *(const GAS v4u*)(up + 8); un[2] = *(const GAS v4u*)(up + 1024); un[3] = *(const GAS v4u*)(up + 1032); }
            const bf16x8 Sb00 = PK8(S0, 0), Sb01 = PK8(S0, 1), Sb10 = PK8(S1, 0), Sb11 = PK8(S1, 1), Sb20 = PK8(S2, 0), Sb21 = PK8(S2, 1), Sb30 = PK8(S3, 0), Sb31 = PK8(S3, 1);
            f32x16 P0 = {}, P1 = {};
            P0 = MF(FRAG(0 * 1024), Sb00, P0); P1 = MF(FRAG(8 * 1024), Sb00, P1);
            P0 = MF(FRAG(1 * 1024), Sb01, P0); P1 = MF(FRAG(9 * 1024), Sb01, P1);
            P0 = MF(FRAG(2 * 1024), Sb10, P0); P1 = MF(FRAG(10 * 1024), Sb10, P1);
            P0 = MF(FRAG(3 * 1024), Sb11, P0); P1 = MF(FRAG(11 * 1024), Sb11, P1);
            P0 = MF(FRAG(4 * 1024), Sb20, P0); P1 = MF(FRAG(12 * 1024), Sb20, P1);
            P0 = MF(FRAG(5 * 1024), Sb21, P0); P1 = MF(FRAG(13 * 1024), Sb21, P1);
            P0 = MF(FRAG(6 * 1024), Sb30, P0); P1 = MF(FRAG(14 * 1024), Sb30, P1);
            P0 = MF(FRAG(7 * 1024), Sb31, P0); P1 = MF(FRAG(15 * 1024), Sb31, P1);
            float V0[16], V1[16], E0[16], E1[16];
            { float uu[8]; unpack8(u0, uu);
#pragma unroll
              for (int e = 0; e < 8; ++e) V0[e] = uu[e] - P0[e];
              unpack8(u1, uu);
#pragma unroll
              for (int e = 0; e < 8; ++e) V0[8 + e] = uu[e] - P0[8 + e];
              unpack8(u2, uu);
#pragma unroll
              for (int e = 0; e < 8; ++e) V1[e] = uu[e] - P1[e];
              unpack8(u3, uu);
#pragma unroll
              for (int e = 0; e < 8; ++e) V1[8 + e] = uu[e] - P1[8 + e]; }
            const LAS float* scl = (const LAS float*)(bp + 57344);
#pragma unroll
            for (int g = 0; g < 4; ++g) { const f32x4 k0 = *(const LAS f32x4*)(scl + 64 + 8 * g + 4 * h), k1 = *(const LAS f32x4*)(scl + 64 + 32 + 8 * g + 4 * h);
                E0[4 * g + 0] = V0[4 * g + 0] * k0.x; E0[4 * g + 1] = V0[4 * g + 1] * k0.y; E0[4 * g + 2] = V0[4 * g + 2] * k0.z; E0[4 * g + 3] = V0[4 * g + 3] * k0.w;
                E1[4 * g + 0] = V1[4 * g + 0] * k1.x; E1[4 * g + 1] = V1[4 * g + 1] * k1.y; E1[4 * g + 2] = V1[4 * g + 2] * k1.z; E1[4 * g + 3] = V1[4 * g + 3] * k1.w; }
            const bf16x8 Vb00 = PK8(V0, 0), Vb01 = PK8(V0, 1), Vb10 = PK8(V1, 0), Vb11 = PK8(V1, 1);
            const bf16x8 Ve00 = PK8(E0, 0), Ve01 = PK8(E0, 1), Ve10 = PK8(E1, 0), Ve11 = PK8(E1, 1);
            const size_t orow = (size_t)n * 64;
#pragma unroll
            for (int tp = 0; tp < 2; ++tp) {
                f32x16 oa = {};
                oa = MF(FRAG(16384 + (tp * 8 + 0) * 1024), Sb00, oa); oa = MF(FRAG(16384 + (tp * 8 + 1) * 1024), Sb01, oa);
                oa = MF(FRAG(16384 + (tp * 8 + 2) * 1024), Sb10, oa); oa = MF(FRAG(16384 + (tp * 8 + 3) * 1024), Sb11, oa);
                oa = MF(FRAG(16384 + (tp * 8 + 4) * 1024), Sb20, oa); oa = MF(FRAG(16384 + (tp * 8 + 5) * 1024), Sb21, oa);
                oa = MF(FRAG(16384 + (tp * 8 + 6) * 1024), Sb30, oa); oa = MF(FRAG(16384 + (tp * 8 + 7) * 1024), Sb31, oa);
#pragma unroll
                for (int g = 0; g < 4; ++g) { const f32x4 e4 = *(const LAS f32x4*)(scl + 32 * tp + 8 * g + 4 * h);
                    oa[4 * g + 0] *= e4.x; oa[4 * g + 1] *= e4.y; oa[4 * g + 2] *= e4.z; oa[4 * g + 3] *= e4.w; }
                oa = MF(FRAG(49152 + (tp * 4 + 0) * 1024), Vb00, oa); oa = MF(FRAG(49152 + (tp * 4 + 1) * 1024), Vb01, oa);
                if (tp == 1) { oa = MF(FRAG(49152 + (tp * 4 + 2) * 1024), Vb10, oa); oa = MF(FRAG(49152 + (tp * 4 + 3) * 1024), Vb11, oa); }
#pragma unroll
                for (int rho = 0; rho < 16; ++rho) obase[(orow + 32 * tp + rowof(rho, h)) * VDIM] = oa[rho];
            }
            const float cd = scl[128];
            S0 = S0 * cd; S1 = S1 * cd; S2 = S2 * cd; S3 = S3 * cd;
            S0 = MF(FRAG(32768 + 0 * 1024), Ve00, S0); S0 = MF(FRAG(32768 + 1 * 1024), Ve01, S0); S0 = MF(FRAG(32768 + 2 * 1024), Ve10, S0); S0 = MF(FRAG(32768 + 3 * 1024), Ve11, S0);
            S1 = MF(FRAG(32768 + 4 * 1024), Ve00, S1); S1 = MF(FRAG(32768 + 5 * 1024), Ve01, S1); S1 = MF(FRAG(32768 + 6 * 1024), Ve10, S1); S1 = MF(FRAG(32768 + 7 * 1024), Ve11, S1);
            S2 = MF(FRAG(32768 + 8 * 1024), Ve00, S2); S2 = MF(FRAG(32768 + 9 * 1024), Ve01, S2); S2 = MF(FRAG(32768 + 10 * 1024), Ve10, S2); S2 = MF(FRAG(32768 + 11 * 1024), Ve11, S2);
            S3 = MF(FRAG(32768 + 12 * 1024), Ve00, S3); S3 = MF(FRAG(32768 + 13 * 1024), Ve01, S3); S3 = MF(FRAG(32768 + 14 * 1024), Ve10, S3); S3 = MF(FRAG(32768 + 15 * 1024), Ve11, S3);
        }
#undef MF
#undef FRAG
#undef PK8
    }
    LDS_WAIT(); __syncthreads();
}

__device__ __forceinline__ void dn_gnorm_phase(const float* O, const bf16* Z, const float* nw, bf16* A3, int gw, int NGW, int lane) {
    constexpr int NCG = VDIM / 512, NITEMS = M * NCG;
    float wv[8];
    { const f32x4 a = *(const GAS f32x4*)(nw + (lane & 15) * 8), b = *(const GAS f32x4*)(nw + (lane & 15) * 8 + 4); wv[0] = a.x; wv[1] = a.y; wv[2] = a.z; wv[3] = a.w; wv[4] = b.x; wv[5] = b.y; wv[6] = b.z; wv[7] = b.w; }
#pragma unroll 4
    for (int it = gw; it < NITEMS; it += NGW) {
        const int cgp = it % NCG, row = it / NCG, c0 = cgp * 512 + lane * 8;
        const f32x4 a = *(const GAS f32x4*)(O + (size_t)row * VDIM + c0), b = *(const GAS f32x4*)(O + (size_t)row * VDIM + c0 + 4);
        float z[8]; unpack8(*(const GAS v4u*)(Z + (size_t)row * VDIM + c0), z);
        float o[8] = {a.x, a.y, a.z, a.w, b.x, b.y, b.z, b.w};
        float ss = 0.f;
#pragma unroll
        for (int e = 0; e < 8; ++e) ss += o[e] * o[e];
        ss = sum16(ss);
        const float rs = 1.f / sqrtf(ss * (1.f / HD) + RMS_EPS);
#pragma unroll
        for (int e = 0; e < 8; ++e) o[e] = o[e] * rs * wv[e] * silu_f(z[e]);
        *(GAS v4u*)(A3 + (size_t)row * VDIM + c0) = pack8(o);
    }
}

struct Args { const float* in[14]; float* out; unsigned char* ws; int ph_lo, ph_hi, li, pad; };
__device__ __forceinline__ unsigned long long ptab_get(LAS unsigned char* lds, int i) {
    volatile LAS unsigned* p = (volatile LAS unsigned*)(lds + PTAB_OFF) + 2 * i;
    const unsigned lo = __builtin_amdgcn_readfirstlane(p[0]), hi = __builtin_amdgcn_readfirstlane(p[1]);
    return ((unsigned long long)hi << 32) | lo;
}
#ifndef REP_MASK
#define REP_MASK 0
#endif
#define REPS(t) for (int rep_ = 0; rep_ < 1 + ((REP_MASK >> (t)) & 1); ++rep_)
#define PIN(i) ((const float*)ptab_get(lds, (i)))
#define POUT ((float*)ptab_get(lds, 14))
#define PWS ((unsigned char*)ptab_get(lds, 15))
#define LOCAL_IDS int tid = threadIdx.x; asm volatile("" : "+v"(tid)); const int lane = tid & 63, wave = __builtin_amdgcn_readfirstlane(tid >> 6); const int G = gridDim.x, bx = blockIdx.x; \
    const int vcu = (G % 8 == 0) ? (bx % 8) * (G / 8) + bx / 8 : bx; const int gw = vcu * NWAVES + wave, NGW = G * NWAVES, gt = vcu * (NWAVES * 64) + tid, NGT = G * NWAVES * 64; \
    unsigned char* const ws = PWS; (void)lane; (void)gw; (void)NGW; (void)gt; (void)NGT; (void)ws
__global__ void __launch_bounds__(NWAVES * 64, 2) fwd(Args args) {
    extern __shared__ __attribute__((aligned(16))) unsigned char lds_raw[];
    LAS unsigned char* lds = (LAS unsigned char*)lds_raw;
    volatile LAS unsigned* MISC = (volatile LAS unsigned*)(lds + MISC_OFF);
    for (int u = threadIdx.x; u < (LDS_BYTES - LDSCTL_OFF) / 4; u += NWAVES * 64) ((LAS unsigned*)(lds + LDSCTL_OFF))[u] = 0u;
    __syncthreads();
    if (threadIdx.x == 0) {
        LAS unsigned long long* pt = (LAS unsigned long long*)(lds + PTAB_OFF);
#pragma unroll
        for (int i = 0; i < 14; ++i) pt[i] = (unsigned long long)args.in[i];
        pt[14] = (unsigned long long)args.out; pt[15] = (unsigned long long)args.ws;
    }
    __syncthreads();
    if (threadIdx.x == 0) { LAS unsigned* pw = (LAS unsigned*)(lds + PTAB_OFF) + 32; pw[0] = (unsigned)args.ph_lo; pw[1] = (unsigned)args.ph_hi; }
    if (!MK_PER_PHASE) (void)xcd_barrier_post((unsigned*)(args.ws + WS_CTL) + CW_BAR, MISC + 8);
    __syncthreads();
#define PH_LO ((int)__builtin_amdgcn_readfirstlane(((volatile LAS unsigned*)(lds + PTAB_OFF))[32]))
#define PH_HI ((int)__builtin_amdgcn_readfirstlane(((volatile LAS unsigned*)(lds + PTAB_OFF))[33]))
#define IN(k) (PH_LO <= (k) && (k) < PH_HI)
#define SEAM(k) do { if (!MK_PER_PHASE) { if (IN(k) && IN((k) + 1)) { XcdBarrier bar_; bar_.bar = (unsigned*)(PWS + WS_CTL) + CW_BAR; bar_.x = xb_xcc_id(); bar_.st = MISC + 8; xcd_barrier(bar_); } } } while (0)

    if (IN(0)) REPS(0) { LOCAL_IDS; Ptrs P; P.x = PIN(0); P.sc_w_in = PIN(1); P.sc_w_out = PIN(3); P.dn_w_in = PIN(4); P.dn_w_out = PIN(9); P.ffn_gu = PIN(10); P.ffn_down = PIN(11); P.ws = ws;
        p0_prologue(P, lds, gw, NGW, wave, lane); }
    SEAM(0);

    for (int L = 0; L < DEPTH; ++L) {
        const int j = L >> 1;
        const int pb = 1 + 17 * j + ((L & 1) ? 7 : 0);
        int fb;
        if ((L & 1) == 0) {
            if (IN(pb + 0)) REPS(1) {
                LOCAL_IDS;
                pg8::Gemm g{(const bf16*)(ws + WS_XB), (const bf16*)(ws + WS_W_SCIN) + (size_t)j * 3 * DM * DM, M, 3 * DM, DM}; pg8::StaticOrder S; S.init(M, 3 * DM, G, bx);
                pg8::EpiGate<0> E{(bf16*)(ws + WS_GB), DM, (bf16*)(ws + WS_CU), DM, DM / 256};
                pg8::gemm_phase<pg8::EpiGate<0>, pg8::StaticOrder, PG8_ALIGN, PG8_SP2>(lds + RING_OFF, g, S, E);
            }
            SEAM(pb + 0);
            if (IN(pb + 1)) REPS(2) { LOCAL_IDS; sc_conv_phase((const bf16*)(ws + WS_GB), (const bf16*)(ws + WS_CU), PIN(2) + (size_t)j * 3 * DM, (bf16*)(ws + WS_A2), gt, NGT); }
            SEAM(pb + 1);
            if (IN(pb + 2)) REPS(3) {
                LOCAL_IDS;
                pg8::Gemm g{(const bf16*)(ws + WS_A2), (const bf16*)(ws + WS_W_SCOUT) + (size_t)j * DM * DM, M, DM, DM}; pg8::StaticOrder S; S.init(M, DM, G, bx);
                pg8::EpiStore2 E{(bf16*)(ws + WS_H1), DM, (bf16*)(ws + WS_H1), DM, 1 << 30};
                pg8::gemm_phase<pg8::EpiStore2, pg8::StaticOrder, PG8_ALIGN, PG8_SP2>(lds + RING_OFF, g, S, E);
            }
            SEAM(pb + 2);
            if (IN(pb + 3)) { LOCAL_IDS; ln_phase((L == 0) ? PIN(0) : (const float*)POUT, (const bf16*)(ws + WS_H1), PIN(12) + (size_t)(L * 2) * DM, PIN(13) + (size_t)(L * 2) * DM, POUT, (bf16*)(ws + WS_XB), gw, NGW, lane); }
            SEAM(pb + 3);
            fb = pb + 4;
        } else {
            if (IN(pb + 0)) REPS(5) {
                LOCAL_IDS;
                pg8::Gemm g{(const bf16*)(ws + WS_XB), (const bf16*)(ws + WS_W_DNIN) + (size_t)j * DNP_MAIN * DM, M, DNP_MAIN, DM}; pg8::StaticOrder S; S.init(M, DNP_MAIN, G, bx);
                pg8::EpiStore2 E{(bf16*)(ws + WS_QKV), QKV, (bf16*)(ws + WS_Z), VDIM, QKV};
                pg8::gemm_phase<pg8::EpiStore2, pg8::StaticOrder, PG8_ALIGN, PG8_SP2>(lds + RING_OFF, g, S, E);
            }
            if (IN(pb + 0)) {
                LOCAL_IDS;
                for (int u = bx; u < M / 64; u += G) ba_phase((const bf16*)(ws + WS_XB), (const bf16*)(ws + WS_W_BA) + (size_t)j * 64 * DM, (float*)(ws + WS_BA), lds, u, wave, lane);
            }
            SEAM(pb + 0);
            if (IN(pb + 1)) REPS(6) { LOCAL_IDS; dn_pre_phase((const bf16*)(ws + WS_QKV), PIN(5) + (size_t)j * 4 * QKV, (bf16*)(ws + WS_QC), (bf16*)(ws + WS_KC), (bf16*)(ws + WS_VC), (const float*)(ws + WS_BA), PIN(6) + j * HV, PIN(7) + j * HV,
                                                       (float*)(ws + WS_BETA), (float*)(ws + WS_DEC), (float*)(ws + WS_GL), gw, NGW, lane, gt, NGT); }
            SEAM(pb + 1);
#if DN_CHUNKED
            if (IN(pb + 2)) REPS(7) { LOCAL_IDS; for (int it = vcu; it < BATCH * HK * (SEQ / 64); it += G)
                dn_prep_item((const bf16*)(ws + WS_QC), (const bf16*)(ws + WS_KC), (const bf16*)(ws + WS_VC), (const float*)(ws + WS_BETA), (const float*)(ws + WS_GL),
                             (bf16*)(ws + WS_WF), (bf16*)(ws + WS_QF), (bf16*)(ws + WS_KF), (bf16*)(ws + WS_AQKF), (bf16*)(ws + WS_UF), (float*)(ws + WS_SC), lds, it, tid, wave, lane); }
            SEAM(pb + 2);
            if (IN(pb + 3)) REPS(12) { LOCAL_IDS; for (int u = vcu; u < BATCH * HV * 4; u += G)
                dn_scan_phase((const bf16*)(ws + WS_WF), (const bf16*)(ws + WS_QF), (const bf16*)(ws + WS_KF), (const bf16*)(ws + WS_AQKF), (const bf16*)(ws + WS_UF), (const float*)(ws + WS_SC), (float*)(ws + WS_O2), lds, u, wave, lane); }
            SEAM(pb + 3);
            if (IN(pb + 4)) REPS(8) { LOCAL_IDS; dn_gnorm_phase((const float*)(ws + WS_O2), (const bf16*)(ws + WS_Z), PIN(8) + j * HD, (bf16*)(ws + WS_A3), gw, NGW, lane); }
#else
            if (IN(pb + 2)) REPS(7) { LOCAL_IDS; for (int u = vcu; u < BATCH * HV * 4; u += G) dn_naive_phase((const bf16*)(ws + WS_QC), (const bf16*)(ws + WS_KC), (const bf16*)(ws + WS_VC), (const float*)(ws + WS_BETA), (const float*)(ws + WS_DEC), (float*)(ws + WS_O), lds, u, tid); }
            SEAM(pb + 2);
            SEAM(pb + 3);
            if (IN(pb + 4)) REPS(8) { LOCAL_IDS; dn_gnorm_phase((const float*)(ws + WS_O), (const bf16*)(ws + WS_Z), PIN(8) + j * HD, (bf16*)(ws + WS_A3), gw, NGW, lane); }
#endif
            SEAM(pb + 4);
            if (IN(pb + 5)) REPS(9) {
                LOCAL_IDS;
                pg8::Gemm g{(const bf16*)(ws + WS_A3), (const bf16*)(ws + WS_W_DNOUT) + (size_t)j * DM * VDIM, M, DM, VDIM}; pg8::StaticOrder S; S.init(M, DM, G, bx);
                pg8::EpiStore2 E{(bf16*)(ws + WS_H1), DM, (bf16*)(ws + WS_H1), DM, 1 << 30};
                pg8::gemm_phase<pg8::EpiStore2, pg8::StaticOrder, PG8_ALIGN, PG8_SP2>(lds + RING_OFF, g, S, E);
            }
            SEAM(pb + 5);
            if (IN(pb + 6)) { LOCAL_IDS; ln_phase((const float*)POUT, (const bf16*)(ws + WS_H1), PIN(12) + (size_t)(L * 2) * DM, PIN(13) + (size_t)(L * 2) * DM, POUT, (bf16*)(ws + WS_XB), gw, NGW, lane); }
            SEAM(pb + 6);
            fb = pb + 7;
        }
        if (IN(fb + 0)) REPS(10) {
            LOCAL_IDS;
            pg8::Gemm g{(const bf16*)(ws + WS_XB), (const bf16*)(ws + WS_W_GU) + (size_t)L * 2 * FF * DM, M, 2 * FF, DM}; pg8::StaticOrder S; S.init(M, 2 * FF, G, bx);
            pg8::EpiGate<1> E{(bf16*)(ws + WS_HID), FF, (bf16*)(ws + WS_HID), FF, 0};
            pg8::gemm_phase<pg8::EpiGate<1>, pg8::StaticOrder, PG8_ALIGN, PG8_SP2>(lds + RING_OFF, g, S, E);
        }
        SEAM(fb + 0);
        if (IN(fb + 1)) REPS(11) {
            LOCAL_IDS;
            pg8::Gemm g{(const bf16*)(ws + WS_HID), (const bf16*)(ws + WS_W_DOWN) + (size_t)L * DM * FF, M, DM, FF}; pg8::StaticOrder S; S.init(M, DM, G, bx);
            pg8::EpiStore2 E{(bf16*)(ws + WS_H1), DM, (bf16*)(ws + WS_H1), DM, 1 << 30};
            pg8::gemm_phase<pg8::EpiStore2, pg8::StaticOrder, PG8_ALIGN, PG8_SP2>(lds + RING_OFF, g, S, E);
        }
        SEAM(fb + 1);
        if (IN(fb + 2)) { LOCAL_IDS; ln_phase((const float*)POUT, (const bf16*)(ws + WS_H1), PIN(12) + (size_t)(L * 2 + 1) * DM, PIN(13) + (size_t)(L * 2 + 1) * DM, POUT, (bf16*)(ws + WS_XB), gw, NGW, lane); }
        SEAM(fb + 2);
    }
#undef IN
#undef SEAM
}

extern "C" void kernel_launch(void* const* d_in, const int* in_sizes, int n_in, void* d_out, int out_size, void* d_ws, size_t ws_size, hipStream_t stream) {
    static int grid = 0;
    if (grid == 0) {
        if (n_in != 14 || in_sizes[0] != M * DM || out_size != M * DM || ws_size < WS_END) { fprintf(stderr, "kernel_launch: unexpected shapes (n_in %d, in0 %d, out %d, ws %zu < %zu); nothing launched\n", n_in, n_in > 0 ? in_sizes[0] : -1, out_size, ws_size, (size_t)WS_END); grid = -1; return; }
        int dev = 0, cus = 0, per_cu = 0;
        if (hipGetDevice(&dev) != hipSuccess || hipDeviceGetAttribute(&cus, hipDeviceAttributeMultiprocessorCount, dev) != hipSuccess) { grid = -1; return; }
        if (hipFuncSetAttribute((const void*)fwd, hipFuncAttributeMaxDynamicSharedMemorySize, LDS_BYTES) != hipSuccess) { fprintf(stderr, "kernel_launch: hipFuncSetAttribute failed\n"); grid = -1; return; }
        if (hipOccupancyMaxActiveBlocksPerMultiprocessor(&per_cu, (const void*)fwd, NWAVES * 64, LDS_BYTES) != hipSuccess || per_cu < 1) fprintf(stderr, "kernel_launch: occupancy query reports %d\n", per_cu);
        (void)hipGetLastError();
        grid = cus;
        if (grid > 256) grid = 256;
    }
    if (grid < 0) return;
    if (hipMemsetAsync((char*)d_ws + WS_CTL, 0, CTL_ZERO_BYTES, stream) != hipSuccess) return;
    Args a{};
    for (int i = 0; i < 14; ++i) a.in[i] = (const float*)d_in[i];
    a.out = (float*)d_out; a.ws = (unsigned char*)d_ws;
#if MK_PER_PHASE
    for (int p = 0; p < N_PHASES; ++p) { a.ph_lo = p; a.ph_hi = p + 1; a.li = p; hipLaunchKernelGGL(fwd, dim3(grid), dim3(NWAVES * 64), LDS_BYTES, stream, a); }
#else
    a.ph_lo = 0; a.ph_hi = N_PHASES; a.li = 0;
    hipLaunchKernelGGL(fwd, dim3(grid), dim3(NWAVES * 64), LDS_BYTES, stream, a);
#endif
}
```

```cpp
#include <hip/hip_runtime.h>
#include <cstdio>
#include <cstdint>
namespace pg8 {
#define PG8_LAS __attribute__((address_space(3)))
typedef unsigned short bf16_t;
typedef short bf16x8 __attribute__((ext_vector_type(8)));
typedef float f32x4 __attribute__((ext_vector_type(4)));
typedef unsigned u32x4 __attribute__((ext_vector_type(4)));
constexpr int BM = 256, BK = 64, HALF = 128, HTB = HALF * BK * 2  , STAGE_BYTES = 8 * HTB, NXCD = 8, WGM = 8;

__host__ __device__ __forceinline__ int lds_byte(int r, int c) { const int st = (r >> 4) * 2 + (c >> 5), rr = r & 15, cc = c & 31, ob = rr * 64 + cc * 2; return st * 1024 + (ob ^ (((ob >> 9) & 1) << 5)); }
__host__ __device__ __forceinline__ void stage_rc(int b, int& R, int& C) { const int st = b / 1024, sb = b % 1024, swz = sb ^ (((sb >> 9) & 1) << 5); R = (st >> 1) * 16 + swz / 64; C = (st & 1) * 32 + (swz % 64) / 2; }
__host__ __device__ __forceinline__ int perm32(int rho) { const int n = rho >> 4, i = rho & 15; return 8 * (i >> 2) + 4 * n + (i & 3); }

struct Unit { int pm, pn; };
struct Gemm { const bf16_t* A; const bf16_t* Bt; int M, N, K; };

struct StaticOrder {
    int nM, nN, nwg, G, c;
    __host__ __device__ void init(int M, int N, int G_, int c_) { nM = M / BM; nN = N / BM; nwg = nM * nN; G = G_; c = c_; }
    __host__ __device__ bool next(int i, Unit& u) const {
        const long L = (long)i * G + c; if (L >= nwg) return false;
        int wgid = (int)L; { const int q = nwg / NXCD, r = nwg % NXCD, xcd = wgid % NXCD, off = wgid / NXCD; wgid = (xcd < r ? xcd * (q + 1) : r * (q + 1) + (xcd - r) * q) + off; }
        const int nig = WGM * nN, gid = wgid / nig, fm = gid * WGM, gsz = (nM - fm) < WGM ? (nM - fm) : WGM;
        u.pm = fm + ((wgid % nig) % gsz); u.pn = (wgid % nig) / gsz; return true;
    }
    __device__ __forceinline__ void a_ready(const Unit&) const {}
    __device__ __forceinline__ void done(const Unit&) const {}
};


typedef float f32x2_t __attribute__((ext_vector_type(2)));
typedef __bf16 bf16x2_t __attribute__((ext_vector_type(2)));
__device__ __forceinline__ unsigned cvt_pk_bf16(float lo, float hi) { f32x2_t v = {lo, hi}; bf16x2_t b = __builtin_convertvector(v, bf16x2_t); return __builtin_bit_cast(unsigned, b); }
__device__ __forceinline__ float silu_f(float v) { return v * __builtin_amdgcn_rcpf(1.0f + __expf(-v)); }

struct EpiStore2 {
    static constexpr bool PERM = true, AFTER_DRAIN = false;
    bf16_t* O0; int ld0; bf16_t* O1; int ld1; int split;
    __device__ __forceinline__ void operator()(const f32x4 (&acc)[2][2][4][2], const Unit& u, int wr, int wc, int fr, int fq) const {
        int colt = u.pn * BM; bf16_t* base = O0; int ld = ld0;
        if (colt >= split) { base = O1; ld = ld1; colt -= split; }
        const int row0 = u.pm * BM + wr * 64 + fr, col0 = colt + wc * 32 + 8 * fq;
#pragma unroll
        for (int ai = 0; ai < 2; ++ai)
#pragma unroll
            for (int m = 0; m < 4; ++m) { bf16_t* rowp = base + (size_t)(row0 + ai * HALF + m * 16) * ld + col0;
#pragma unroll
                for (int bj = 0; bj < 2; ++bj) { const f32x4 v0 = acc[ai][bj][m][0], v1 = acc[ai][bj][m][1];
                    u32x4 w; w.x = cvt_pk_bf16(v0[0], v0[1]); w.y = cvt_pk_bf16(v0[2], v0[3]); w.z = cvt_pk_bf16(v1[0], v1[1]); w.w = cvt_pk_bf16(v1[2], v1[3]);
                    *(u32x4*)(rowp + bj * HALF) = w; } }
    }
};
template <int ACT> struct EpiGate {
    static constexpr bool PERM = true, AFTER_DRAIN = false;
    bf16_t* P; int ldp; bf16_t* G; int ldg; int pn_plain;
    __device__ __forceinline__ void operator()(const f32x4 (&acc)[2][2][4][2], const Unit& u, int wr, int wc, int fr, int fq) const {
        const int row0 = u.pm * BM + wr * 64 + fr;
        if (u.pn < pn_plain) {
            const int col0 = u.pn * BM + wc * 32 + 8 * fq;
#pragma unroll
            for (int ai = 0; ai < 2; ++ai)
#pragma unroll
                for (int m = 0; m < 4; ++m) { bf16_t* rowp = P + (size_t)(row0 + ai * HALF + m * 16) * ldp + col0;
#pragma unroll
                    for (int bj = 0; bj < 2; ++bj) { const f32x4 v0 = acc[ai][bj][m][0], v1 = acc[ai][bj][m][1];
                        u32x4 w; w.x = cvt_pk_bf16(v0[0], v0[1]); w.y = cvt_pk_bf16(v0[2], v0[3]); w.z = cvt_pk_bf16(v1[0], v1[1]); w.w = cvt_pk_bf16(v1[2], v1[3]);
                        *(u32x4*)(rowp + bj * HALF) = w; } }
        } else {
            const int col0 = (u.pn - pn_plain) * HALF + wc * 32 + 8 * fq;
#pragma unroll
            for (int ai = 0; ai < 2; ++ai)
#pragma unroll
                for (int m = 0; m < 4; ++m) { bf16_t* rowp = G + (size_t)(row0 + ai * HALF + m * 16) * ldg + col0;
                    f32x4 a0 = acc[ai][0][m][0], a1 = acc[ai][0][m][1]; const f32x4 b0 = acc[ai][1][m][0], b1 = acc[ai][1][m][1];
                    if (ACT == 1) {
#pragma unroll
                        for (int e = 0; e < 4; ++e) { a0[e] = silu_f(a0[e]); a1[e] = silu_f(a1[e]); } }
                    a0 = a0 * b0; a1 = a1 * b1;
                    u32x4 w; w.x = cvt_pk_bf16(a0[0], a0[1]); w.y = cvt_pk_bf16(a0[2], a0[3]); w.z = cvt_pk_bf16(a1[0], a1[1]); w.w = cvt_pk_bf16(a1[2], a1[3]);
                    *(u32x4*)rowp = w; }
        }
    }
};

template <class Epi, class Sched, bool ALIGN_EPI = false, bool SP2 = false>
__device__ __forceinline__ void gemm_phase(PG8_LAS unsigned char* lds, const Gemm g, const Sched& S, const Epi& E) {
    int tid_o = threadIdx.x; asm volatile("" : "+v"(tid_o));
    const int tid = tid_o, wid = __builtin_amdgcn_readfirstlane(tid >> 6), lane = tid & 63, wr = wid >> 2, wc = wid & 3, fr = lane & 15, fq = lane >> 4;
    const int K = g.K, nt = K / BK;
    unsigned voffA[2], voffB[2];
#pragma unroll
    for (int i = 0; i < 2; ++i) { int R, C; stage_rc(tid * 16 + i * 8192, R, C); const int Rb = Epi::PERM ? ((R & ~31) + perm32(R & 31)) : R;
        voffA[i] = (unsigned)(R * K + C) * 2u; voffB[i] = (unsigned)(Rb * K + C) * 2u; }
    const size_t kstep = (size_t)(BK * 2);
    const size_t hstep = (size_t)HALF * K * 2;
    const size_t tstep = 2 * hstep;
    const unsigned ldsw = (unsigned)wid * 1024u;
    const int aoff = lds_byte(wr * 64 + fr, fq * 8), boff = lds_byte(wc * 32 + fr, fq * 8);
#define PG8_SA(b, h) (((b) * 2 + (h)) * HTB)
#define PG8_SB(b, h) ((4 + (b) * 2 + (h)) * HTB)
#define PG8_STAGE(bufoff, gbase, voff) do { _Pragma("unroll") for (int _i = 0; _i < 2; ++_i) \
        __builtin_amdgcn_global_load_lds((const unsigned*)((const char*)(gbase) + (voff)[_i]), (PG8_LAS unsigned*)(lds + (bufoff) + ldsw + _i * 8192), 16, 0, 0); } while (0)
#define PG8_LDA(dst, b, h) do { _Pragma("unroll") for (int m = 0; m < 4; ++m) _Pragma("unroll") for (int k = 0; k < 2; ++k) dst[m][k] = *(const PG8_LAS bf16x8*)(lds + PG8_SA(b, h) + aoff + m * 2048 + k * 1024); } while (0)
#define PG8_LDB(dst, b, h) do { _Pragma("unroll") for (int n = 0; n < 2; ++n) _Pragma("unroll") for (int k = 0; k < 2; ++k) dst[n][k] = *(const PG8_LAS bf16x8*)(lds + PG8_SB(b, h) + boff + n * 2048 + k * 1024); } while (0)
#define PG8_MMA(ai, bj, At, Bt) do { __builtin_amdgcn_s_setprio(1); _Pragma("unroll") for (int m = 0; m < 4; ++m) _Pragma("unroll") for (int n = 0; n < 2; ++n) _Pragma("unroll") for (int k = 0; k < 2; ++k) \
        acc[ai][bj][m][n] = __builtin_amdgcn_mfma_f32_16x16x32_bf16(Bt[n][k], At[m][k], acc[ai][bj][m][n], 0, 0, 0); __builtin_amdgcn_s_setprio(0); } while (0)
#define PG8_WAIT_V(n) asm volatile("s_waitcnt vmcnt(" #n ")" ::: "memory")
#define PG8_WAIT_L(n) asm volatile("s_waitcnt lgkmcnt(" #n ")" ::: "memory")
#define PG8_BAR __builtin_amdgcn_s_barrier()
#define PG8_SCHED __builtin_amdgcn_sched_barrier(0)
    Unit cur, nxt; int ui = 0;
    if (!S.next(0, cur)) return;
    f32x4 acc[2][2][4][2];
#pragma unroll
    for (int a = 0; a < 2; ++a)
#pragma unroll
        for (int b = 0; b < 2; ++b)
#pragma unroll
            for (int m = 0; m < 4; ++m)
#pragma unroll
                for (int n = 0; n < 2; ++n) acc[a][b][m][n] = (f32x4){0.f, 0.f, 0.f, 0.f};
    bf16x8 At[4][2], B0[2][2], B1[2][2];
    const char* cA = (const char*)g.A + (size_t)cur.pm * tstep; const char* cB = (const char*)g.Bt + (size_t)cur.pn * tstep;
    S.a_ready(cur);
    if constexpr (SP2) {
        PG8_STAGE(PG8_SB(0, 0), cB, voffB); PG8_STAGE(PG8_SB(0, 1), cB + hstep, voffB); PG8_STAGE(PG8_SA(0, 0), cA, voffA); PG8_STAGE(PG8_SA(0, 1), cA + hstep, voffA);
        if (wr == 1) PG8_BAR;
        PG8_WAIT_V(2); PG8_BAR;
        PG8_STAGE(PG8_SB(1, 0), cB + kstep, voffB); PG8_STAGE(PG8_SA(1, 0), cA + kstep, voffA); PG8_STAGE(PG8_SB(1, 1), cB + hstep + kstep, voffB);
        PG8_WAIT_V(6); PG8_BAR;
    } else {
        PG8_STAGE(PG8_SB(0, 0), cB, voffB); PG8_STAGE(PG8_SA(0, 0), cA, voffA); PG8_STAGE(PG8_SB(0, 1), cB + hstep, voffB); PG8_STAGE(PG8_SA(0, 1), cA + hstep, voffA);
        if (wr == 1) PG8_BAR;
        PG8_WAIT_V(4); PG8_BAR;
        PG8_STAGE(PG8_SB(1, 0), cB + kstep, voffB); PG8_STAGE(PG8_SA(1, 0), cA + kstep, voffA); PG8_STAGE(PG8_SB(1, 1), cB + hstep + kstep, voffB);
        PG8_WAIT_V(6); PG8_BAR;
    }
    for (;;) {
        const bool has_next = S.next(ui + 1, nxt);
        const char* nA = has_next ? (const char*)g.A + (size_t)nxt.pm * tstep : cA; const char* nB = has_next ? (const char*)g.Bt + (size_t)nxt.pn * tstep : cB;
        for (int t = 0; t < nt; t += 2) {
            const bool last = (t == nt - 2);
            const char* a1 = cA + (size_t)(t + 1) * kstep;
            const char* a2 = last ? nA : cA + (size_t)(t + 2) * kstep; const char* b2 = last ? nB : cB + (size_t)(t + 2) * kstep;
            const char* a3 = a2 + kstep; const char* b3 = b2 + kstep;
            if (last && has_next) S.a_ready(nxt);
            if constexpr (SP2) {
            PG8_LDB(B0, 0, 0); PG8_LDB(B1, 0, 1); PG8_SCHED; PG8_LDA(At, 0, 0); PG8_STAGE(PG8_SA(1, 1), a1 + hstep, voffA);
            PG8_WAIT_V(8); PG8_WAIT_L(0); PG8_BAR; PG8_MMA(0, 0, At, B0); PG8_MMA(0, 1, At, B1); PG8_BAR; PG8_SCHED;
            PG8_LDA(At, 0, 1); PG8_STAGE(PG8_SB(0, 0), b2, voffB); PG8_STAGE(PG8_SB(0, 1), b2 + hstep, voffB); PG8_STAGE(PG8_SA(0, 0), a2, voffA);
            PG8_WAIT_V(8); PG8_WAIT_L(0); PG8_BAR; PG8_MMA(1, 0, At, B0); PG8_MMA(1, 1, At, B1); PG8_BAR; PG8_SCHED;
            PG8_LDB(B0, 1, 0); PG8_LDB(B1, 1, 1); PG8_SCHED; PG8_LDA(At, 1, 0); PG8_STAGE(PG8_SA(0, 1), a2 + hstep, voffA);
            PG8_WAIT_V(8); PG8_WAIT_L(0); PG8_BAR; PG8_MMA(0, 0, At, B0); PG8_MMA(0, 1, At, B1); PG8_BAR; PG8_SCHED;
            PG8_LDA(At, 1, 1); PG8_STAGE(PG8_SB(1, 0), b3, voffB); PG8_STAGE(PG8_SB(1, 1), b3 + hstep, voffB); PG8_STAGE(PG8_SA(1, 0), a3, voffA);
            PG8_WAIT_V(8); PG8_WAIT_L(0); PG8_BAR; PG8_MMA(1, 0, At, B0); PG8_MMA(1, 1, At, B1); PG8_BAR; PG8_SCHED;
            } else {
            PG8_LDB(B0, 0, 0); PG8_SCHED; PG8_LDA(At, 0, 0); PG8_STAGE(PG8_SA(1, 1), a1 + hstep, voffA);
            PG8_WAIT_L(8); PG8_BAR; PG8_WAIT_L(0); PG8_MMA(0, 0, At, B0); PG8_BAR; PG8_SCHED;
            PG8_LDB(B1, 0, 1); PG8_STAGE(PG8_SB(0, 0), b2, voffB);
            PG8_BAR; PG8_WAIT_L(0); PG8_MMA(0, 1, At, B1); PG8_BAR;
            PG8_LDA(At, 0, 1); PG8_STAGE(PG8_SA(0, 0), a2, voffA);
            PG8_BAR; PG8_WAIT_L(0); PG8_MMA(1, 0, At, B0); PG8_BAR; PG8_SCHED;
            PG8_STAGE(PG8_SB(0, 1), b2 + hstep, voffB);
            PG8_WAIT_V(6); PG8_BAR; PG8_MMA(1, 1, At, B1); PG8_BAR;
            PG8_LDB(B0, 1, 0); PG8_SCHED; PG8_LDA(At, 1, 0); PG8_STAGE(PG8_SA(0, 1), a2 + hstep, voffA);
            PG8_WAIT_L(8); PG8_BAR; PG8_WAIT_L(0); PG8_MMA(0, 0, At, B0); PG8_BAR; PG8_SCHED;
            PG8_LDB(B1, 1, 1); PG8_STAGE(PG8_SB(1, 0), b3, voffB);
            PG8_BAR; PG8_WAIT_L(0); PG8_MMA(0, 1, At, B1); PG8_BAR;
            PG8_LDA(At, 1, 1); PG8_STAGE(PG8_SA(1, 0), a3, voffA);
            PG8_BAR; PG8_WAIT_L(0); PG8_MMA(1, 0, At, B0); PG8_BAR; PG8_SCHED;
            PG8_STAGE(PG8_SB(1, 1), b3 + hstep, voffB);
            PG8_WAIT_V(6); PG8_BAR; PG8_MMA(1, 1, At, B1); PG8_BAR;
            }
        }
        if constexpr (ALIGN_EPI) { if (wr == 0) PG8_BAR; }
        if constexpr (!Epi::AFTER_DRAIN) { E(acc, cur, wr, wc, fr, fq); S.done(cur); }
        if (!has_next) break;
#pragma unroll
        for (int a = 0; a < 2; ++a)
#pragma unroll
            for (int b = 0; b < 2; ++b)
#pragma unroll
                for (int m = 0; m < 4; ++m)
#pragma unroll
                    for (int n = 0; n < 2; ++n) acc[a][b][m][n] = (f32x4){0.f, 0.f, 0.f, 0.f};
        cur = nxt; cA = nA; cB = nB; ++ui;
        if constexpr (ALIGN_EPI) { if (wr == 1) PG8_BAR; }
    }
    PG8_WAIT_V(0);
    if constexpr (!ALIGN_EPI) { if (wr == 0) PG8_BAR; }
    PG8_BAR;
    if constexpr (Epi::AFTER_DRAIN) { E.fused(acc, cur, wr, wc, fr, fq, lds, wid, lane); S.done(cur); }
#undef PG8_SA
#undef PG8_SB
#undef PG8_STAGE
#undef PG8_LDA
#undef PG8_LDB
#undef PG8_MMA
#undef PG8_WAIT_V
#undef PG8_WAIT_L
#undef PG8_BAR
#undef PG8_SCHED
}
}

#ifndef PG8_SP2
#define PG8_SP2 true
#endif
#ifndef PG8_ALIGN
#define PG8_ALIGN true
#endif
#ifndef MK_PER_PHASE
#define MK_PER_PHASE 0
#endif

constexpr int NWAVES = 8;
constexpr int DM = 2048, BATCH = 2, SEQ = 8192, M = BATCH * SEQ, DEPTH = 4;
constexpr int HD = 128, HK = 16, HV = 32, KDIM = 2048, VDIM = 4096, QKV = 8192;
constexpr int DNP = 12352, DNP_MAIN = 12288;
constexpr int FF = 5632;
constexpr float LN_EPS = 1e-5f, RMS_EPS = 1e-6f;
constexpr float ALPHA = 1.6817928305074290f;
#ifndef DN_CHUNKED
#define DN_CHUNKED 1
#endif
constexpr int N_PHASES = 35;

constexpr size_t MiB = 1u << 20;
constexpr size_t WS_CTL = 0, CTL_ZERO_BYTES = 1 * MiB;
constexpr size_t WS_W_SCIN = 1 * MiB;
constexpr size_t WS_W_SCOUT = WS_W_SCIN + 48 * MiB;
constexpr size_t WS_W_DNIN = WS_W_SCOUT + 16 * MiB;
constexpr size_t WS_W_BA = WS_W_DNIN + 96 * MiB;
constexpr size_t WS_W_DNOUT = WS_W_BA + 1 * MiB;
constexpr size_t WS_W_GU = WS_W_DNOUT + 32 * MiB;
constexpr size_t WS_W_DOWN = WS_W_GU + 176 * MiB;
constexpr size_t WS_XB = WS_W_DOWN + 88 * MiB;
constexpr size_t WS_BIGA = WS_XB + 64 * MiB;
constexpr size_t WS_QKV = WS_BIGA, WS_Z = WS_BIGA + 256 * MiB, WS_O = WS_BIGA;
constexpr size_t WS_GB = WS_BIGA, WS_CU = WS_BIGA + 64 * MiB, WS_A2 = WS_BIGA + 128 * MiB, WS_HID = WS_BIGA;
constexpr size_t WS_BIGB = WS_BIGA + 384 * MiB;
constexpr size_t WS_QC = WS_BIGB, WS_KC = WS_BIGB + 64 * MiB, WS_VC = WS_BIGB + 128 * MiB, WS_A3 = WS_BIGB + 256 * MiB, WS_H1 = WS_BIGB;
constexpr size_t WS_BA = WS_BIGB + 384 * MiB;
constexpr size_t WS_BETA = WS_BA + 4 * MiB, WS_DEC = WS_BETA + 2 * MiB;
constexpr size_t WS_GL = WS_DEC + 2 * MiB;
constexpr size_t WS_KF = WS_GL + 2 * MiB;
constexpr size_t WS_SC = WS_KF + 64 * MiB;
constexpr size_t WS_END = WS_SC + 8 * MiB;
constexpr size_t WS_WF = WS_BIGA, WS_UF = WS_BIGA + 128 * MiB, WS_QF = WS_BIGB + 256 * MiB, WS_AQKF = WS_BIGB + 320 * MiB;
constexpr size_t WS_WF2 = WS_BIGB, WS_UF2 = WS_BIGB + 128 * MiB;
static_assert(WS_END <= (size_t)1476395008ull, "d_ws map exceeds the guaranteed workspace");
constexpr int CW_BAR = 4096;

constexpr int RING_OFF = 0, RING_BYTES = 131072;
constexpr int LDSCTL_OFF = RING_BYTES, MISC_OFF = LDSCTL_OFF + 320, PTAB_OFF = LDSCTL_OFF + 1024;
constexpr int LDS_BYTES = 147456;

#define GAS __attribute__((address_space(1)))
#define LAS __attribute__((address_space(3)))
typedef unsigned short bf16;
typedef unsigned v4u __attribute__((ext_vector_type(4)));
typedef unsigned v2u __attribute__((ext_vector_type(2)));
typedef float f32x4 __attribute__((ext_vector_type(4)));
typedef float f32x16 __attribute__((ext_vector_type(16)));
typedef short bf16x8 __attribute__((ext_vector_type(8)));
typedef GAS unsigned gu32;
#define RLX_AGENT __ATOMIC_RELAXED, __HIP_MEMORY_SCOPE_AGENT
#define LDS_WAIT() asm volatile("s_waitcnt lgkmcnt(0)" ::: "memory")
#define VM_WAIT() asm volatile("s_waitcnt vmcnt(0)" ::: "memory")
__device__ __forceinline__ unsigned pk2(float lo, float hi) { return pg8::cvt_pk_bf16(lo, hi); }
__device__ __forceinline__ float bf_lo(unsigned w) { return __uint_as_float(w << 16); }
__device__ __forceinline__ float bf_hi(unsigned w) { return __uint_as_float(w & 0xffff0000u); }
__device__ __forceinline__ float silu_f(float v) { return v * __builtin_amdgcn_rcpf(1.0f + __expf(-v)); }
#define XB_TMO      128
#define XB_XCNT(j)  (256  + 64 * (j))
#define XB_XSUB(j)  (1280 + 64 * (j))
#define XB_XGEN(j)  (2304 + 64 * (j))
#define XB_TOP      3328
#define XB_TOPGEN   3392
#define XCD_BAR_WORDS 3456
#define XB_SPIN_CAP (1u << 21)

__device__ __forceinline__ unsigned xb_ld(unsigned* p)              { return __hip_atomic_load(p, __ATOMIC_RELAXED, __HIP_MEMORY_SCOPE_AGENT); }
__device__ __forceinline__ unsigned xb_add(unsigned* p, unsigned v) { return __hip_atomic_fetch_add(p, v, __ATOMIC_RELAXED, __HIP_MEMORY_SCOPE_AGENT); }
__device__ __forceinline__ unsigned xb_xcc_id() { return (unsigned)__builtin_amdgcn_s_getreg((3 << 11) | 20) & 0xFu; }
#define XB_SPIN(cond, bar) do { unsigned _sp = 0; while (cond) { __builtin_amdgcn_s_sleep(1); \
    if ((++_sp & 255u) == 0u) { if (xb_ld(&(bar)[XB_TMO])) break; if (_sp > XB_SPIN_CAP) { atomicAdd(&(bar)[XB_TMO], 1u); break; } } } } while (0)

struct XcdBarrier {
    unsigned* bar; unsigned x;
    volatile LAS unsigned* st;
};

__device__ __forceinline__ XcdBarrier xcd_barrier_post(unsigned* bar, volatile LAS unsigned* st) {
    XcdBarrier b; b.bar = bar; b.x = xb_xcc_id(); b.st = st;
    if (threadIdx.x == 0) (void)xb_add(&bar[XB_XCNT(b.x)], 1u);
    return b;
}
__device__ __forceinline__ void xcd_barrier_complete(unsigned* bar, unsigned x, unsigned& nloc, unsigned& nx) {
    const unsigned G = gridDim.x * gridDim.y * gridDim.z;
    unsigned sum, cnt, mine, sp = 0u;
    for (;;) {
        sum = 0u; cnt = 0u; mine = 0u;
#pragma unroll
        for (unsigned j = 0; j < 16; ++j) { const unsigned c = xb_ld(&bar[XB_XCNT(j)]); sum += c; cnt += (c > 0u) ? 1u : 0u; mine = (j == x) ? c : mine; }
        if (sum == G) break;
        __builtin_amdgcn_s_sleep(1);
        if ((++sp & 255u) == 0u) { if (xb_ld(&bar[XB_TMO])) break; if (sp > XB_SPIN_CAP) { atomicAdd(&bar[XB_TMO], 1u); break; } }
    }
    nloc = mine > 0u ? mine : 1u; nx = cnt > 0u ? cnt : 1u;
}

__device__ __forceinline__ void xcd_barrier(const XcdBarrier& b) {
    asm volatile("s_waitcnt vmcnt(0)" ::: "memory");
    __syncthreads();
    if (threadIdx.x == 0) {
        unsigned* bar = b.bar;
        __builtin_amdgcn_s_waitcnt(0);
        unsigned nloc = b.st[0], nx = b.st[1];
        if (nloc == 0u) { xcd_barrier_complete(bar, b.x, nloc, nx); b.st[0] = nloc; b.st[1] = nx; }
        const unsigned old = xb_add(&bar[XB_XSUB(b.x)], 1u);
        const unsigned gen = old / nloc;
        if (old + 1u == (gen + 1u) * nloc) {
            __builtin_amdgcn_fence(__ATOMIC_RELEASE, "agent");
            asm volatile("s_waitcnt vmcnt(0)" ::: "memory");
            const unsigned og = xb_add(&bar[XB_TOP], 1u);
            const unsigned tg = og / nx;
            if (og + 1u == (tg + 1u) * nx) xb_add(&bar[XB_TOPGEN], 1u);
            else XB_SPIN(xb_ld(&bar[XB_TOPGEN]) == tg, bar);
            __builtin_amdgcn_fence(__ATOMIC_ACQUIRE, "agent");
            xb_add(&bar[XB_XGEN(b.x)], 1u);
            asm volatile("s_waitcnt vmcnt(0)" ::: "memory");
        } else {
            XB_SPIN(xb_ld(&bar[XB_XGEN(b.x)]) == gen, bar);
            __builtin_amdgcn_fence(__ATOMIC_ACQUIRE, "agent");
            asm volatile("s_waitcnt vmcnt(0)" ::: "memory");
        }
    }
    __syncthreads();
}

__device__ __forceinline__ float wave_sum(float v) {
#pragma unroll
    for (int o = 1; o < 64; o <<= 1) v += __shfl_xor(v, o);
    return v;
}
__device__ __forceinline__ float sum16(float v) {
    v += __shfl_xor(v, 1); v += __shfl_xor(v, 2); v += __shfl_xor(v, 4); v += __shfl_xor(v, 8);
    return v;
}
template <int CTRL> __device__ __forceinline__ float dppf(float v) { return __builtin_bit_cast(float, __builtin_amdgcn_update_dpp(0, __builtin_bit_cast(int, v), CTRL, 0xF, 0xF, false)); }
__device__ __forceinline__ float rowsum16(float v) {
    v += dppf<0x128>(v); v += dppf<0x124>(v); v += dppf<0x122>(v); v += dppf<0x121>(v);
    return v;
}
__device__ __forceinline__ void unpack8(const v4u w, float (&f)[8]) {
    f[0] = bf_lo(w.x); f[1] = bf_hi(w.x); f[2] = bf_lo(w.y); f[3] = bf_hi(w.y); f[4] = bf_lo(w.z); f[5] = bf_hi(w.z); f[6] = bf_lo(w.w); f[7] = bf_hi(w.w);
}
__device__ __forceinline__ v4u pack8(const float (&f)[8]) { v4u o; o.x = pk2(f[0], f[1]); o.y = pk2(f[2], f[3]); o.z = pk2(f[4], f[5]); o.w = pk2(f[6], f[7]); return o; }

__device__ __forceinline__ void p0_transpose_item(const float* W, int ldw, int src_col0, bf16* WT, int K, int dst_row0, int k0, LAS float* scr, int lane) {
    float tv[32];
#pragma unroll
    for (int i = 0; i < 32; ++i) tv[i] = W[(size_t)(k0 + 2 * i + (lane >> 5)) * ldw + src_col0 + (lane & 31)];
#pragma unroll
    for (int i = 0; i < 32; ++i) scr[(2 * i + (lane >> 5)) * 33 + (lane & 31)] = tv[i];
    LDS_WAIT(); asm volatile("" ::: "memory");
    const int c = lane & 7;
#pragma unroll
    for (int j = 0; j < 4; ++j) { const int n = (lane >> 3) + 8 * j; const LAS float* s = scr + (8 * c) * 33 + n;
        v4u o; o.x = pk2(s[0 * 33], s[1 * 33]); o.y = pk2(s[2 * 33], s[3 * 33]); o.z = pk2(s[4 * 33], s[5 * 33]); o.w = pk2(s[6 * 33], s[7 * 33]);
        *(GAS v4u*)(WT + (size_t)(dst_row0 + n) * K + k0 + 8 * c) = o; }
    LDS_WAIT(); asm volatile("" ::: "memory");
}

struct Ptrs {
    const float *x, *sc_w_in, *sc_conv_w, *sc_w_out, *dn_w_in, *dn_conv_w, *dn_a_log, *dn_dt_bias, *dn_norm_w, *dn_w_out, *ffn_gu, *ffn_down, *ln_gain, *ln_bias;
    float* out; unsigned char* ws;
};

__device__ __forceinline__ void p0_prologue(const Ptrs& P, LAS unsigned char* lds, int gw, int NGW, int wave, int lane) {
    LAS float* scr = (LAS float*)(lds + RING_OFF + wave * 16384);
    constexpr int I_SCIN = 32 * 192, I_SCOUT = 32 * 64, I_DNIN = 32 * 384, I_BA = 32 * 2, I_DNOUT = 64 * 64, I_GU = 32 * 352, I_DOWN = 88 * 64;
    constexpr int NITEMS = 2 * (I_SCIN + I_SCOUT + I_DNIN + I_BA + I_DNOUT) + 4 * (I_GU + I_DOWN);
    for (int it = gw; it < NITEMS; it += NGW) {
        int r = it; const float* W; int ldw, K, nblk, mode; bf16* WT; int layer;
        if (r < 2 * I_SCIN) { layer = r / I_SCIN; r -= layer * I_SCIN; W = P.sc_w_in + (size_t)layer * DM * 3 * DM; ldw = 3 * DM; K = DM; nblk = 192; mode = 1; WT = (bf16*)(P.ws + WS_W_SCIN) + (size_t)layer * 3 * DM * DM; }
        else { r -= 2 * I_SCIN;
        if (r < 2 * I_SCOUT) { layer = r / I_SCOUT; r -= layer * I_SCOUT; W = P.sc_w_out + (size_t)layer * DM * DM; ldw = DM; K = DM; nblk = 64; mode = 0; WT = (bf16*)(P.ws + WS_W_SCOUT) + (size_t)layer * DM * DM; }
        else { r -= 2 * I_SCOUT;
        if (r < 2 * I_DNIN) { layer = r / I_DNIN; r -= layer * I_DNIN; W = P.dn_w_in + (size_t)layer * DM * DNP; ldw = DNP; K = DM; nblk = 384; mode = 0; WT = (bf16*)(P.ws + WS_W_DNIN) + (size_t)layer * DNP_MAIN * DM; }
        else { r -= 2 * I_DNIN;
        if (r < 2 * I_BA) { layer = r / I_BA; r -= layer * I_BA; W = P.dn_w_in + (size_t)layer * DM * DNP; ldw = DNP; K = DM; nblk = 2; mode = 3; WT = (bf16*)(P.ws + WS_W_BA) + (size_t)layer * 64 * DM; }
        else { r -= 2 * I_BA;
        if (r < 2 * I_DNOUT) { layer = r / I_DNOUT; r -= layer * I_DNOUT; W = P.dn_w_out + (size_t)layer * VDIM * DM; ldw = DM; K = VDIM; nblk = 64; mode = 0; WT = (bf16*)(P.ws + WS_W_DNOUT) + (size_t)layer * DM * VDIM; }
        else { r -= 2 * I_DNOUT;
        if (r < 4 * I_GU) { layer = r / I_GU; r -= layer * I_GU; W = P.ffn_gu + (size_t)layer * DM * 2 * FF; ldw = 2 * FF; K = DM; nblk = 352; mode = 2; WT = (bf16*)(P.ws + WS_W_GU) + (size_t)layer * 2 * FF * DM; }
        else { r -= 4 * I_GU; layer = r / I_DOWN; r -= layer * I_DOWN; W = P.ffn_down + (size_t)layer * FF * DM; ldw = DM; K = FF; nblk = 64; mode = 0; WT = (bf16*)(P.ws + WS_W_DOWN) + (size_t)layer * DM * FF; } } } } } }
        const int kb = r / nblk, nb = r % nblk, n0 = 32 * nb;
        int src;
        if (mode == 0) src = n0;
        else if (mode == 1) { if (n0 < DM) src = n0; else { const int n2 = n0 - DM; src = DM + ((n2 >> 7) & 1) * DM + (n2 >> 8) * 128 + (n2 & 127); } }
        else if (mode == 2) src = ((n0 >> 7) & 1) * FF + (n0 >> 8) * 128 + (n0 & 127);
        else src = DNP_MAIN + n0;
        p0_transpose_item(W, ldw, src, WT, K, n0, 64 * kb, scr, lane);
    }
    bf16* XB = (bf16*)(P.ws + WS_XB);
    for (int m = gw; m < M; m += NGW) {
        const GAS f32x4* xr = (const GAS f32x4*)(P.x + (size_t)m * DM) + lane;
        GAS v2u* o8 = (GAS v2u*)(XB + (size_t)m * DM) + lane;
#pragma unroll
        for (int j = 0; j < 8; ++j) { const f32x4 v = xr[64 * j]; v2u o; o.x = pk2(v.x, v.y); o.y = pk2(v.z, v.w); o8[64 * j] = o; }
    }
}

__device__ __forceinline__ void ln_phase(const float* xin, const bf16* H, const float* gain, const float* bias, float* xout, bf16* XB, int gw, int NGW, int lane) {
    f32x4 g[8], bb[8];
#pragma unroll
    for (int j = 0; j < 8; ++j) { g[j] = ((const GAS f32x4*)gain)[lane + 64 * j]; bb[j] = ((const GAS f32x4*)bias)[lane + 64 * j]; }
    for (int m = gw; m < M; m += NGW) {
        const GAS f32x4* xr = (const GAS f32x4*)(xin + (size_t)m * DM) + lane;
        const GAS v2u* hr = (const GAS v2u*)(H + (size_t)m * DM) + lane;
        f32x4 v[8]; float s = 0.f;
#pragma unroll
        for (int j = 0; j < 8; ++j) { const f32x4 xv = xr[64 * j]; const v2u hv = hr[64 * j];
            v[j].x = ALPHA * xv.x + bf_lo(hv.x); v[j].y = ALPHA * xv.y + bf_hi(hv.x); v[j].z = ALPHA * xv.z + bf_lo(hv.y); v[j].w = ALPHA * xv.w + bf_hi(hv.y);
            s += (v[j].x + v[j].y) + (v[j].z + v[j].w); }
        const float mean = wave_sum(s) * (1.f / DM); float s2 = 0.f;
#pragma unroll
        for (int j = 0; j < 8; ++j) { v[j] = v[j] - mean; s2 += (v[j].x * v[j].x + v[j].y * v[j].y) + (v[j].z * v[j].z + v[j].w * v[j].w); }
        const float rstd = 1.f / sqrtf(wave_sum(s2) * (1.f / DM) + LN_EPS);
        GAS f32x4* xo = (GAS f32x4*)(xout + (size_t)m * DM) + lane;
        GAS v2u* bo = (GAS v2u*)(XB + (size_t)m * DM) + lane;
#pragma unroll
        for (int j = 0; j < 8; ++j) { const f32x4 o = v[j] * rstd * g[j] + bb[j]; xo[64 * j] = o; v2u w; w.x = pk2(o.x, o.y); w.y = pk2(o.z, o.w); bo[64 * j] = w; }
    }
}

__device__ __forceinline__ void sc_conv_phase(const bf16* GB, const bf16* CU, const float* cw  , bf16* A2, int gt, int NGT) {
    constexpr int RB = 16, NCG = DM / 8, NITEMS = (M / RB) * NCG;
    for (int it = gt; it < NITEMS; it += NGT) {
        const int cgp = it % NCG, rb = it / NCG, c0 = cgp * 8, r0 = rb * RB;
        float w0[8], w1[8], w2[8];
#pragma unroll
        for (int e = 0; e < 8; e += 4) { const f32x4 a = *(const GAS f32x4*)(cw + c0 + e), b = *(const GAS f32x4*)(cw + DM + c0 + e), c = *(const GAS f32x4*)(cw + 2 * DM + c0 + e);
            w0[e] = a.x; w0[e + 1] = a.y; w0[e + 2] = a.z; w0[e + 3] = a.w; w1[e] = b.x; w1[e + 1] = b.y; w1[e + 2] = b.z; w1[e + 3] = b.w; w2[e] = c.x; w2[e + 1] = c.y; w2[e + 2] = c.z; w2[e + 3] = c.w; }
        float um2[8], um1[8];
        const bool first = (r0 % SEQ) == 0;
        if (first) {
#pragma unroll
            for (int e = 0; e < 8; ++e) { um2[e] = 0.f; um1[e] = 0.f; } }
        else { unpack8(*(const GAS v4u*)(CU + (size_t)(r0 - 2) * DM + c0), um2); unpack8(*(const GAS v4u*)(CU + (size_t)(r0 - 1) * DM + c0), um1); }
#pragma unroll 4
        for (int r = 0; r < RB; ++r) {
            float u0[8], gb[8], o[8];
            unpack8(*(const GAS v4u*)(CU + (size_t)(r0 + r) * DM + c0), u0);
            unpack8(*(const GAS v4u*)(GB + (size_t)(r0 + r) * DM + c0), gb);
#pragma unroll
            for (int e = 0; e < 8; ++e) { o[e] = gb[e] * (w0[e] * um2[e] + w1[e] * um1[e] + w2[e] * u0[e]); um2[e] = um1[e]; um1[e] = u0[e]; }
            *(GAS v4u*)(A2 + (size_t)(r0 + r) * DM + c0) = pack8(o);
        }
    }
}

__device__ __forceinline__ void dn_pre_phase(const bf16* QKVr, const float* cw  , bf16* QC, bf16* KC, bf16* VC, const float* BA, const float* a_log, const float* dt_bias, float* BETA, float* DEC, float* GL,
                                             int gw, int NGW, int lane, int gt, int NGT) {
    constexpr int RB = 8, NCG = QKV / 512, NITEMS = (M / RB) * NCG;
    for (int it = gw; it < NITEMS; it += NGW) {
        const int cgp = it % NCG, rb = it / NCG, c0 = cgp * 512 + lane * 8, r0 = rb * RB;
        float w[4][8];
#pragma unroll
        for (int j = 0; j < 4; ++j)
#pragma unroll
            for (int e = 0; e < 8; e += 4) { const f32x4 a = *(const GAS f32x4*)(cw + (size_t)j * QKV + c0 + e); w[j][e] = a.x; w[j][e + 1] = a.y; w[j][e + 2] = a.z; w[j][e + 3] = a.w; }
        float h3[8], h2[8], h1[8];
        const bool first = (r0 % SEQ) == 0;
        if (first) {
#pragma unroll
            for (int e = 0; e < 8; ++e) { h3[e] = 0.f; h2[e] = 0.f; h1[e] = 0.f; } }
        else { unpack8(*(const GAS v4u*)(QKVr + (size_t)(r0 - 3) * QKV + c0), h3); unpack8(*(const GAS v4u*)(QKVr + (size_t)(r0 - 2) * QKV + c0), h2); unpack8(*(const GAS v4u*)(QKVr + (size_t)(r0 - 1) * QKV + c0), h1); }
        bf16* dst; int ldd, cd; float qs = 1.f; bool norm;
        if (c0 < KDIM) { dst = QC; ldd = KDIM; cd = c0; norm = true; qs = 0.08838834764831845f; }
        else if (c0 < 2 * KDIM) { dst = KC; ldd = KDIM; cd = c0 - KDIM; norm = true; }
        else { dst = VC; ldd = VDIM; cd = c0 - 2 * KDIM; norm = false; }
        v4u rowv[RB];
#pragma unroll
        for (int r = 0; r < RB; ++r) rowv[r] = *(const GAS v4u*)(QKVr + (size_t)(r0 + r) * QKV + c0);
#pragma unroll
        for (int r = 0; r < RB; ++r) {
            float u0[8], o[8]; float ss = 0.f;
            unpack8(rowv[r], u0);
#pragma unroll
            for (int e = 0; e < 8; ++e) { const float c = w[0][e] * h3[e] + w[1][e] * h2[e] + w[2][e] * h1[e] + w[3][e] * u0[e]; o[e] = silu_f(c); ss += o[e] * o[e]; h3[e] = h2[e]; h2[e] = h1[e]; h1[e] = u0[e]; }
            if (norm) { ss = sum16(ss); const float sc = qs / sqrtf(ss + RMS_EPS);
#pragma unroll
                for (int e = 0; e < 8; ++e) o[e] *= sc; }
            *(GAS v4u*)(dst + (size_t)(r0 + r) * ldd + cd) = pack8(o);
        }
    }
    for (int i = gt; i < M * HV; i += NGT) {
        const int hv = i & (HV - 1), row = i >> 5;
        const float br = BA[(size_t)row * 64 + hv], ar = BA[(size_t)row * 64 + HV + hv];
        const float xx = ar + dt_bias[hv];
        const float sp = fmaxf(xx, 0.f) + log1pf(__expf(-fabsf(xx)));
        const float gg = -__expf(a_log[hv]) * sp;
        BETA[i] = 1.f / (1.f + __expf(-br));
        DEC[i] = __expf(gg);
        GL[i] = gg;
    }
}

__device__ __forceinline__ void ba_phase(const bf16* XB, const bf16* Wba, float* BA, LAS unsigned char* lds, int unit, int wave, int lane) {
    const int mt = wave & 1, nt = (wave >> 1) & 1, kh = wave >> 2, r = lane & 31, h = lane >> 5;
    const bf16* ap = XB + (size_t)(unit * 64 + mt * 32 + r) * DM + kh * 1024 + 8 * h;
    const bf16* bp = Wba + (size_t)(nt * 32 + r) * DM + kh * 1024 + 8 * h;
    f32x16 acc = {};
#pragma unroll 8
    for (int ks = 0; ks < 64; ++ks) {
        const bf16x8 a = *(const GAS bf16x8*)(ap + ks * 16), b = *(const GAS bf16x8*)(bp + ks * 16);
        acc = __builtin_amdgcn_mfma_f32_32x32x16_bf16(a, b, acc, 0, 0, 0);
    }
    LAS float* red = (LAS float*)(lds + RING_OFF);
    if (kh == 1) {
#pragma unroll
        for (int i = 0; i < 16; ++i) red[((wave - 4) * 16 + i) * 64 + lane] = acc[i]; }
    __syncthreads();
    if (kh == 0) {
#pragma unroll
        for (int i = 0; i < 16; ++i) { const float v = acc[i] + red[(wave * 16 + i) * 64 + lane];
            const int row = unit * 64 + mt * 32 + (i & 3) + 8 * (i >> 2) + 4 * h;
            BA[(size_t)row * 64 + nt * 32 + r] = v; } }
    __syncthreads();
}

__device__ __forceinline__ void dn_naive_phase(const bf16* QC, const bf16* KC, const bf16* VC, const float* BETA, const float* DEC, float* O, LAS unsigned char* lds, int unit, int tid) {
    constexpr int CT = 32, NCH = SEQ / CT;
    constexpr int BUF = 16384 + 16384 + 4096 + 256;
    const int bh = unit >> 2, vq = unit & 3, b = bh >> 5, hv = bh & 31, hk = hv >> 1;
    const int vl = tid >> 4, p = tid & 15;
    LAS float* ob = (LAS float*)(lds + 2 * BUF);
    const size_t row0 = (size_t)b * SEQ;
    const int lr = tid >> 4, lp = tid & 15;
    const bf16* qsrc = QC + (row0 + lr) * KDIM + hk * HD + lp * 8;
    const bf16* ksrc = KC + (row0 + lr) * KDIM + hk * HD + lp * 8;
    const int vr = (tid & 127) >> 2, vp = tid & 3;
    const bf16* vsrc = VC + (row0 + vr) * VDIM + hv * HD + vq * 32 + vp * 8;
    const float* gsrc = (tid < 32 ? BETA : DEC) + (row0 + (tid & 31)) * HV + hv;
    v4u rq, rk, rv = {0u, 0u, 0u, 0u}; float rg = 0.f;
    rq = *(const GAS v4u*)qsrc; rk = *(const GAS v4u*)ksrc; if (tid < 128) rv = *(const GAS v4u*)vsrc; if (tid < 64) rg = *gsrc;
    float S[8];
#pragma unroll
    for (int i = 0; i < 8; ++i) S[i] = 0.f;
    for (int c = 0; c < NCH; ++c) {
        LAS unsigned char* buf = lds + (c & 1) * BUF;
        { float f[8]; unpack8(rq, f); LAS f32x4* d = (LAS f32x4*)(buf + (lr * 128 + lp * 8) * 4); d[0] = (f32x4){f[0], f[1], f[2], f[3]}; d[1] = (f32x4){f[4], f[5], f[6], f[7]};
          unpack8(rk, f); d = (LAS f32x4*)(buf + 16384 + (lr * 128 + lp * 8) * 4); d[0] = (f32x4){f[0], f[1], f[2], f[3]}; d[1] = (f32x4){f[4], f[5], f[6], f[7]};
          if (tid < 128) { unpack8(rv, f); d = (LAS f32x4*)(buf + 32768 + (vr * 32 + vp * 8) * 4); d[0] = (f32x4){f[0], f[1], f[2], f[3]}; d[1] = (f32x4){f[4], f[5], f[6], f[7]}; }
          if (tid < 64) ((LAS float*)(buf + 36864))[tid] = rg; }
        __syncthreads();
        if (c + 1 < NCH) { const size_t adv = (size_t)(c + 1) * CT;
            rq = *(const GAS v4u*)(qsrc + adv * KDIM); rk = *(const GAS v4u*)(ksrc + adv * KDIM); if (tid < 128) rv = *(const GAS v4u*)(vsrc + adv * VDIM); if (tid < 64) rg = gsrc[adv * HV]; }
        const LAS float* qf = (const LAS float*)buf; const LAS float* kf = (const LAS float*)(buf + 16384); const LAS float* vf = (const LAS float*)(buf + 32768); const LAS float* gf = (const LAS float*)(buf + 36864);
#pragma unroll 4
        for (int tt = 0; tt < CT; ++tt) {
            const f32x4 k0 = *(const LAS f32x4*)(kf + tt * 128 + 8 * p), k1 = *(const LAS f32x4*)(kf + tt * 128 + 8 * p + 4);
            const f32x4 q0 = *(const LAS f32x4*)(qf + tt * 128 + 8 * p), q1 = *(const LAS f32x4*)(qf + tt * 128 + 8 * p + 4);
            const float vt = vf[tt * 32 + vl], bt = gf[tt], at = gf[32 + tt];
            float pred = (S[0] * k0.x + S[1] * k0.y) + (S[2] * k0.z + S[3] * k0.w) + (S[4] * k1.x + S[5] * k1.y) + (S[6] * k1.z + S[7] * k1.w);
            pred = rowsum16(pred);
            const float delta = bt * (vt - at * pred);
            S[0] = at * S[0] + k0.x * delta; S[1] = at * S[1] + k0.y * delta; S[2] = at * S[2] + k0.z * delta; S[3] = at * S[3] + k0.w * delta;
            S[4] = at * S[4] + k1.x * delta; S[5] = at * S[5] + k1.y * delta; S[6] = at * S[6] + k1.z * delta; S[7] = at * S[7] + k1.w * delta;
            float o = (S[0] * q0.x + S[1] * q0.y) + (S[2] * q0.z + S[3] * q0.w) + (S[4] * q1.x + S[5] * q1.y) + (S[6] * q1.z + S[7] * q1.w);
            o = rowsum16(o);
            if (p == 0) ob[tt * 32 + vl] = o;
        }
        __syncthreads();
        if (tid < 256) { const int orow = tid >> 3, oc = (tid & 7) * 4; const f32x4 v = *(const LAS f32x4*)(ob + orow * 32 + oc);
            *(GAS f32x4*)(O + (row0 + (size_t)c * CT + orow) * VDIM + hv * HD + vq * 32 + oc) = v; }
    }
    __syncthreads();
}


constexpr int PL_Q = 0, PL_KT = 16384, PL_K = 32768, PL_V = 49152, PL_A = 81920, PL_SM = 114688, PL_WST = 0;
__device__ __forceinline__ int rm_addr(int row, int col) { return row * 256 + (((col >> 3) ^ (row & 15)) << 4) + (col & 7) * 2; }
__device__ __forceinline__ int kt_addr(int d, int c) { return d * 128 + (((c >> 2) ^ (d & 15)) << 3) + (c & 3) * 2; }
__device__ __forceinline__ int rowof(int rho, int h) { return (rho & 3) + 8 * (rho >> 2) + 4 * h; }
__device__ __forceinline__ unsigned short bf1(float v) { return (unsigned short)(pk2(v, v) & 0xffffu); }

__device__ __forceinline__ void dn_prep_item(const bf16* QKVr, const float* cw  , const float* BA, const float* a_log, const float* dt_bias, bf16* Wf, bf16* Qf, bf16* Kf, bf16* AQKf, bf16* Uf, float* SC,
                                             LAS unsigned char* lds, int item, int tid, int wave, int lane) {
    asm volatile("" : "+v"(tid), "+v"(lane));
    const int chunk = item & 127, bk = item >> 7, hk = bk & 15, b = bk >> 4;
    const size_t tok0 = (size_t)b * SEQ + (size_t)chunk * 64;
    const size_t ki = (size_t)item;
    const int r = lane & 31, h = lane >> 5;
    LAS float* betl = (LAS float*)(lds + PL_SM);
    LAS float* gcl_ = (LAS float*)(lds + PL_SM + 512);
    LAS float* facl = (LAS float*)(lds + PL_SM + 1024);
    {   int c0, run, kind;
        if (tid < 256) { const int tq = tid & 127; kind = tid >> 7; run = tq >> 4; c0 = kind * KDIM + hk * HD + (tq & 15) * 8; }
        else { const int tv = tid - 256; kind = 2; run = tv >> 5; c0 = 2 * KDIM + hk * 2 * HD + (tv & 31) * 8; }
        const int lc = (kind == 2) ? (tid & 31) * 8 : (tid & 15) * 8;
        float w[4][8];
#pragma unroll
        for (int j = 0; j < 4; ++j)
#pragma unroll
            for (int e = 0; e < 8; e += 4) { const f32x4 a = *(const GAS f32x4*)(cw + (size_t)j * QKV + c0 + e); w[j][e] = a.x; w[j][e + 1] = a.y; w[j][e + 2] = a.z; w[j][e + 3] = a.w; }
        const size_t rr0 = tok0 + run * 8;
        const bool first = (chunk == 0) && (run == 0);
        v4u rowv[11];
#pragma unroll
        for (int q = 0; q < 11; ++q) rowv[q] = (first && q < 3) ? (v4u){0u, 0u, 0u, 0u} : *(const GAS v4u*)(QKVr + (rr0 + q - 3) * QKV + c0);
        float h3[8], h2[8], h1[8];
        unpack8(rowv[0], h3); unpack8(rowv[1], h2); unpack8(rowv[2], h1);
        const float qs = (kind == 0) ? 0.08838834764831845f : 1.0f;
#pragma unroll
        for (int q = 0; q < 8; ++q) {
            float u0[8], o[8]; float ss = 0.f;
            unpack8(rowv[3 + q], u0);
#pragma unroll
            for (int e = 0; e < 8; ++e) { const float c = w[0][e] * h3[e] + w[1][e] * h2[e] + w[2][e] * h1[e] + w[3][e] * u0[e]; o[e] = silu_f(c); ss += o[e] * o[e]; h3[e] = h2[e]; h2[e] = h1[e]; h1[e] = u0[e]; }
            ss = sum16(ss);
            const float sc = (kind == 2) ? 1.0f : qs / sqrtf(ss + RMS_EPS);
#pragma unroll
            for (int e = 0; e < 8; ++e) o[e] *= sc;
            const v4u pv = pack8(o); const int row = run * 8 + q;
            if (kind == 0) *(LAS v4u*)(lds + PL_Q + rm_addr(row, lc)) = pv;
            else if (kind == 1) { *(LAS v4u*)(lds + PL_K + rm_addr(row, lc)) = pv;
                const unsigned kw[4] = {pv.x, pv.y, pv.z, pv.w};
#pragma unroll
                for (int e2 = 0; e2 < 8; ++e2) *(LAS unsigned short*)(lds + PL_KT + kt_addr(lc + e2, row)) = (unsigned short)((kw[e2 >> 1] >> ((e2 & 1) * 16)) & 0xffffu); }
            else *(LAS v4u*)(lds + PL_V + (lc >> 7) * 16384 + row * 256 + (lc & 127) * 2) = pv;
        }
    }
    if (wave < 2) { const int hv = 2 * hk + wave; const size_t tk = tok0 + lane;
        const float br = BA[tk * 64 + hv], ar = BA[tk * 64 + HV + hv];
        const float xx = ar + dt_bias[hv];
        const float sp = fmaxf(xx, 0.f) + log1pf(__expf(-fabsf(xx)));
        const float bt = 1.f / (1.f + __expf(-br)); float gc = -__expf(a_log[hv]) * sp;
#pragma unroll
        for (int o = 1; o < 64; o <<= 1) { const float t = __shfl_up(gc, o); if (lane >= o) gc += t; }
        const float gl = __shfl(gc, 63);
        betl[wave * 64 + lane] = bt; gcl_[wave * 64 + lane] = gc; const float eg = __expf(gc);
        facl[(wave * 2 + 0) * 64 + lane] = bt; facl[(wave * 2 + 1) * 64 + lane] = bt * eg;
        float* sc = SC + ((size_t)(b * HV + hv) * 128 + chunk) * 256;
        sc[lane] = eg; sc[64 + lane] = __expf(gl - gc); if (lane == 0) sc[128] = __expf(gl); }
    LDS_WAIT(); __syncthreads();
    {   f32x16 acc = {};
        if (wave < 4) { const int tc = wave >> 1, tm = wave & 1;
#pragma unroll
            for (int ks = 0; ks < 8; ++ks) { const bf16x8 a = *(const LAS bf16x8*)(lds + PL_K + rm_addr(32 * tc + r, 16 * ks + 8 * h)), bb = *(const LAS bf16x8*)(lds + PL_K + rm_addr(32 * tm + r, 16 * ks + 8 * h));
                acc = __builtin_amdgcn_mfma_f32_32x32x16_bf16(a, bb, acc, 0, 0, 0); }
#pragma unroll
            for (int hvl = 0; hvl < 2; ++hvl) { const int m = 32 * tm + r; const float gm = gcl_[hvl * 64 + m];
#pragma unroll
                for (int rho = 0; rho < 16; ++rho) { const int c = 32 * tc + rowof(rho, h); const float e = __expf(fminf(gcl_[hvl * 64 + c] - gm, 0.f));
                    const float val = (c > m) ? betl[hvl * 64 + c] * acc[rho] * e : 0.f;
                    *(LAS float*)(lds + PL_A + hvl * 16384 + (c * 64 + m) * 4) = val; } }
        } else { const int tm = (wave - 4) >> 1, tcp = (wave - 4) & 1;
#pragma unroll
            for (int ks = 0; ks < 8; ++ks) { const bf16x8 a = *(const LAS bf16x8*)(lds + PL_K + rm_addr(32 * tm + r, 16 * ks + 8 * h)), bb = *(const LAS bf16x8*)(lds + PL_Q + rm_addr(32 * tcp + r, 16 * ks + 8 * h));
                acc = __builtin_amdgcn_mfma_f32_32x32x16_bf16(a, bb, acc, 0, 0, 0); }
#pragma unroll
            for (int hvl = 0; hvl < 2; ++hvl) { const int cp = 32 * tcp + r; const float gp = gcl_[hvl * 64 + cp]; float val[16];
#pragma unroll
                for (int rho = 0; rho < 16; ++rho) { const int m = 32 * tm + rowof(rho, h); const float e = __expf(fminf(gp - gcl_[hvl * 64 + m], 0.f)); val[rho] = (cp >= m) ? acc[rho] * e : 0.f; }
                bf16* dst = AQKf + ((size_t)(b * HV + 2 * hk + hvl) * 128 + chunk) * 4096 + ((tcp * 2 + tm) * 2) * 512 + lane * 8;
                v4u w0, w1; w0.x = pk2(val[0], val[1]); w0.y = pk2(val[2], val[3]); w0.z = pk2(val[4], val[5]); w0.w = pk2(val[6], val[7]);
                w1.x = pk2(val[8], val[9]); w1.y = pk2(val[10], val[11]); w1.z = pk2(val[12], val[13]); w1.w = pk2(val[14], val[15]);
                *(GAS v4u*)dst = w0; *(GAS v4u*)(dst + 512) = w1; } }
#pragma unroll
        for (int e = 0; e < 2; ++e) { const int f = 2 * wave + e;
            { const int t = f >> 3, i = (f >> 1) & 3, s = f & 1, row = 32 * t + r, col0 = 32 * i + 16 * s + 4 * h;
              const v2u lo = *(const LAS v2u*)(lds + PL_Q + rm_addr(row, col0)), hi = *(const LAS v2u*)(lds + PL_Q + rm_addr(row, col0 + 8));
              *(GAS v4u*)(Qf + ki * 8192 + f * 512 + lane * 8) = (v4u){lo.x, lo.y, hi.x, hi.y}; }
            { const int i = f >> 2, t = (f >> 1) & 1, s = f & 1, d = 32 * i + r, c0 = 32 * t + 16 * s + 4 * h;
              const v2u lo = *(const LAS v2u*)(lds + PL_KT + kt_addr(d, c0)), hi = *(const LAS v2u*)(lds + PL_KT + kt_addr(d, c0 + 8));
              *(GAS v4u*)(Kf + ki * 8192 + f * 512 + lane * 8) = (v4u){lo.x, lo.y, hi.x, hi.y}; } }
    }
    LDS_WAIT(); __syncthreads();
    {   const int hvl = wave >> 2, q4 = wave & 3; const bool isw = q4 >= 2; const int col = 64 * (q4 & 1) + lane;
        const LAS float* Am = (const LAS float*)(lds + PL_A + hvl * 16384);
        const LAS float* fc = facl + (hvl * 2 + (isw ? 1 : 0)) * 64;
        float X[64]; f32x4 ar[2][16];
        ar[1][0] = *(const LAS f32x4*)(Am + 64);
#pragma unroll
        for (int i = 0; i < 64; ++i) {
            const int sa = isw ? (PL_K + rm_addr(i, col)) : (PL_V + hvl * 16384 + i * 256 + col * 2);
            const float rv = __uint_as_float((unsigned)(*(const LAS unsigned short*)(lds + sa)) << 16), fv = fc[i];
            if (i + 1 < 64) {
#pragma unroll
                for (int c = 0; c < (i + 1 + 3) / 4; ++c) ar[(i + 1) & 1][c] = *(const LAS f32x4*)(Am + (i + 1) * 64 + 4 * c); }
            __builtin_amdgcn_sched_barrier(0);
            float acc = fv * rv, acc1 = 0.f, acc2 = 0.f, acc3 = 0.f;
#pragma unroll
            for (int j0 = 0; j0 < i; j0 += 4) { const f32x4 a = ar[i & 1][j0 >> 2];
                acc -= a.x * X[j0]; if (j0 + 1 < i) acc1 -= a.y * X[j0 + 1]; if (j0 + 2 < i) acc2 -= a.z * X[j0 + 2]; if (j0 + 3 < i) acc3 -= a.w * X[j0 + 3]; }
            X[i] = (acc + acc1) + (acc2 + acc3);
            __builtin_amdgcn_sched_barrier(0); }
        const size_t ci = (size_t)(b * HV + 2 * hk + hvl) * 128 + chunk;
        if (!isw) { const int jd = col >> 5, dl = col & 31;
#pragma unroll
            for (int t = 0; t < 2; ++t)
#pragma unroll
                for (int hh = 0; hh < 2; ++hh) { v4u w0, w1;
                    w0.x = pk2(X[32 * t + rowof(0, hh)], X[32 * t + rowof(1, hh)]); w0.y = pk2(X[32 * t + rowof(2, hh)], X[32 * t + rowof(3, hh)]); w0.z = pk2(X[32 * t + rowof(4, hh)], X[32 * t + rowof(5, hh)]); w0.w = pk2(X[32 * t + rowof(6, hh)], X[32 * t + rowof(7, hh)]);
                    w1.x = pk2(X[32 * t + rowof(8, hh)], X[32 * t + rowof(9, hh)]); w1.y = pk2(X[32 * t + rowof(10, hh)], X[32 * t + rowof(11, hh)]); w1.z = pk2(X[32 * t + rowof(12, hh)], X[32 * t + rowof(13, hh)]); w1.w = pk2(X[32 * t + rowof(14, hh)], X[32 * t + rowof(15, hh)]);
                    bf16* dst = Uf + ci * 8192 + (size_t)(((jd * 2 + t) * 64 + hh * 32 + dl) * 16);
                    *(GAS v4u*)dst = w0; *(GAS v4u*)(dst + 8) = w1; }
        } else {
#pragma unroll
            for (int i = 0; i < 64; ++i) *(LAS unsigned short*)(lds + PL_WST + hvl * 16384 + rm_addr(i, col)) = bf1(-X[i]);
        }
    }
    LDS_WAIT(); __syncthreads();
#pragma unroll
    for (int e = 0; e < 4; ++e) { const int idx = wave * 4 + e, hvl = idx >> 4, f = idx & 15, t = f >> 3, i = (f >> 1) & 3, s = f & 1, row = 32 * t + r, col0 = 32 * i + 16 * s + 4 * h;
        const v2u lo = *(const LAS v2u*)(lds + PL_WST + hvl * 16384 + rm_addr(row, col0)), hi = *(const LAS v2u*)(lds + PL_WST + hvl * 16384 + rm_addr(row, col0 + 8));
        *(GAS v4u*)(Wf + ((size_t)(b * HV + 2 * hk + hvl) * 128 + chunk) * 8192 + f * 512 + lane * 8) = (v4u){lo.x, lo.y, hi.x, hi.y}; }
    LDS_WAIT(); __syncthreads();
}

__device__ __forceinline__ void dn_scan_phase(const bf16* Wf, const bf16* Qf, const bf16* Kf, const bf16* AQKf, const bf16* Uf, const float* SC, float* O, LAS unsigned char* lds, int unit, int wave, int lane) {
    constexpr int BUFB = 58368, NST = SEQ / 64;
    const int bh = unit >> 2, jd = unit & 3, b = bh >> 5, hv = bh & 31, hk = hv >> 1;
    const size_t ci0 = (size_t)(b * HV + hv) * 128, ki0 = (size_t)(b * HK + hk) * 128;
    const int r = lane & 31, h = lane >> 5;
    if (wave > 0) {
        const bf16* src; size_t stride;
        if (wave <= 2) { src = Wf + ci0 * 8192 + (wave - 1) * 4096; stride = 8192; }
        else if (wave <= 4) { src = Qf + ki0 * 8192 + (wave - 3) * 4096; stride = 8192; }
        else if (wave <= 6) { src = Kf + ki0 * 8192 + (wave - 5) * 4096; stride = 8192; }
        else { src = AQKf + ci0 * 4096; stride = 4096; }
        src += lane * 8;
        const float* ssrc = SC + ci0 * 256 + lane * 4;
        const int dofs = (wave - 1) * 8192 + lane * 16;
        v4u RA[8], RB[8]; f32x4 RsA = {0.f, 0.f, 0.f, 0.f}, RsB = {0.f, 0.f, 0.f, 0.f};
#define LD_SET(R, Rs, st) do { const bf16* sp_ = src + (size_t)(st) * stride; _Pragma("unroll") for (int e = 0; e < 8; ++e) R[e] = *(const GAS v4u*)(sp_ + e * 512); if (wave == 1) Rs = *(const GAS f32x4*)(ssrc + (size_t)(st) * 256); } while (0)
#define ST_SET(R, Rs, st) do { LAS unsigned char* bp_ = lds + ((st) & 1) * BUFB; _Pragma("unroll") for (int e = 0; e < 8; ++e) *(LAS v4u*)(bp_ + dofs + e * 1024) = R[e]; if (wave == 1) *(LAS f32x4*)(bp_ + 57344 + lane * 16) = Rs; } while (0)
        LD_SET(RA, RsA, 0); ST_SET(RA, RsA, 0);
        LD_SET(RA, RsA, 1); LD_SET(RB, RsB, 2);
        for (int n = 0; n < NST; n += 2) {
            LDS_WAIT(); __builtin_amdgcn_s_barrier(); asm volatile("" ::: "memory");
            if (n + 1 < NST) ST_SET(RA, RsA, n + 1);
            if (n + 3 < NST) LD_SET(RA, RsA, n + 3);
            LDS_WAIT(); __builtin_amdgcn_s_barrier(); asm volatile("" ::: "memory");
            if (n + 2 < NST) ST_SET(RB, RsB, n + 2);
            if (n + 4 < NST) LD_SET(RB, RsB, n + 4);
        }
#undef LD_SET
#undef ST_SET
    } else {
        f32x16 S0 = {}, S1 = {}, S2 = {}, S3 = {};
        const bf16* usrc = Uf + ci0 * 8192 + (size_t)((jd * 2) * 64 + lane) * 16;
        v4u un[4];
        un[0] = *(const GAS v4u*)usrc; un[1] = *(const GAS v4u*)(usrc + 8); un[2] = *(const GAS v4u*)(usrc + 1024); un[3] = *(const GAS v4u*)(usrc + 1032);
        GAS float* obase = (GAS float*)(O + ((size_t)b * SEQ) * VDIM + hv * HD + jd * 32 + r);
#define MF(a, bq, c) __builtin_amdgcn_mfma_f32_32x32x16_bf16(a, bq, c, 0, 0, 0)
#define FRAG(off) (*(const LAS bf16x8*)(bp + (off) + lane * 16))
#define PK8(V, s) __builtin_bit_cast(bf16x8, (v4u){pk2(V[8 * (s) + 0], V[8 * (s) + 1]), pk2(V[8 * (s) + 2], V[8 * (s) + 3]), pk2(V[8 * (s) + 4], V[8 * (s) + 5]), pk2(V[8 * (s) + 6], V[8 * (s) + 7])})
#define SBAR() __builtin_amdgcn_sched_barrier(0)
#define RD4(D, o0, o1, o2, o3) do { D[0] = FRAG(o0); D[1] = FRAG(o1); D[2] = FRAG(o2); D[3] = FRAG(o3); } while (0)
#define WF(f) ((f) * 1024)
#define QF(f) (16384 + (f) * 1024)
#define KF(f) (32768 + (f) * 1024)
#define AF(f) (49152 + (f) * 1024)
        for (int n = 0; n < NST; ++n) {
            LDS_WAIT(); __builtin_amdgcn_s_barrier(); asm volatile("" ::: "memory");
            const LAS unsigned char* bp = lds + (n & 1) * BUFB;
            const LAS float* scl = (const LAS float*)(bp + 57344);
            bf16x8 X[4], Y[4];
            RD4(X, WF(0), WF(1), WF(2), WF(3));
            f32x16 P0, P1;
            { float uu[8]; unpack8(un[0], uu);
#pragma unroll
              for (int e = 0; e < 8; ++e) P0[e] = uu[e];
              unpack8(un[1], uu);
#pragma unroll
              for (int e = 0; e < 8; ++e) P0[8 + e] = uu[e];
              unpack8(un[2], uu);
#pragma unroll
              for (int e = 0; e < 8; ++e) P1[e] = uu[e];
              unpack8(un[3], uu);
#pragma unroll
              for (int e = 0; e < 8; ++e) P1[8 + e] = uu[e]; }
            if (n + 1 < NST) { const bf16* up = usrc + (size_t)(n + 1) * 8192; un[0] = *(const GAS v4u*)up; un[1] = *(const GAS v4u*)(up + 8); un[2] = *(const GAS v4u*)(up + 1024); un[3] = *(const GAS v4u*)(up + 1032); }
            const bf16x8 Sb00 = PK8(S0, 0), Sb01 = PK8(S0, 1), Sb10 = PK8(S1, 0), Sb11 = PK8(S1, 1), Sb20 = PK8(S2, 0), Sb21 = PK8(S2, 1), Sb30 = PK8(S3, 0), Sb31 = PK8(S3, 1);
            SBAR();
            RD4(Y, WF(4), WF(5), WF(6), WF(7));
            P0 = MF(X[0], Sb00, P0); P0 = MF(X[1], Sb01, P0); P0 = MF(X[2], Sb10, P0); P0 = MF(X[3], Sb11, P0);
            SBAR();
            RD4(X, WF(8), WF(9), WF(10), WF(11));
            P0 = MF(Y[0], Sb20, P0); P0 = MF(Y[1], Sb21, P0); P0 = MF(Y[2], Sb30, P0); P0 = MF(Y[3], Sb31, P0);
            SBAR();
            RD4(Y, WF(12), WF(13), WF(14), WF(15));
            P1 = MF(X[0], Sb00, P1); P1 = MF(X[1], Sb01, P1); P1 = MF(X[2], Sb10, P1); P1 = MF(X[3], Sb11, P1);
            SBAR();
            RD4(X, QF(0), QF(1), QF(2), QF(3));
            P1 = MF(Y[0], Sb20, P1); P1 = MF(Y[1], Sb21, P1); P1 = MF(Y[2], Sb30, P1); P1 = MF(Y[3], Sb31, P1);
            bf16x8 Vb00, Vb01, Ve00, Ve01, Vb10, Vb11, Ve10, Ve11;
            { float E[16];
#pragma unroll
              for (int g = 0; g < 4; ++g) { const f32x4 k0 = *(const LAS f32x4*)(scl + 64 + 8 * g + 4 * h);
                  E[4 * g + 0] = P0[4 * g + 0] * k0.x; E[4 * g + 1] = P0[4 * g + 1] * k0.y; E[4 * g + 2] = P0[4 * g + 2] * k0.z; E[4 * g + 3] = P0[4 * g + 3] * k0.w; }
              Vb00 = PK8(P0, 0); Vb01 = PK8(P0, 1); Ve00 = PK8(E, 0); Ve01 = PK8(E, 1); }
            SBAR();
            RD4(Y, QF(4), QF(5), QF(6), QF(7));
            f32x16 oa0 = {}, oa1 = {};
            oa0 = MF(X[0], Sb00, oa0); oa0 = MF(X[1], Sb01, oa0); oa0 = MF(X[2], Sb10, oa0); oa0 = MF(X[3], Sb11, oa0);
            { float E[16];
#pragma unroll
              for (int g = 0; g < 4; ++g) { const f32x4 k1 = *(const LAS f32x4*)(scl + 64 + 32 + 8 * g + 4 * h);
                  E[4 * g + 0] = P1[4 * g + 0] * k1.x; E[4 * g + 1] = P1[4 * g + 1] * k1.y; E[4 * g + 2] = P1[4 * g + 2] * k1.z; E[4 * g + 3] = P1[4 * g + 3] * k1.w; }
              Vb10 = PK8(P1, 0); Vb11 = PK8(P1, 1); Ve10 = PK8(E, 0); Ve11 = PK8(E, 1); }
            SBAR();
            RD4(X, QF(8), QF(9), QF(10), QF(11));
            oa0 = MF(Y[0], Sb20, oa0); oa0 = MF(Y[1], Sb21, oa0); oa0 = MF(Y[2], Sb30, oa0); oa0 = MF(Y[3], Sb31, oa0);
            SBAR();
            RD4(Y, QF(12), QF(13), QF(14), QF(15));
            oa1 = MF(X[0], Sb00, oa1); oa1 = MF(X[1], Sb01, oa1); oa1 = MF(X[2], Sb10, oa1); oa1 = MF(X[3], Sb11, oa1);
            SBAR();
            RD4(X, AF(0), AF(1), AF(4), AF(5));
            oa1 = MF(Y[0], Sb20, oa1); oa1 = MF(Y[1], Sb21, oa1); oa1 = MF(Y[2], Sb30, oa1); oa1 = MF(Y[3], Sb31, oa1);
            SBAR();
            bf16x8 Z[2]; Z[0] = FRAG(AF(6)); Z[1] = FRAG(AF(7));
#pragma unroll
            for (int g = 0; g < 4; ++g) { const f32x4 e0 = *(const LAS f32x4*)(scl + 8 * g + 4 * h), e1 = *(const LAS f32x4*)(scl + 32 + 8 * g + 4 * h);
                oa0[4 * g + 0] *= e0.x; oa0[4 * g + 1] *= e0.y; oa0[4 * g + 2] *= e0.z; oa0[4 * g + 3] *= e0.w;
                oa1[4 * g + 0] *= e1.x; oa1[4 * g + 1] *= e1.y; oa1[4 * g + 2] *= e1.z; oa1[4 * g + 3] *= e1.w; }
            oa0 = MF(X[0], Vb00, oa0); oa0 = MF(X[1], Vb01, oa0);
            oa1 = MF(X[2], Vb00, oa1); oa1 = MF(X[3], Vb01, oa1);
            const float cd = scl[128];
            S0 = S0 * cd; S1 = S1 * cd; S2 = S2 * cd; S3 = S3 * cd;
            SBAR();
            RD4(X, KF(0), KF(1), KF(2), KF(3));
            oa1 = MF(Z[0], Vb10, oa1); oa1 = MF(Z[1], Vb11, oa1);
            { const size_t orow = (size_t)n * 64;
#pragma unroll
              for (int rho = 0; rho < 16; ++rho) obase[(orow + rowof(rho, h)) * VDIM] = oa0[rho]; }
            SBAR();
            RD4(Y, KF(4), KF(5), KF(6), KF(7));
            S0 = MF(X[0], Ve00, S0); S0 = MF(X[1], Ve01, S0); S0 = MF(X[2], Ve10, S0); S0 = MF(X[3], Ve11, S0);
            { const size_t orow = (size_t)n * 64 + 32;
#pragma unroll
              for (int rho = 0; rho < 16; ++rho) obase[(orow + rowof(rho, h)) * VDIM] = oa1[rho]; }
            SBAR();
            RD4(X, KF(8), KF(9), KF(10), KF(11));
            S1 = MF(Y[0], Ve00, S1); S1 = MF(Y[1], Ve01, S1); S1 = MF(Y[2], Ve10, S1); S1 = MF(Y[3], Ve11, S1);
            SBAR();
            RD4(Y, KF(12), KF(13), KF(14), KF(15));
            S2 = MF(X[0], Ve00, S2); S2 = MF(X[1], Ve01, S2); S2 = MF(X[2], Ve10, S2); S2 = MF(X[3], Ve11, S2);
            SBAR();
            S3 = MF(Y[0], Ve00, S3); S3 = MF(Y[1], Ve01, S3); S3 = MF(Y[2], Ve10, S3); S3 = MF(Y[3], Ve11, S3);
            SBAR();
        }
#undef SBAR
#undef RD4
#undef WF
#undef QF
#undef KF
#undef AF
#undef MF
#undef FRAG
#undef PK8
    }
    LDS_WAIT(); __syncthreads();
}

__device__ __forceinline__ void dn_gnorm_phase(const float* O, const bf16* Z, const float* nw, bf16* A3, int gw, int NGW, int lane) {
    constexpr int NCG = VDIM / 512, NITEMS = M * NCG;
    float wv[8];
    { const f32x4 a = *(const GAS f32x4*)(nw + (lane & 15) * 8), b = *(const GAS f32x4*)(nw + (lane & 15) * 8 + 4); wv[0] = a.x; wv[1] = a.y; wv[2] = a.z; wv[3] = a.w; wv[4] = b.x; wv[5] = b.y; wv[6] = b.z; wv[7] = b.w; }
#pragma unroll 4
    for (int it = gw; it < NITEMS; it += NGW) {
        const int cgp = it % NCG, row = it / NCG, c0 = cgp * 512 + lane * 8;
        const f32x4 a = *(const GAS f32x4*)(O + (size_t)row * VDIM + c0), b = *(const GAS f32x4*)(O + (size_t)row * VDIM + c0 + 4);
        float z[8]; unpack8(*(const GAS v4u*)(Z + (size_t)row * VDIM + c0), z);
        float o[8] = {a.x, a.y, a.z, a.w, b.x, b.y, b.z, b.w};
        float ss = 0.f;
#pragma unroll
        for (int e = 0; e < 8; ++e) ss += o[e] * o[e];
        ss = sum16(ss);
        const float rs = 1.f / sqrtf(ss * (1.f / HD) + RMS_EPS);
#pragma unroll
        for (int e = 0; e < 8; ++e) o[e] = o[e] * rs * wv[e] * silu_f(z[e]);
        *(GAS v4u*)(A3 + (size_t)row * VDIM + c0) = pack8(o);
    }
}

struct Args { const float* in[14]; float* out; unsigned char* ws; int ph_lo, ph_hi, li, pad; };
__device__ __forceinline__ unsigned long long ptab_get(LAS unsigned char* lds, int i) {
    volatile LAS unsigned* p = (volatile LAS unsigned*)(lds + PTAB_OFF) + 2 * i;
    const unsigned lo = __builtin_amdgcn_readfirstlane(p[0]), hi = __builtin_amdgcn_readfirstlane(p[1]);
    return ((unsigned long long)hi << 32) | lo;
}
#ifndef REP_MASK
#define REP_MASK 0
#endif
#define REPS(t) for (int rep_ = 0; rep_ < 1 + ((REP_MASK >> (t)) & 1); ++rep_)
#define PIN(i) ((const float*)ptab_get(lds, (i)))
#define POUT ((float*)ptab_get(lds, 14))
#define PWS ((unsigned char*)ptab_get(lds, 15))
#define LOCAL_IDS int tid = threadIdx.x; asm volatile("" : "+v"(tid)); const int lane = tid & 63, wave = __builtin_amdgcn_readfirstlane(tid >> 6); const int G = gridDim.x, bx = blockIdx.x; \
    const int vcu = (G % 8 == 0) ? (bx % 8) * (G / 8) + bx / 8 : bx; const int gw = vcu * NWAVES + wave, NGW = G * NWAVES, gt = vcu * (NWAVES * 64) + tid, NGT = G * NWAVES * 64; \
    unsigned char* const ws = PWS; (void)lane; (void)gw; (void)NGW; (void)gt; (void)NGT; (void)ws
__global__ void __launch_bounds__(NWAVES * 64, 2) fwd(Args args) {
    extern __shared__ __attribute__((aligned(16))) unsigned char lds_raw[];
    LAS unsigned char* lds = (LAS unsigned char*)lds_raw;
    volatile LAS unsigned* MISC = (volatile LAS unsigned*)(lds + MISC_OFF);
    for (int u = threadIdx.x; u < (LDS_BYTES - LDSCTL_OFF) / 4; u += NWAVES * 64) ((LAS unsigned*)(lds + LDSCTL_OFF))[u] = 0u;
    __syncthreads();
    if (threadIdx.x == 0) {
        LAS unsigned long long* pt = (LAS unsigned long long*)(lds + PTAB_OFF);
#pragma unroll
        for (int i = 0; i < 14; ++i) pt[i] = (unsigned long long)args.in[i];
        pt[14] = (unsigned long long)args.out; pt[15] = (unsigned long long)args.ws;
    }
    __syncthreads();
    if (threadIdx.x == 0) { LAS unsigned* pw = (LAS unsigned*)(lds + PTAB_OFF) + 32; pw[0] = (unsigned)args.ph_lo; pw[1] = (unsigned)args.ph_hi; }
    if (!MK_PER_PHASE) (void)xcd_barrier_post((unsigned*)(args.ws + WS_CTL) + CW_BAR, MISC + 8);
    __syncthreads();
#define PH_LO ((int)__builtin_amdgcn_readfirstlane(((volatile LAS unsigned*)(lds + PTAB_OFF))[32]))
#define PH_HI ((int)__builtin_amdgcn_readfirstlane(((volatile LAS unsigned*)(lds + PTAB_OFF))[33]))
#define IN(k) (PH_LO <= (k) && (k) < PH_HI)
#define SEAM(k) do { if (!MK_PER_PHASE) { if (IN(k) && IN((k) + 1)) { XcdBarrier bar_; bar_.bar = (unsigned*)(PWS + WS_CTL) + CW_BAR; bar_.x = xb_xcc_id(); bar_.st = MISC + 8; xcd_barrier(bar_); } } } while (0)

    if (IN(0)) REPS(0) { LOCAL_IDS; Ptrs P; P.x = PIN(0); P.sc_w_in = PIN(1); P.sc_w_out = PIN(3); P.dn_w_in = PIN(4); P.dn_w_out = PIN(9); P.ffn_gu = PIN(10); P.ffn_down = PIN(11); P.ws = ws;
        p0_prologue(P, lds, gw, NGW, wave, lane); }
    SEAM(0);

    for (int L = 0; L < DEPTH; ++L) {
        const int j = L >> 1;
        const int pb = 1 + 17 * j + ((L & 1) ? 7 : 0);
        int fb;
        if ((L & 1) == 0) {
            if (IN(pb + 0)) REPS(1) {
                LOCAL_IDS;
                pg8::Gemm g{(const bf16*)(ws + WS_XB), (const bf16*)(ws + WS_W_SCIN) + (size_t)j * 3 * DM * DM, M, 3 * DM, DM}; pg8::StaticOrder S; S.init(M, 3 * DM, G, bx);
                pg8::EpiGate<0> E{(bf16*)(ws + WS_GB), DM, (bf16*)(ws + WS_CU), DM, DM / 256};
                pg8::gemm_phase<pg8::EpiGate<0>, pg8::StaticOrder, PG8_ALIGN, PG8_SP2>(lds + RING_OFF, g, S, E);
            }
            SEAM(pb + 0);
            if (IN(pb + 1)) REPS(2) { LOCAL_IDS; sc_conv_phase((const bf16*)(ws + WS_GB), (const bf16*)(ws + WS_CU), PIN(2) + (size_t)j * 3 * DM, (bf16*)(ws + WS_A2), gt, NGT); }
            SEAM(pb + 1);
            if (IN(pb + 2)) REPS(3) {
                LOCAL_IDS;
                pg8::Gemm g{(const bf16*)(ws + WS_A2), (const bf16*)(ws + WS_W_SCOUT) + (size_t)j * DM * DM, M, DM, DM}; pg8::StaticOrder S; S.init(M, DM, G, bx);
                pg8::EpiStore2 E{(bf16*)(ws + WS_H1), DM, (bf16*)(ws + WS_H1), DM, 1 << 30};
                pg8::gemm_phase<pg8::EpiStore2, pg8::StaticOrder, PG8_ALIGN, PG8_SP2>(lds + RING_OFF, g, S, E);
            }
            SEAM(pb + 2);
            if (IN(pb + 3)) { LOCAL_IDS; ln_phase((L == 0) ? PIN(0) : (const float*)POUT, (const bf16*)(ws + WS_H1), PIN(12) + (size_t)(L * 2) * DM, PIN(13) + (size_t)(L * 2) * DM, POUT, (bf16*)(ws + WS_XB), gw, NGW, lane); }
            SEAM(pb + 3);
            fb = pb + 4;
        } else {
            if (IN(pb + 0)) REPS(5) {
                LOCAL_IDS;
                pg8::Gemm g{(const bf16*)(ws + WS_XB), (const bf16*)(ws + WS_W_DNIN) + (size_t)j * DNP_MAIN * DM, M, DNP_MAIN, DM}; pg8::StaticOrder S; S.init(M, DNP_MAIN, G, bx);
                pg8::EpiStore2 E{(bf16*)(ws + WS_QKV), QKV, (bf16*)(ws + WS_Z), VDIM, QKV};
                pg8::gemm_phase<pg8::EpiStore2, pg8::StaticOrder, PG8_ALIGN, PG8_SP2>(lds + RING_OFF, g, S, E);
            }
            if (IN(pb + 0)) {
                LOCAL_IDS;
                for (int u = bx; u < M / 64; u += G) ba_phase((const bf16*)(ws + WS_XB), (const bf16*)(ws + WS_W_BA) + (size_t)j * 64 * DM, (float*)(ws + WS_BA), lds, u, wave, lane);
            }
            SEAM(pb + 0);
#if DN_CHUNKED
            if (IN(pb + 2)) REPS(7) { LOCAL_IDS; for (int it = vcu; it < BATCH * HK * (SEQ / 64); it += G)
                dn_prep_item((const bf16*)(ws + WS_QKV), PIN(5) + (size_t)j * 4 * QKV, (const float*)(ws + WS_BA), PIN(6) + j * HV, PIN(7) + j * HV,
                             (bf16*)(ws + WS_WF2), (bf16*)(ws + WS_QF), (bf16*)(ws + WS_KF), (bf16*)(ws + WS_AQKF), (bf16*)(ws + WS_UF2), (float*)(ws + WS_SC), lds, it, tid, wave, lane); }
            SEAM(pb + 2);
            if (IN(pb + 3)) REPS(12) { LOCAL_IDS; for (int u = vcu; u < BATCH * HV * 4; u += G)
                dn_scan_phase((const bf16*)(ws + WS_WF2), (const bf16*)(ws + WS_QF), (const bf16*)(ws + WS_KF), (const bf16*)(ws + WS_AQKF), (const bf16*)(ws + WS_UF2), (const float*)(ws + WS_SC), (float*)(ws + WS_O), lds, u, wave, lane); }
            SEAM(pb + 3);
            if (IN(pb + 4)) REPS(8) { LOCAL_IDS; dn_gnorm_phase((const float*)(ws + WS_O), (const bf16*)(ws + WS_Z), PIN(8) + j * HD, (bf16*)(ws + WS_A3), gw, NGW, lane); }
#else
            if (IN(pb + 1)) REPS(6) { LOCAL_IDS; dn_pre_phase((const bf16*)(ws + WS_QKV), PIN(5) + (size_t)j * 4 * QKV, (bf16*)(ws + WS_QC), (bf16*)(ws + WS_KC), (bf16*)(ws + WS_VC), (const float*)(ws + WS_BA), PIN(6) + j * HV, PIN(7) + j * HV,
                                                       (float*)(ws + WS_BETA), (float*)(ws + WS_DEC), (float*)(ws + WS_GL), gw, NGW, lane, gt, NGT); }
            SEAM(pb + 1);
            if (IN(pb + 2)) REPS(7) { LOCAL_IDS; for (int u = vcu; u < BATCH * HV * 4; u += G) dn_naive_phase((const bf16*)(ws + WS_QC), (const bf16*)(ws + WS_KC), (const bf16*)(ws + WS_VC), (const float*)(ws + WS_BETA), (const float*)(ws + WS_DEC), (float*)(ws + WS_O), lds, u, tid); }
            SEAM(pb + 2);
            SEAM(pb + 3);
            if (IN(pb + 4)) REPS(8) { LOCAL_IDS; dn_gnorm_phase((const float*)(ws + WS_O), (const bf16*)(ws + WS_Z), PIN(8) + j * HD, (bf16*)(ws + WS_A3), gw, NGW, lane); }
#endif
            SEAM(pb + 4);
            if (IN(pb + 5)) REPS(9) {
                LOCAL_IDS;
                pg8::Gemm g{(const bf16*)(ws + WS_A3), (const bf16*)(ws + WS_W_DNOUT) + (size_t)j * DM * VDIM, M, DM, VDIM}; pg8::StaticOrder S; S.init(M, DM, G, bx);
                pg8::EpiStore2 E{(bf16*)(ws + WS_H1), DM, (bf16*)(ws + WS_H1), DM, 1 << 30};
                pg8::gemm_phase<pg8::EpiStore2, pg8::StaticOrder, PG8_ALIGN, PG8_SP2>(lds + RING_OFF, g, S, E);
            }
            SEAM(pb + 5);
            if (IN(pb + 6)) { LOCAL_IDS; ln_phase((const float*)POUT, (const bf16*)(ws + WS_H1), PIN(12) + (size_t)(L * 2) * DM, PIN(13) + (size_t)(L * 2) * DM, POUT, (bf16*)(ws + WS_XB), gw, NGW, lane); }
            SEAM(pb + 6);
            fb = pb + 7;
        }
        if (IN(fb + 0)) REPS(10) {
            LOCAL_IDS;
            pg8::Gemm g{(const bf16*)(ws + WS_XB), (const bf16*)(ws + WS_W_GU) + (size_t)L * 2 * FF * DM, M, 2 * FF, DM}; pg8::StaticOrder S; S.init(M, 2 * FF, G, bx);
            pg8::EpiGate<1> E{(bf16*)(ws + WS_HID), FF, (bf16*)(ws + WS_HID), FF, 0};
            pg8::gemm_phase<pg8::EpiGate<1>, pg8::StaticOrder, PG8_ALIGN, PG8_SP2>(lds + RING_OFF, g, S, E);
        }
        SEAM(fb + 0);
        if (IN(fb + 1)) REPS(11) {
            LOCAL_IDS;
            pg8::Gemm g{(const bf16*)(ws + WS_HID), (const bf16*)(ws + WS_W_DOWN) + (size_t)L * DM * FF, M, DM, FF}; pg8::StaticOrder S; S.init(M, DM, G, bx);
            pg8::EpiStore2 E{(bf16*)(ws + WS_H1), DM, (bf16*)(ws + WS_H1), DM, 1 << 30};
            pg8::gemm_phase<pg8::EpiStore2, pg8::StaticOrder, PG8_ALIGN, PG8_SP2>(lds + RING_OFF, g, S, E);
        }
        SEAM(fb + 1);
        if (IN(fb + 2)) { LOCAL_IDS; ln_phase((const float*)POUT, (const bf16*)(ws + WS_H1), PIN(12) + (size_t)(L * 2 + 1) * DM, PIN(13) + (size_t)(L * 2 + 1) * DM, POUT, (bf16*)(ws + WS_XB), gw, NGW, lane); }
        SEAM(fb + 2);
    }
#undef IN
#undef SEAM
}

extern "C" void kernel_launch(void* const* d_in, const int* in_sizes, int n_in, void* d_out, int out_size, void* d_ws, size_t ws_size, hipStream_t stream) {
    static int grid = 0;
    if (grid == 0) {
        if (n_in != 14 || in_sizes[0] != M * DM || out_size != M * DM || ws_size < WS_END) { fprintf(stderr, "kernel_launch: unexpected shapes (n_in %d, in0 %d, out %d, ws %zu < %zu); nothing launched\n", n_in, n_in > 0 ? in_sizes[0] : -1, out_size, ws_size, (size_t)WS_END); grid = -1; return; }
        int dev = 0, cus = 0, per_cu = 0;
        if (hipGetDevice(&dev) != hipSuccess || hipDeviceGetAttribute(&cus, hipDeviceAttributeMultiprocessorCount, dev) != hipSuccess) { grid = -1; return; }
        if (hipFuncSetAttribute((const void*)fwd, hipFuncAttributeMaxDynamicSharedMemorySize, LDS_BYTES) != hipSuccess) { fprintf(stderr, "kernel_launch: hipFuncSetAttribute failed\n"); grid = -1; return; }
        if (hipOccupancyMaxActiveBlocksPerMultiprocessor(&per_cu, (const void*)fwd, NWAVES * 64, LDS_BYTES) != hipSuccess || per_cu < 1) fprintf(stderr, "kernel_launch: occupancy query reports %d\n", per_cu);
        (void)hipGetLastError();
        grid = cus;
        if (grid > 256) grid = 256;
    }
    if (grid < 0) return;
    if (hipMemsetAsync((char*)d_ws + WS_CTL, 0, CTL_ZERO_BYTES, stream) != hipSuccess) return;
    Args a{};
    for (int i = 0; i < 14; ++i) a.in[i] = (const float*)d_in[i];
    a.out = (float*)d_out; a.ws = (unsigned char*)d_ws;
#if MK_PER_PHASE
    for (int p = 0; p < N_PHASES; ++p) { a.ph_lo = p; a.ph_hi = p + 1; a.li = p; hipLaunchKernelGGL(fwd, dim3(grid), dim3(NWAVES * 64), LDS_BYTES, stream, a); }
#else
    a.ph_lo = 0; a.ph_hi = N_PHASES; a.li = 0;
    hipLaunchKernelGGL(fwd, dim3(grid), dim3(NWAVES * 64), LDS_BYTES, stream, a);
#endif
}
```

```cpp
#include <hip/hip_runtime.h>
#include <cstdio>
#include <cstdint>
namespace pg8 {
#define PG8_LAS __attribute__((address_space(3)))
typedef unsigned short bf16_t;
typedef short bf16x8 __attribute__((ext_vector_type(8)));
typedef float f32x4 __attribute__((ext_vector_type(4)));
typedef unsigned u32x4 __attribute__((ext_vector_type(4)));
constexpr int BM = 256, BK = 64, HALF = 128, HTB = HALF * BK * 2  , STAGE_BYTES = 8 * HTB, NXCD = 8, WGM = 8;

__host__ __device__ __forceinline__ int lds_byte(int r, int c) { const int st = (r >> 4) * 2 + (c >> 5), rr = r & 15, cc = c & 31, ob = rr * 64 + cc * 2; return st * 1024 + (ob ^ (((ob >> 9) & 1) << 5)); }
__host__ __device__ __forceinline__ void stage_rc(int b, int& R, int& C) { const int st = b / 1024, sb = b % 1024, swz = sb ^ (((sb >> 9) & 1) << 5); R = (st >> 1) * 16 + swz / 64; C = (st & 1) * 32 + (swz % 64) / 2; }
__host__ __device__ __forceinline__ int perm32(int rho) { const int n = rho >> 4, i = rho & 15; return 8 * (i >> 2) + 4 * n + (i & 3); }

struct Unit { int pm, pn; };
struct Gemm { const bf16_t* A; const bf16_t* Bt; int M, N, K; };

struct StaticOrder {
    int nM, nN, nwg, G, c;
    __host__ __device__ void init(int M, int N, int G_, int c_) { nM = M / BM; nN = N / BM; nwg = nM * nN; G = G_; c = c_; }
    __host__ __device__ bool next(int i, Unit& u) const {
        const long L = (long)i * G + c; if (L >= nwg) return false;
        int wgid = (int)L; { const int q = nwg / NXCD, r = nwg % NXCD, xcd = wgid % NXCD, off = wgid / NXCD; wgid = (xcd < r ? xcd * (q + 1) : r * (q + 1) + (xcd - r) * q) + off; }
        const int nig = WGM * nN, gid = wgid / nig, fm = gid * WGM, gsz = (nM - fm) < WGM ? (nM - fm) : WGM;
        u.pm = fm + ((wgid % nig) % gsz); u.pn = (wgid % nig) / gsz; return true;
    }
    __device__ __forceinline__ void a_ready(const Unit&) const {}
    __device__ __forceinline__ void done(const Unit&) const {}
};


typedef float f32x2_t __attribute__((ext_vector_type(2)));
typedef __bf16 bf16x2_t __attribute__((ext_vector_type(2)));
__device__ __forceinline__ unsigned cvt_pk_bf16(float lo, float hi) { f32x2_t v = {lo, hi}; bf16x2_t b = __builtin_convertvector(v, bf16x2_t); return __builtin_bit_cast(unsigned, b); }
__device__ __forceinline__ float silu_f(float v) { return v * __builtin_amdgcn_rcpf(1.0f + __expf(-v)); }

struct EpiStore2 {
    static constexpr bool PERM = true, AFTER_DRAIN = false;
    bf16_t* O0; int ld0; bf16_t* O1; int ld1; int split;
    __device__ __forceinline__ void operator()(const f32x4 (&acc)[2][2][4][2], const Unit& u, int wr, int wc, int fr, int fq) const {
        int colt = u.pn * BM; bf16_t* base = O0; int ld = ld0;
        if (colt >= split) { base = O1; ld = ld1; colt -= split; }
        const int row0 = u.pm * BM + wr * 64 + fr, col0 = colt + wc * 32 + 8 * fq;
#pragma unroll
        for (int ai = 0; ai < 2; ++ai)
#pragma unroll
            for (int m = 0; m < 4; ++m) { bf16_t* rowp = base + (size_t)(row0 + ai * HALF + m * 16) * ld + col0;
#pragma unroll
                for (int bj = 0; bj < 2; ++bj) { const f32x4 v0 = acc[ai][bj][m][0], v1 = acc[ai][bj][m][1];
                    u32x4 w; w.x = cvt_pk_bf16(v0[0], v0[1]); w.y = cvt_pk_bf16(v0[2], v0[3]); w.z = cvt_pk_bf16(v1[0], v1[1]); w.w = cvt_pk_bf16(v1[2], v1[3]);
                    *(u32x4*)(rowp + bj * HALF) = w; } }
    }
};
template <int ACT> struct EpiGate {
    static constexpr bool PERM = true, AFTER_DRAIN = false;
    bf16_t* P; int ldp; bf16_t* G; int ldg; int pn_plain;
    __device__ __forceinline__ void operator()(const f32x4 (&acc)[2][2][4][2], const Unit& u, int wr, int wc, int fr, int fq) const {
        const int row0 = u.pm * BM + wr * 64 + fr;
        if (u.pn < pn_plain) {
            const int col0 = u.pn * BM + wc * 32 + 8 * fq;
#pragma unroll
            for (int ai = 0; ai < 2; ++ai)
#pragma unroll
                for (int m = 0; m < 4; ++m) { bf16_t* rowp = P + (size_t)(row0 + ai * HALF + m * 16) * ldp + col0;
#pragma unroll
                    for (int bj = 0; bj < 2; ++bj) { const f32x4 v0 = acc[ai][bj][m][0], v1 = acc[ai][bj][m][1];
                        u32x4 w; w.x = cvt_pk_bf16(v0[0], v0[1]); w.y = cvt_pk_bf16(v0[2], v0[3]); w.z = cvt_pk_bf16(v1[0], v1[1]); w.w = cvt_pk_bf16(v1[2], v1[3]);
                        *(u32x4*)(rowp + bj * HALF) = w; } }
        } else {
            const int col0 = (u.pn - pn_plain) * HALF + wc * 32 + 8 * fq;
#pragma unroll
            for (int ai = 0; ai < 2; ++ai)
#pragma unroll
                for (int m = 0; m < 4; ++m) { bf16_t* rowp = G + (size_t)(row0 + ai * HALF + m * 16) * ldg + col0;
                    f32x4 a0 = acc[ai][0][m][0], a1 = acc[ai][0][m][1]; const f32x4 b0 = acc[ai][1][m][0], b1 = acc[ai][1][m][1];
                    if (ACT == 1) {
#pragma unroll
                        for (int e = 0; e < 4; ++e) { a0[e] = silu_f(a0[e]); a1[e] = silu_f(a1[e]); } }
                    a0 = a0 * b0; a1 = a1 * b1;
                    u32x4 w; w.x = cvt_pk_bf16(a0[0], a0[1]); w.y = cvt_pk_bf16(a0[2], a0[3]); w.z = cvt_pk_bf16(a1[0], a1[1]); w.w = cvt_pk_bf16(a1[2], a1[3]);
                    *(u32x4*)rowp = w; }
        }
    }
};

template <class Epi, class Sched, bool ALIGN_EPI = false, bool SP2 = false>
__device__ __forceinline__ void gemm_phase(PG8_LAS unsigned char* lds, const Gemm g, const Sched& S, const Epi& E) {
    int tid_o = threadIdx.x; asm volatile("" : "+v"(tid_o));
    const int tid = tid_o, wid = __builtin_amdgcn_readfirstlane(tid >> 6), lane = tid & 63, wr = wid >> 2, wc = wid & 3, fr = lane & 15, fq = lane >> 4;
    const int K = g.K, nt = K / BK;
    unsigned voffA[2], voffB[2];
#pragma unroll
    for (int i = 0; i < 2; ++i) { int R, C; stage_rc(tid * 16 + i * 8192, R, C); const int Rb = Epi::PERM ? ((R & ~31) + perm32(R & 31)) : R;
        voffA[i] = (unsigned)(R * K + C) * 2u; voffB[i] = (unsigned)(Rb * K + C) * 2u; }
    const size_t kstep = (size_t)(BK * 2);
    const size_t hstep = (size_t)HALF * K * 2;
    const size_t tstep = 2 * hstep;
    const unsigned ldsw = (unsigned)wid * 1024u;
    const int aoff = lds_byte(wr * 64 + fr, fq * 8), boff = lds_byte(wc * 32 + fr, fq * 8);
#define PG8_SA(b, h) (((b) * 2 + (h)) * HTB)
#define PG8_SB(b, h) ((4 + (b) * 2 + (h)) * HTB)
#define PG8_STAGE(bufoff, gbase, voff) do { _Pragma("unroll") for (int _i = 0; _i < 2; ++_i) \
        __builtin_amdgcn_global_load_lds((const unsigned*)((const char*)(gbase) + (voff)[_i]), (PG8_LAS unsigned*)(lds + (bufoff) + ldsw + _i * 8192), 16, 0, 0); } while (0)
#define PG8_LDA(dst, b, h) do { _Pragma("unroll") for (int m = 0; m < 4; ++m) _Pragma("unroll") for (int k = 0; k < 2; ++k) dst[m][k] = *(const PG8_LAS bf16x8*)(lds + PG8_SA(b, h) + aoff + m * 2048 + k * 1024); } while (0)
#define PG8_LDB(dst, b, h) do { _Pragma("unroll") for (int n = 0; n < 2; ++n) _Pragma("unroll") for (int k = 0; k < 2; ++k) dst[n][k] = *(const PG8_LAS bf16x8*)(lds + PG8_SB(b, h) + boff + n * 2048 + k * 1024); } while (0)
#define PG8_MMA(ai, bj, At, Bt) do { __builtin_amdgcn_s_setprio(1); _Pragma("unroll") for (int m = 0; m < 4; ++m) _Pragma("unroll") for (int n = 0; n < 2; ++n) _Pragma("unroll") for (int k = 0; k < 2; ++k) \
        acc[ai][bj][m][n] = __builtin_amdgcn_mfma_f32_16x16x32_bf16(Bt[n][k], At[m][k], acc[ai][bj][m][n], 0, 0, 0); __builtin_amdgcn_s_setprio(0); } while (0)
#define PG8_WAIT_V(n) asm volatile("s_waitcnt vmcnt(" #n ")" ::: "memory")
#define PG8_WAIT_L(n) asm volatile("s_waitcnt lgkmcnt(" #n ")" ::: "memory")
#define PG8_BAR __builtin_amdgcn_s_barrier()
#define PG8_SCHED __builtin_amdgcn_sched_barrier(0)
    Unit cur, nxt; int ui = 0;
    if (!S.next(0, cur)) return;
    f32x4 acc[2][2][4][2];
#pragma unroll
    for (int a = 0; a < 2; ++a)
#pragma unroll
        for (int b = 0; b < 2; ++b)
#pragma unroll
            for (int m = 0; m < 4; ++m)
#pragma unroll
                for (int n = 0; n < 2; ++n) acc[a][b][m][n] = (f32x4){0.f, 0.f, 0.f, 0.f};
    bf16x8 At[4][2], B0[2][2], B1[2][2];
    const char* cA = (const char*)g.A + (size_t)cur.pm * tstep; const char* cB = (const char*)g.Bt + (size_t)cur.pn * tstep;
    S.a_ready(cur);
    if constexpr (SP2) {
        PG8_STAGE(PG8_SB(0, 0), cB, voffB); PG8_STAGE(PG8_SB(0, 1), cB + hstep, voffB); PG8_STAGE(PG8_SA(0, 0), cA, voffA); PG8_STAGE(PG8_SA(0, 1), cA + hstep, voffA);
        if (wr == 1) PG8_BAR;
        PG8_WAIT_V(2); PG8_BAR;
        PG8_STAGE(PG8_SB(1, 0), cB + kstep, voffB); PG8_STAGE(PG8_SA(1, 0), cA + kstep, voffA); PG8_STAGE(PG8_SB(1, 1), cB + hstep + kstep, voffB);
        PG8_WAIT_V(6); PG8_BAR;
    } else {
        PG8_STAGE(PG8_SB(0, 0), cB, voffB); PG8_STAGE(PG8_SA(0, 0), cA, voffA); PG8_STAGE(PG8_SB(0, 1), cB + hstep, voffB); PG8_STAGE(PG8_SA(0, 1), cA + hstep, voffA);
        if (wr == 1) PG8_BAR;
        PG8_WAIT_V(4); PG8_BAR;
        PG8_STAGE(PG8_SB(1, 0), cB + kstep, voffB); PG8_STAGE(PG8_SA(1, 0), cA + kstep, voffA); PG8_STAGE(PG8_SB(1, 1), cB + hstep + kstep, voffB);
        PG8_WAIT_V(6); PG8_BAR;
    }
    for (;;) {
        const bool has_next = S.next(ui + 1, nxt);
        const char* nA = has_next ? (const char*)g.A + (size_t)nxt.pm * tstep : cA; const char* nB = has_next ? (const char*)g.Bt + (size_t)nxt.pn * tstep : cB;
        for (int t = 0; t < nt; t += 2) {
            const bool last = (t == nt - 2);
            const char* a1 = cA + (size_t)(t + 1) * kstep;
            const char* a2 = last ? nA : cA + (size_t)(t + 2) * kstep; const char* b2 = last ? nB : cB + (size_t)(t + 2) * kstep;
            const char* a3 = a2 + kstep; const char* b3 = b2 + kstep;
            if (last && has_next) S.a_ready(nxt);
            if constexpr (SP2) {
            PG8_LDB(B0, 0, 0); PG8_LDB(B1, 0, 1); PG8_SCHED; PG8_LDA(At, 0, 0); PG8_STAGE(PG8_SA(1, 1), a1 + hstep, voffA);
            PG8_WAIT_V(8); PG8_WAIT_L(0); PG8_BAR; PG8_MMA(0, 0, At, B0); PG8_MMA(0, 1, At, B1); PG8_BAR; PG8_SCHED;
            PG8_LDA(At, 0, 1); PG8_STAGE(PG8_SB(0, 0), b2, voffB); PG8_STAGE(PG8_SB(0, 1), b2 + hstep, voffB); PG8_STAGE(PG8_SA(0, 0), a2, voffA);
            PG8_WAIT_V(8); PG8_WAIT_L(0); PG8_BAR; PG8_MMA(1, 0, At, B0); PG8_MMA(1, 1, At, B1); PG8_BAR; PG8_SCHED;
            PG8_LDB(B0, 1, 0); PG8_LDB(B1, 1, 1); PG8_SCHED; PG8_LDA(At, 1, 0); PG8_STAGE(PG8_SA(0, 1), a2 + hstep, voffA);
            PG8_WAIT_V(8); PG8_WAIT_L(0); PG8_BAR; PG8_MMA(0, 0, At, B0); PG8_MMA(0, 1, At, B1); PG8_BAR; PG8_SCHED;
            PG8_LDA(At, 1, 1); PG8_STAGE(PG8_SB(1, 0), b3, voffB); PG8_STAGE(PG8_SB(1, 1), b3 + hstep, voffB); PG8_STAGE(PG8_SA(1, 0), a3, voffA);
            PG8_WAIT_V(8); PG8_WAIT_L(0); PG8_BAR; PG8_MMA(1, 0, At, B0); PG8_MMA(1, 1, At, B1); PG8_BAR; PG8_SCHED;
            } else {
            PG8_LDB(B0, 0, 0); PG8_SCHED; PG8_LDA(At, 0, 0); PG8_STAGE(PG8_SA(1, 1), a1 + hstep, voffA);
            PG8_WAIT_L(8); PG8_BAR; PG8_WAIT_L(0); PG8_MMA(0, 0, At, B0); PG8_BAR; PG8_SCHED;
            PG8_LDB(B1, 0, 1); PG8_STAGE(PG8_SB(0, 0), b2, voffB);
            PG8_BAR; PG8_WAIT_L(0); PG8_MMA(0, 1, At, B1); PG8_BAR;
            PG8_LDA(At, 0, 1); PG8_STAGE(PG8_SA(0, 0), a2, voffA);
            PG8_BAR; PG8_WAIT_L(0); PG8_MMA(1, 0, At, B0); PG8_BAR; PG8_SCHED;
            PG8_STAGE(PG8_SB(0, 1), b2 + hstep, voffB);
            PG8_WAIT_V(6); PG8_BAR; PG8_MMA(1, 1, At, B1); PG8_BAR;
            PG8_LDB(B0, 1, 0); PG8_SCHED; PG8_LDA(At, 1, 0); PG8_STAGE(PG8_SA(0, 1), a2 + hstep, voffA);
            PG8_WAIT_L(8); PG8_BAR; PG8_WAIT_L(0); PG8_MMA(0, 0, At, B0); PG8_BAR; PG8_SCHED;
            PG8_LDB(B1, 1, 1); PG8_STAGE(PG8_SB(1, 0), b3, voffB);
            PG8_BAR; PG8_WAIT_L(0); PG8_MMA(0, 1, At, B1); PG8_BAR;
            PG8_LDA(At, 1, 1); PG8_STAGE(PG8_SA(1, 0), a3, voffA);
            PG8_BAR; PG8_WAIT_L(0); PG8_MMA(1, 0, At, B0); PG8_BAR; PG8_SCHED;
            PG8_STAGE(PG8_SB(1, 1), b3 + hstep, voffB);
            PG8_WAIT_V(6); PG8_BAR; PG8_MMA(1, 1, At, B1); PG8_BAR;
            }
        }
        if constexpr (ALIGN_EPI) { if (wr == 0) PG8_BAR; }
        if constexpr (!Epi::AFTER_DRAIN) { E(acc, cur, wr, wc, fr, fq); S.done(cur); }
        if (!has_next) break;
#pragma unroll
        for (int a = 0; a < 2; ++a)
#pragma unroll
            for (int b = 0; b < 2; ++b)
#pragma unroll
                for (int m = 0; m < 4; ++m)
#pragma unroll
                    for (int n = 0; n < 2; ++n) acc[a][b][m][n] = (f32x4){0.f, 0.f, 0.f, 0.f};
        cur = nxt; cA = nA; cB = nB; ++ui;
        if constexpr (ALIGN_EPI) { if (wr == 1) PG8_BAR; }
    }
    PG8_WAIT_V(0);
    if constexpr (!ALIGN_EPI) { if (wr == 0) PG8_BAR; }
    PG8_BAR;
    if constexpr (Epi::AFTER_DRAIN) { E.fused(acc, cur, wr, wc, fr, fq, lds, wid, lane); S.done(cur); }
#undef PG8_SA
#undef PG8_SB
#undef PG8_STAGE
#undef PG8_LDA
#undef PG8_LDB
#undef PG8_MMA
#undef PG8_WAIT_V
#undef PG8_WAIT_L
#undef PG8_BAR
#undef PG8_SCHED
}
}

#ifndef PG8_SP2
#define PG8_SP2 true
#endif
#ifndef PG8_ALIGN
#define PG8_ALIGN true
#endif
#ifndef MK_PER_PHASE
#define MK_PER_PHASE 0
#endif

constexpr int NWAVES = 8;
constexpr int DM = 2048, BATCH = 2, SEQ = 8192, M = BATCH * SEQ, DEPTH = 4;
constexpr int HD = 128, HK = 16, HV = 32, KDIM = 2048, VDIM = 4096, QKV = 8192;
constexpr int DNP = 12352, DNP_MAIN = 12288;
constexpr int FF = 5632;
constexpr float LN_EPS = 1e-5f, RMS_EPS = 1e-6f;
constexpr float ALPHA = 1.6817928305074290f;
#ifndef DN_CHUNKED
#define DN_CHUNKED 1
#endif
constexpr int N_PHASES = 35;

constexpr size_t MiB = 1u << 20;
constexpr size_t WS_CTL = 0, CTL_ZERO_BYTES = 1 * MiB;
constexpr size_t WS_W_SCIN = 1 * MiB;
constexpr size_t WS_W_SCOUT = WS_W_SCIN + 48 * MiB;
constexpr size_t WS_W_DNIN = WS_W_SCOUT + 16 * MiB;
constexpr size_t WS_W_BA = WS_W_DNIN + 96 * MiB;
constexpr size_t WS_W_DNOUT = WS_W_BA + 1 * MiB;
constexpr size_t WS_W_GU = WS_W_DNOUT + 32 * MiB;
constexpr size_t WS_W_DOWN = WS_W_GU + 176 * MiB;
constexpr size_t WS_XB = WS_W_DOWN + 88 * MiB;
constexpr size_t WS_BIGA = WS_XB + 64 * MiB;
constexpr size_t WS_QKV = WS_BIGA, WS_Z = WS_BIGA + 256 * MiB, WS_O = WS_BIGA;
constexpr size_t WS_GB = WS_BIGA, WS_CU = WS_BIGA + 64 * MiB, WS_A2 = WS_BIGA + 128 * MiB, WS_HID = WS_BIGA;
constexpr size_t WS_BIGB = WS_BIGA + 384 * MiB;
constexpr size_t WS_QC = WS_BIGB, WS_KC = WS_BIGB + 64 * MiB, WS_VC = WS_BIGB + 128 * MiB, WS_A3 = WS_BIGB + 256 * MiB, WS_H1 = WS_BIGB;
constexpr size_t WS_BA = WS_BIGB + 384 * MiB;
constexpr size_t WS_BETA = WS_BA + 4 * MiB, WS_DEC = WS_BETA + 2 * MiB;
constexpr size_t WS_GL = WS_DEC + 2 * MiB;
constexpr size_t WS_KF = WS_GL + 2 * MiB;
constexpr size_t WS_SC = WS_KF + 64 * MiB;
constexpr size_t WS_END = WS_SC + 8 * MiB;
constexpr size_t WS_WF = WS_BIGA, WS_UF = WS_BIGA + 128 * MiB, WS_QF = WS_BIGB + 256 * MiB, WS_AQKF = WS_BIGB + 320 * MiB;
constexpr size_t WS_WF2 = WS_BIGB, WS_UF2 = WS_BIGB + 128 * MiB;
static_assert(WS_END <= (size_t)1476395008ull, "d_ws map exceeds the guaranteed workspace");
constexpr int CW_BAR = 4096;

constexpr int RING_OFF = 0, RING_BYTES = 131072;
constexpr int LDSCTL_OFF = RING_BYTES, MISC_OFF = LDSCTL_OFF + 320, PTAB_OFF = LDSCTL_OFF + 1024;
constexpr int LDS_BYTES = 147456;

#define GAS __attribute__((address_space(1)))
#define LAS __attribute__((address_space(3)))
typedef unsigned short bf16;
typedef unsigned v4u __attribute__((ext_vector_type(4)));
typedef unsigned v2u __attribute__((ext_vector_type(2)));
typedef float f32x4 __attribute__((ext_vector_type(4)));
typedef float f32x16 __attribute__((ext_vector_type(16)));
typedef short bf16x8 __attribute__((ext_vector_type(8)));
typedef GAS unsigned gu32;
#define RLX_AGENT __ATOMIC_RELAXED, __HIP_MEMORY_SCOPE_AGENT
#define LDS_WAIT() asm volatile("s_waitcnt lgkmcnt(0)" ::: "memory")
#define VM_WAIT() asm volatile("s_waitcnt vmcnt(0)" ::: "memory")
__device__ __forceinline__ unsigned pk2(float lo, float hi) { return pg8::cvt_pk_bf16(lo, hi); }
__device__ __forceinline__ float bf_lo(unsigned w) { return __uint_as_float(w << 16); }
__device__ __forceinline__ float bf_hi(unsigned w) { return __uint_as_float(w & 0xffff0000u); }
__device__ __forceinline__ float silu_f(float v) { return v * __builtin_amdgcn_rcpf(1.0f + __expf(-v)); }
#define XB_TMO      128
#define XB_XCNT(j)  (256  + 64 * (j))
#define XB_XSUB(j)  (1280 + 64 * (j))
#define XB_XGEN(j)  (2304 + 64 * (j))
#define XB_TOP      3328
#define XB_TOPGEN   3392
#define XCD_BAR_WORDS 3456
#define XB_SPIN_CAP (1u << 21)

__device__ __forceinline__ unsigned xb_ld(unsigned* p)              { return __hip_atomic_load(p, __ATOMIC_RELAXED, __HIP_MEMORY_SCOPE_AGENT); }
__device__ __forceinline__ unsigned xb_add(unsigned* p, unsigned v) { return __hip_atomic_fetch_add(p, v, __ATOMIC_RELAXED, __HIP_MEMORY_SCOPE_AGENT); }
__device__ __forceinline__ unsigned xb_xcc_id() { return (unsigned)__builtin_amdgcn_s_getreg((3 << 11) | 20) & 0xFu; }
#define XB_SPIN(cond, bar) do { unsigned _sp = 0; while (cond) { __builtin_amdgcn_s_sleep(1); \
    if ((++_sp & 255u) == 0u) { if (xb_ld(&(bar)[XB_TMO])) break; if (_sp > XB_SPIN_CAP) { atomicAdd(&(bar)[XB_TMO], 1u); break; } } } } while (0)

struct XcdBarrier {
    unsigned* bar; unsigned x;
    volatile LAS unsigned* st;
};

__device__ __forceinline__ XcdBarrier xcd_barrier_post(unsigned* bar, volatile LAS unsigned* st) {
    XcdBarrier b; b.bar = bar; b.x = xb_xcc_id(); b.st = st;
    if (threadIdx.x == 0) (void)xb_add(&bar[XB_XCNT(b.x)], 1u);
    return b;
}
__device__ __forceinline__ void xcd_barrier_complete(unsigned* bar, unsigned x, unsigned& nloc, unsigned& nx) {
    const unsigned G = gridDim.x * gridDim.y * gridDim.z;
    unsigned sum, cnt, mine, sp = 0u;
    for (;;) {
        sum = 0u; cnt = 0u; mine = 0u;
#pragma unroll
        for (unsigned j = 0; j < 16; ++j) { const unsigned c = xb_ld(&bar[XB_XCNT(j)]); sum += c; cnt += (c > 0u) ? 1u : 0u; mine = (j == x) ? c : mine; }
        if (sum == G) break;
        __builtin_amdgcn_s_sleep(1);
        if ((++sp & 255u) == 0u) { if (xb_ld(&bar[XB_TMO])) break; if (sp > XB_SPIN_CAP) { atomicAdd(&bar[XB_TMO], 1u); break; } }
    }
    nloc = mine > 0u ? mine : 1u; nx = cnt > 0u ? cnt : 1u;
}

__device__ __forceinline__ void xcd_barrier(const XcdBarrier& b) {
    asm volatile("s_waitcnt vmcnt(0)" ::: "memory");
    __syncthreads();
    if (threadIdx.x == 0) {
        unsigned* bar = b.bar;
        __builtin_amdgcn_s_waitcnt(0);
        unsigned nloc = b.st[0], nx = b.st[1];
        if (nloc == 0u) { xcd_barrier_complete(bar, b.x, nloc, nx); b.st[0] = nloc; b.st[1] = nx; }
        const unsigned old = xb_add(&bar[XB_XSUB(b.x)], 1u);
        const unsigned gen = old / nloc;
        if (old + 1u == (gen + 1u) * nloc) {
            __builtin_amdgcn_fence(__ATOMIC_RELEASE, "agent");
            asm volatile("s_waitcnt vmcnt(0)" ::: "memory");
            const unsigned og = xb_add(&bar[XB_TOP], 1u);
            const unsigned tg = og / nx;
            if (og + 1u == (tg + 1u) * nx) xb_add(&bar[XB_TOPGEN], 1u);
            else XB_SPIN(xb_ld(&bar[XB_TOPGEN]) == tg, bar);
            __builtin_amdgcn_fence(__ATOMIC_ACQUIRE, "agent");
            xb_add(&bar[XB_XGEN(b.x)], 1u);
            asm volatile("s_waitcnt vmcnt(0)" ::: "memory");
        } else {
            XB_SPIN(xb_ld(&bar[XB_XGEN(b.x)]) == gen, bar);
            __builtin_amdgcn_fence(__ATOMIC_ACQUIRE, "agent");
            asm volatile("s_waitcnt vmcnt(0)" ::: "memory");
        }
    }
    __syncthreads();
}

__device__ __forceinline__ float wave_sum(float v) {
#pragma unroll
    for (int o = 1; o < 64; o <<= 1) v += __shfl_xor(v, o);
    return v;
}
__device__ __forceinline__ float sum16(float v) {
    v += __shfl_xor(v, 1); v += __shfl_xor(v, 2); v += __shfl_xor(v, 4); v += __shfl_xor(v, 8);
    return v;
}
template <int CTRL> __device__ __forceinline__ float dppf(float v) { return __builtin_bit_cast(float, __builtin_amdgcn_update_dpp(0, __builtin_bit_cast(int, v), CTRL, 0xF, 0xF, false)); }
__device__ __forceinline__ float rowsum16(float v) {
    v += dppf<0x128>(v); v += dppf<0x124>(v); v += dppf<0x122>(v); v += dppf<0x121>(v);
    return v;
}
__device__ __forceinline__ void unpack8(const v4u w, float (&f)[8]) {
    f[0] = bf_lo(w.x); f[1] = bf_hi(w.x); f[2] = bf_lo(w.y); f[3] = bf_hi(w.y); f[4] = bf_lo(w.z); f[5] = bf_hi(w.z); f[6] = bf_lo(w.w); f[7] = bf_hi(w.w);
}
__device__ __forceinline__ v4u pack8(const float (&f)[8]) { v4u o; o.x = pk2(f[0], f[1]); o.y = pk2(f[2], f[3]); o.z = pk2(f[4], f[5]); o.w = pk2(f[6], f[7]); return o; }

__device__ __forceinline__ void p0_transpose_item(const float* W, int ldw, int src_col0, bf16* WT, int K, int dst_row0, int k0, LAS float* scr, int lane) {
    float tv[32];
#pragma unroll
    for (int i = 0; i < 32; ++i) tv[i] = W[(size_t)(k0 + 2 * i + (lane >> 5)) * ldw + src_col0 + (lane & 31)];
#pragma unroll
    for (int i = 0; i < 32; ++i) scr[(2 * i + (lane >> 5)) * 33 + (lane & 31)] = tv[i];
    LDS_WAIT(); asm volatile("" ::: "memory");
    const int c = lane & 7;
#pragma unroll
    for (int j = 0; j < 4; ++j) { const int n = (lane >> 3) + 8 * j; const LAS float* s = scr + (8 * c) * 33 + n;
        v4u o; o.x = pk2(s[0 * 33], s[1 * 33]); o.y = pk2(s[2 * 33], s[3 * 33]); o.z = pk2(s[4 * 33], s[5 * 33]); o.w = pk2(s[6 * 33], s[7 * 33]);
        *(GAS v4u*)(WT + (size_t)(dst_row0 + n) * K + k0 + 8 * c) = o; }
    LDS_WAIT(); asm volatile("" ::: "memory");
}

struct Ptrs {
    const float *x, *sc_w_in, *sc_conv_w, *sc_w_out, *dn_w_in, *dn_conv_w, *dn_a_log, *dn_dt_bias, *dn_norm_w, *dn_w_out, *ffn_gu, *ffn_down, *ln_gain, *ln_bias;
    float* out; unsigned char* ws;
};

__device__ __forceinline__ void p0_prologue(const Ptrs& P, LAS unsigned char* lds, int gw, int NGW, int wave, int lane) {
    LAS float* scr = (LAS float*)(lds + RING_OFF + wave * 16384);
    constexpr int I_SCIN = 32 * 192, I_SCOUT = 32 * 64, I_DNIN = 32 * 384, I_BA = 32 * 2, I_DNOUT = 64 * 64, I_GU = 32 * 352, I_DOWN = 88 * 64;
    constexpr int NITEMS = 2 * (I_SCIN + I_SCOUT + I_DNIN + I_BA + I_DNOUT) + 4 * (I_GU + I_DOWN);
    for (int it = gw; it < NITEMS; it += NGW) {
        int r = it; const float* W; int ldw, K, nblk, mode; bf16* WT; int layer;
        if (r < 2 * I_SCIN) { layer = r / I_SCIN; r -= layer * I_SCIN; W = P.sc_w_in + (size_t)layer * DM * 3 * DM; ldw = 3 * DM; K = DM; nblk = 192; mode = 1; WT = (bf16*)(P.ws + WS_W_SCIN) + (size_t)layer * 3 * DM * DM; }
        else { r -= 2 * I_SCIN;
        if (r < 2 * I_SCOUT) { layer = r / I_SCOUT; r -= layer * I_SCOUT; W = P.sc_w_out + (size_t)layer * DM * DM; ldw = DM; K = DM; nblk = 64; mode = 0; WT = (bf16*)(P.ws + WS_W_SCOUT) + (size_t)layer * DM * DM; }
        else { r -= 2 * I_SCOUT;
        if (r < 2 * I_DNIN) { layer = r / I_DNIN; r -= layer * I_DNIN; W = P.dn_w_in + (size_t)layer * DM * DNP; ldw = DNP; K = DM; nblk = 384; mode = 0; WT = (bf16*)(P.ws + WS_W_DNIN) + (size_t)layer * DNP_MAIN * DM; }
        else { r -= 2 * I_DNIN;
        if (r < 2 * I_BA) { layer = r / I_BA; r -= layer * I_BA; W = P.dn_w_in + (size_t)layer * DM * DNP; ldw = DNP; K = DM; nblk = 2; mode = 3; WT = (bf16*)(P.ws + WS_W_BA) + (size_t)layer * 64 * DM; }
        else { r -= 2 * I_BA;
        if (r < 2 * I_DNOUT) { layer = r / I_DNOUT; r -= layer * I_DNOUT; W = P.dn_w_out + (size_t)layer * VDIM * DM; ldw = DM; K = VDIM; nblk = 64; mode = 0; WT = (bf16*)(P.ws + WS_W_DNOUT) + (size_t)layer * DM * VDIM; }
        else { r -= 2 * I_DNOUT;
        if (r < 4 * I_GU) { layer = r / I_GU; r -= layer * I_GU; W = P.ffn_gu + (size_t)layer * DM * 2 * FF; ldw = 2 * FF; K = DM; nblk = 352; mode = 2; WT = (bf16*)(P.ws + WS_W_GU) + (size_t)layer * 2 * FF * DM; }
        else { r -= 4 * I_GU; layer = r / I_DOWN; r -= layer * I_DOWN; W = P.ffn_down + (size_t)layer * FF * DM; ldw = DM; K = FF; nblk = 64; mode = 0; WT = (bf16*)(P.ws + WS_W_DOWN) + (size_t)layer * DM * FF; } } } } } }
        const int kb = r / nblk, nb = r % nblk, n0 = 32 * nb;
        int src;
        if (mode == 0) src = n0;
        else if (mode == 1) { if (n0 < DM) src = n0; else { const int n2 = n0 - DM; src = DM + ((n2 >> 7) & 1) * DM + (n2 >> 8) * 128 + (n2 & 127); } }
        else if (mode == 2) src = ((n0 >> 7) & 1) * FF + (n0 >> 8) * 128 + (n0 & 127);
        else src = DNP_MAIN + n0;
        p0_transpose_item(W, ldw, src, WT, K, n0, 64 * kb, scr, lane);
    }
    bf16* XB = (bf16*)(P.ws + WS_XB);
    for (int m = gw; m < M; m += NGW) {
        const GAS f32x4* xr = (const GAS f32x4*)(P.x + (size_t)m * DM) + lane;
        GAS v2u* o8 = (GAS v2u*)(XB + (size_t)m * DM) + lane;
#pragma unroll
        for (int j = 0; j < 8; ++j) { const f32x4 v = xr[64 * j]; v2u o; o.x = pk2(v.x, v.y); o.y = pk2(v.z, v.w); o8[64 * j] = o; }
    }
}

__device__ __forceinline__ void ln_phase(const float* xin, const bf16* H, const float* gain, const float* bias, float* xout, bf16* XB, int gw, int NGW, int lane) {
    f32x4 g[8], bb[8];
#pragma unroll
    for (int j = 0; j < 8; ++j) { g[j] = ((const GAS f32x4*)gain)[lane + 64 * j]; bb[j] = ((const GAS f32x4*)bias)[lane + 64 * j]; }
    for (int m = gw; m < M; m += NGW) {
        const GAS f32x4* xr = (const GAS f32x4*)(xin + (size_t)m * DM) + lane;
        const GAS v2u* hr = (const GAS v2u*)(H + (size_t)m * DM) + lane;
        f32x4 v[8]; float s = 0.f;
#pragma unroll
        for (int j = 0; j < 8; ++j) { const f32x4 xv = xr[64 * j]; const v2u hv = hr[64 * j];
            v[j].x = ALPHA * xv.x + bf_lo(hv.x); v[j].y = ALPHA * xv.y + bf_hi(hv.x); v[j].z = ALPHA * xv.z + bf_lo(hv.y); v[j].w = ALPHA * xv.w + bf_hi(hv.y);
            s += (v[j].x + v[j].y) + (v[j].z + v[j].w); }
        const float mean = wave_sum(s) * (1.f / DM); float s2 = 0.f;
#pragma unroll
        for (int j = 0; j < 8; ++j) { v[j] = v[j] - mean; s2 += (v[j].x * v[j].x + v[j].y * v[j].y) + (v[j].z * v[j].z + v[j].w * v[j].w); }
        const float rstd = 1.f / sqrtf(wave_sum(s2) * (1.f / DM) + LN_EPS);
        GAS f32x4* xo = (GAS f32x4*)(xout + (size_t)m * DM) + lane;
        GAS v2u* bo = (GAS v2u*)(XB + (size_t)m * DM) + lane;
#pragma unroll
        for (int j = 0; j < 8; ++j) { const f32x4 o = v[j] * rstd * g[j] + bb[j]; xo[64 * j] = o; v2u w; w.x = pk2(o.x, o.y); w.y = pk2(o.z, o.w); bo[64 * j] = w; }
    }
}

__device__ __forceinline__ void sc_conv_phase(const bf16* GB, const bf16* CU, const float* cw  , bf16* A2, int gt, int NGT) {
    constexpr int RB = 16, NCG = DM / 8, NITEMS = (M / RB) * NCG;
    for (int it = gt; it < NITEMS; it += NGT) {
        const int cgp = it % NCG, rb = it / NCG, c0 = cgp * 8, r0 = rb * RB;
        float w0[8], w1[8], w2[8];
#pragma unroll
        for (int e = 0; e < 8; e += 4) { const f32x4 a = *(const GAS f32x4*)(cw + c0 + e), b = *(const GAS f32x4*)(cw + DM + c0 + e), c = *(const GAS f32x4*)(cw + 2 * DM + c0 + e);
            w0[e] = a.x; w0[e + 1] = a.y; w0[e + 2] = a.z; w0[e + 3] = a.w; w1[e] = b.x; w1[e + 1] = b.y; w1[e + 2] = b.z; w1[e + 3] = b.w; w2[e] = c.x; w2[e + 1] = c.y; w2[e + 2] = c.z; w2[e + 3] = c.w; }
        float um2[8], um1[8];
        const bool first = (r0 % SEQ) == 0;
        if (first) {
#pragma unroll
            for (int e = 0; e < 8; ++e) { um2[e] = 0.f; um1[e] = 0.f; } }
        else { unpack8(*(const GAS v4u*)(CU + (size_t)(r0 - 2) * DM + c0), um2); unpack8(*(const GAS v4u*)(CU + (size_t)(r0 - 1) * DM + c0), um1); }
#pragma unroll 4
        for (int r = 0; r < RB; ++r) {
            float u0[8], gb[8], o[8];
            unpack8(*(const GAS v4u*)(CU + (size_t)(r0 + r) * DM + c0), u0);
            unpack8(*(const GAS v4u*)(GB + (size_t)(r0 + r) * DM + c0), gb);
#pragma unroll
            for (int e = 0; e < 8; ++e) { o[e] = gb[e] * (w0[e] * um2[e] + w1[e] * um1[e] + w2[e] * u0[e]); um2[e] = um1[e]; um1[e] = u0[e]; }
            *(GAS v4u*)(A2 + (size_t)(r0 + r) * DM + c0) = pack8(o);
        }
    }
}

__device__ __forceinline__ void dn_pre_phase(const bf16* QKVr, const float* cw  , bf16* QC, bf16* KC, bf16* VC, const float* BA, const float* a_log, const float* dt_bias, float* BETA, float* DEC, float* GL,
                                             int gw, int NGW, int lane, int gt, int NGT) {
    constexpr int RB = 8, NCG = QKV / 512, NITEMS = (M / RB) * NCG;
    for (int it = gw; it < NITEMS; it += NGW) {
        const int cgp = it % NCG, rb = it / NCG, c0 = cgp * 512 + lane * 8, r0 = rb * RB;
        float w[4][8];
#pragma unroll
        for (int j = 0; j < 4; ++j)
#pragma unroll
            for (int e = 0; e < 8; e += 4) { const f32x4 a = *(const GAS f32x4*)(cw + (size_t)j * QKV + c0 + e); w[j][e] = a.x; w[j][e + 1] = a.y; w[j][e + 2] = a.z; w[j][e + 3] = a.w; }
        float h3[8], h2[8], h1[8];
        const bool first = (r0 % SEQ) == 0;
        if (first) {
#pragma unroll
            for (int e = 0; e < 8; ++e) { h3[e] = 0.f; h2[e] = 0.f; h1[e] = 0.f; } }
        else { unpack8(*(const GAS v4u*)(QKVr + (size_t)(r0 - 3) * QKV + c0), h3); unpack8(*(const GAS v4u*)(QKVr + (size_t)(r0 - 2) * QKV + c0), h2); unpack8(*(const GAS v4u*)(QKVr + (size_t)(r0 - 1) * QKV + c0), h1); }
        bf16* dst; int ldd, cd; float qs = 1.f; bool norm;
        if (c0 < KDIM) { dst = QC; ldd = KDIM; cd = c0; norm = true; qs = 0.08838834764831845f; }
        else if (c0 < 2 * KDIM) { dst = KC; ldd = KDIM; cd = c0 - KDIM; norm = true; }
        else { dst = VC; ldd = VDIM; cd = c0 - 2 * KDIM; norm = false; }
        v4u rowv[RB];
#pragma unroll
        for (int r = 0; r < RB; ++r) rowv[r] = *(const GAS v4u*)(QKVr + (size_t)(r0 + r) * QKV + c0);
#pragma unroll
        for (int r = 0; r < RB; ++r) {
            float u0[8], o[8]; float ss = 0.f;
            unpack8(rowv[r], u0);
#pragma unroll
            for (int e = 0; e < 8; ++e) { const float c = w[0][e] * h3[e] + w[1][e] * h2[e] + w[2][e] * h1[e] + w[3][e] * u0[e]; o[e] = silu_f(c); ss += o[e] * o[e]; h3[e] = h2[e]; h2[e] = h1[e]; h1[e] = u0[e]; }
            if (norm) { ss = sum16(ss); const float sc = qs / sqrtf(ss + RMS_EPS);
#pragma unroll
                for (int e = 0; e < 8; ++e) o[e] *= sc; }
            *(GAS v4u*)(dst + (size_t)(r0 + r) * ldd + cd) = pack8(o);
        }
    }
    for (int i = gt; i < M * HV; i += NGT) {
        const int hv = i & (HV - 1), row = i >> 5;
        const float br = BA[(size_t)row * 64 + hv], ar = BA[(size_t)row * 64 + HV + hv];
        const float xx = ar + dt_bias[hv];
        const float sp = fmaxf(xx, 0.f) + log1pf(__expf(-fabsf(xx)));
        const float gg = -__expf(a_log[hv]) * sp;
        BETA[i] = 1.f / (1.f + __expf(-br));
        DEC[i] = __expf(gg);
        GL[i] = gg;
    }
}

__device__ __forceinline__ void ba_phase(const bf16* XB, const bf16* Wba, float* BA, LAS unsigned char* lds, int unit, int wave, int lane) {
    const int mt = wave & 1, nt = (wave >> 1) & 1, kh = wave >> 2, r = lane & 31, h = lane >> 5;
    const bf16* ap = XB + (size_t)(unit * 64 + mt * 32 + r) * DM + kh * 1024 + 8 * h;
    const bf16* bp = Wba + (size_t)(nt * 32 + r) * DM + kh * 1024 + 8 * h;
    f32x16 acc = {};
#pragma unroll 8
    for (int ks = 0; ks < 64; ++ks) {
        const bf16x8 a = *(const GAS bf16x8*)(ap + ks * 16), b = *(const GAS bf16x8*)(bp + ks * 16);
        acc = __builtin_amdgcn_mfma_f32_32x32x16_bf16(a, b, acc, 0, 0, 0);
    }
    LAS float* red = (LAS float*)(lds + RING_OFF);
    if (kh == 1) {
#pragma unroll
        for (int i = 0; i < 16; ++i) red[((wave - 4) * 16 + i) * 64 + lane] = acc[i]; }
    __syncthreads();
    if (kh == 0) {
#pragma unroll
        for (int i = 0; i < 16; ++i) { const float v = acc[i] + red[(wave * 16 + i) * 64 + lane];
            const int row = unit * 64 + mt * 32 + (i & 3) + 8 * (i >> 2) + 4 * h;
            BA[(size_t)row * 64 + nt * 32 + r] = v; } }
    __syncthreads();
}

__device__ __forceinline__ void dn_naive_phase(const bf16* QC, const bf16* KC, const bf16* VC, const float* BETA, const float* DEC, float* O, LAS unsigned char* lds, int unit, int tid) {
    constexpr int CT = 32, NCH = SEQ / CT;
    constexpr int BUF = 16384 + 16384 + 4096 + 256;
    const int bh = unit >> 2, vq = unit & 3, b = bh >> 5, hv = bh & 31, hk = hv >> 1;
    const int vl = tid >> 4, p = tid & 15;
    LAS float* ob = (LAS float*)(lds + 2 * BUF);
    const size_t row0 = (size_t)b * SEQ;
    const int lr = tid >> 4, lp = tid & 15;
    const bf16* qsrc = QC + (row0 + lr) * KDIM + hk * HD + lp * 8;
    const bf16* ksrc = KC + (row0 + lr) * KDIM + hk * HD + lp * 8;
    const int vr = (tid & 127) >> 2, vp = tid & 3;
    const bf16* vsrc = VC + (row0 + vr) * VDIM + hv * HD + vq * 32 + vp * 8;
    const float* gsrc = (tid < 32 ? BETA : DEC) + (row0 + (tid & 31)) * HV + hv;
    v4u rq, rk, rv = {0u, 0u, 0u, 0u}; float rg = 0.f;
    rq = *(const GAS v4u*)qsrc; rk = *(const GAS v4u*)ksrc; if (tid < 128) rv = *(const GAS v4u*)vsrc; if (tid < 64) rg = *gsrc;
    float S[8];
#pragma unroll
    for (int i = 0; i < 8; ++i) S[i] = 0.f;
    for (int c = 0; c < NCH; ++c) {
        LAS unsigned char* buf = lds + (c & 1) * BUF;
        { float f[8]; unpack8(rq, f); LAS f32x4* d = (LAS f32x4*)(buf + (lr * 128 + lp * 8) * 4); d[0] = (f32x4){f[0], f[1], f[2], f[3]}; d[1] = (f32x4){f[4], f[5], f[6], f[7]};
          unpack8(rk, f); d = (LAS f32x4*)(buf + 16384 + (lr * 128 + lp * 8) * 4); d[0] = (f32x4){f[0], f[1], f[2], f[3]}; d[1] = (f32x4){f[4], f[5], f[6], f[7]};
          if (tid < 128) { unpack8(rv, f); d = (LAS f32x4*)(buf + 32768 + (vr * 32 + vp * 8) * 4); d[0] = (f32x4){f[0], f[1], f[2], f[3]}; d[1] = (f32x4){f[4], f[5], f[6], f[7]}; }
          if (tid < 64) ((LAS float*)(buf + 36864))[tid] = rg; }
        __syncthreads();
        if (c + 1 < NCH) { const size_t adv = (size_t)(c + 1) * CT;
            rq = *(const GAS v4u*)(qsrc + adv * KDIM); rk = *(const GAS v4u*)(ksrc + adv * KDIM); if (tid < 128) rv = *(const GAS v4u*)(vsrc + adv * VDIM); if (tid < 64) rg = gsrc[adv * HV]; }
        const LAS float* qf = (const LAS float*)buf; const LAS float* kf = (const LAS float*)(buf + 16384); const LAS float* vf = (const LAS float*)(buf + 32768); const LAS float* gf = (const LAS float*)(buf + 36864);
#pragma unroll 4
        for (int tt = 0; tt < CT; ++tt) {
            const f32x4 k0 = *(const LAS f32x4*)(kf + tt * 128 + 8 * p), k1 = *(const LAS f32x4*)(kf + tt * 128 + 8 * p + 4);
            const f32x4 q0 = *(const LAS f32x4*)(qf + tt * 128 + 8 * p), q1 = *(const LAS f32x4*)(qf + tt * 128 + 8 * p + 4);
            const float vt = vf[tt * 32 + vl], bt = gf[tt], at = gf[32 + tt];
            float pred = (S[0] * k0.x + S[1] * k0.y) + (S[2] * k0.z + S[3] * k0.w) + (S[4] * k1.x + S[5] * k1.y) + (S[6] * k1.z + S[7] * k1.w);
            pred = rowsum16(pred);
            const float delta = bt * (vt - at * pred);
            S[0] = at * S[0] + k0.x * delta; S[1] = at * S[1] + k0.y * delta; S[2] = at * S[2] + k0.z * delta; S[3] = at * S[3] + k0.w * delta;
            S[4] = at * S[4] + k1.x * delta; S[5] = at * S[5] + k1.y * delta; S[6] = at * S[6] + k1.z * delta; S[7] = at * S[7] + k1.w * delta;
            float o = (S[0] * q0.x + S[1] * q0.y) + (S[2] * q0.z + S[3] * q0.w) + (S[4] * q1.x + S[5] * q1.y) + (S[6] * q1.z + S[7] * q1.w);
            o = rowsum16(o);
            if (p == 0) ob[tt * 32 + vl] = o;
        }
        __syncthreads();
        if (tid < 256) { const int orow = tid >> 3, oc = (tid & 7) * 4; const f32x4 v = *(const LAS f32x4*)(ob + orow * 32 + oc);
            *(GAS f32x4*)(O + (row0 + (size_t)c * CT + orow) * VDIM + hv * HD + vq * 32 + oc) = v; }
    }
    __syncthreads();
}


constexpr int PL_Q = 0, PL_K = 16384, PL_KT = 32768, PL_VT = 49152, PL_A = 81920, PL_SM = 114688, PL_T0 = 116736, PL_TB = 0;
__device__ __forceinline__ int rm_addr(int row, int col) { return row * 256 + (((col >> 3) ^ (row & 15)) << 4) + (col & 7) * 2; }
__device__ __forceinline__ int kt_addr(int d, int c) { return d * 128 + ((((c >> 3) ^ (d >> 3)) & 7) << 4) + (c & 7) * 2; }
__device__ __forceinline__ int rowof(int rho, int h) { return (rho & 3) + 8 * (rho >> 2) + 4 * h; }
__device__ __forceinline__ unsigned short bf1(float v) { return (unsigned short)(pk2(v, v) & 0xffffu); }

__device__ __forceinline__ void prep_load_rows(const bf16* QKVr, int item, int tid, v4u (&rowv)[11]) {
    const int chunk = item & 127, bk = item >> 7, hk = bk & 15, b = bk >> 4;
    int c0, run;
    if (tid < 256) { const int tq = tid & 127; run = tq >> 4; c0 = (tid >> 7) * KDIM + hk * HD + (tq & 15) * 8; }
    else { const int tv = tid - 256; run = tv >> 5; c0 = 2 * KDIM + hk * 2 * HD + (tv & 31) * 8; }
    const size_t rr0 = (size_t)b * SEQ + (size_t)chunk * 64 + run * 8;
    const bool first = (chunk == 0) && (run == 0);
#pragma unroll
    for (int q = 0; q < 11; ++q) rowv[q] = (first && q < 3) ? (v4u){0u, 0u, 0u, 0u} : *(const GAS v4u*)(QKVr + (rr0 + q - 3) * QKV + c0);
}
template <int STG> __device__ __forceinline__ void dn_prep_item(const bf16* QKVr, const float* cw  , const float* BA, const float* a_log, const float* dt_bias, bf16* Wf, bf16* Qf, bf16* Kf, bf16* AQKf, bf16* Uf, float* SC,
                                             LAS unsigned char* lds, int item, int next_item, v4u (&rowv)[11], int tid, int wave, int lane) {
    asm volatile("" : "+v"(tid), "+v"(lane));
    const int chunk = item & 127, bk = item >> 7, hk = bk & 15, b = bk >> 4;
    const size_t tok0 = (size_t)b * SEQ + (size_t)chunk * 64;
    const size_t ki = (size_t)item;
    const int r = lane & 31, h = lane >> 5;
    LAS float* betl = (LAS float*)(lds + PL_SM);
    LAS float* gcl_ = (LAS float*)(lds + PL_SM + 512);
    LAS float* facl = (LAS float*)(lds + PL_SM + 1024);
    if (STG & 1) {
    {   int c0, run, kind;
        if (tid < 256) { const int tq = tid & 127; kind = tid >> 7; run = tq >> 4; c0 = kind * KDIM + hk * HD + (tq & 15) * 8; }
        else { const int tv = tid - 256; kind = 2; run = tv >> 5; c0 = 2 * KDIM + hk * 2 * HD + (tv & 31) * 8; }
        const int lc = (kind == 2) ? (tid & 31) * 8 : (tid & 15) * 8;
        float w[4][8];
#pragma unroll
        for (int j = 0; j < 4; ++j)
#pragma unroll
            for (int e = 0; e < 8; e += 4) { const f32x4 a = *(const GAS f32x4*)(cw + (size_t)j * QKV + c0 + e); w[j][e] = a.x; w[j][e + 1] = a.y; w[j][e + 2] = a.z; w[j][e + 3] = a.w; }
        float h3[8], h2[8], h1[8];
        unpack8(rowv[0], h3); unpack8(rowv[1], h2); unpack8(rowv[2], h1);
        const float qs = (kind == 0) ? 0.08838834764831845f : 1.0f;
        unsigned pw[8][4];
#pragma unroll
        for (int q = 0; q < 8; ++q) {
            float u0[8], o[8]; float ss = 0.f;
            unpack8(rowv[3 + q], u0);
#pragma unroll
            for (int e = 0; e < 8; ++e) { const float c = w[0][e] * h3[e] + w[1][e] * h2[e] + w[2][e] * h1[e] + w[3][e] * u0[e]; o[e] = silu_f(c); ss += o[e] * o[e]; h3[e] = h2[e]; h2[e] = h1[e]; h1[e] = u0[e]; }
            ss = rowsum16(ss);
            const float sc = (kind == 2) ? 1.0f : qs / sqrtf(ss + RMS_EPS);
#pragma unroll
            for (int e = 0; e < 8; ++e) o[e] *= sc;
            const v4u pv = pack8(o); const int row = run * 8 + q;
            pw[q][0] = pv.x; pw[q][1] = pv.y; pw[q][2] = pv.z; pw[q][3] = pv.w;
            if (kind == 0) *(LAS v4u*)(lds + PL_Q + rm_addr(row, lc)) = pv;
            else if (kind == 1) *(LAS v4u*)(lds + PL_K + rm_addr(row, lc)) = pv;
        }
        if (next_item >= 0) prep_load_rows(QKVr, next_item, tid, rowv);
        if (kind != 0) {
            const int tbase = (kind == 1) ? PL_KT : PL_VT;
#pragma unroll
            for (int e2 = 0; e2 < 8; ++e2) { v4u t; unsigned tw[4];
#pragma unroll
                for (int pr = 0; pr < 4; ++pr) { const unsigned a = pw[2 * pr][e2 >> 1], bq = pw[2 * pr + 1][e2 >> 1]; tw[pr] = (e2 & 1) ? ((a >> 16) | (bq & 0xffff0000u)) : ((a & 0xffffu) | (bq << 16)); }
                t.x = tw[0]; t.y = tw[1]; t.z = tw[2]; t.w = tw[3];
                *(LAS v4u*)(lds + tbase + kt_addr(lc + e2, run * 8)) = t; }
        }
    }
    if (wave < 2) { const int hv = 2 * hk + wave; const size_t tk = tok0 + lane;
        const float br = BA[tk * 64 + hv], ar = BA[tk * 64 + HV + hv];
        const float xx = ar + dt_bias[hv];
        const float sp = fmaxf(xx, 0.f) + log1pf(__expf(-fabsf(xx)));
        const float bt = 1.f / (1.f + __expf(-br)); float gc = -__expf(a_log[hv]) * sp;
#pragma unroll
        for (int o = 1; o < 64; o <<= 1) { const float t = __shfl_up(gc, o); if (lane >= o) gc += t; }
        const float gl = __shfl(gc, 63);
        betl[wave * 64 + lane] = bt; gcl_[wave * 64 + lane] = gc; const float eg = __expf(gc);
        facl[(wave * 2 + 0) * 64 + lane] = bt; facl[(wave * 2 + 1) * 64 + lane] = bt * eg;
        float* sc = SC + ((size_t)(b * HV + hv) * 128 + chunk) * 256;
        sc[lane] = eg; sc[64 + lane] = __expf(gl - gc); if (lane == 0) sc[128] = __expf(gl); }
    }
    LDS_WAIT(); __syncthreads();
    if (STG & 2)
    {   f32x16 acc = {};
        if (wave < 4) { const int tc = wave >> 1, tm = wave & 1;
#pragma unroll
            for (int ks = 0; ks < 8; ++ks) { const bf16x8 a = *(const LAS bf16x8*)(lds + PL_K + rm_addr(32 * tc + r, 16 * ks + 8 * h)), bb = *(const LAS bf16x8*)(lds + PL_K + rm_addr(32 * tm + r, 16 * ks + 8 * h));
                acc = __builtin_amdgcn_mfma_f32_32x32x16_bf16(a, bb, acc, 0, 0, 0); }
#pragma unroll
            for (int hvl = 0; hvl < 2; ++hvl) { const int m = 32 * tm + r; const float gm = gcl_[hvl * 64 + m];
                f32x4 g4[4], b4[4];
#pragma unroll
                for (int g = 0; g < 4; ++g) { g4[g] = *(const LAS f32x4*)(gcl_ + hvl * 64 + 32 * tc + 8 * g + 4 * h); b4[g] = *(const LAS f32x4*)(betl + hvl * 64 + 32 * tc + 8 * g + 4 * h); }
#pragma unroll
                for (int rho = 0; rho < 16; ++rho) { const int c = 32 * tc + rowof(rho, h); const float e = __expf(fminf(g4[rho >> 2][rho & 3] - gm, 0.f));
                    const float val = (c > m) ? b4[rho >> 2][rho & 3] * acc[rho] * e : 0.f;
                    *(LAS float*)(lds + PL_A + hvl * 16384 + (c * 64 + m) * 4) = val; } }
        } else { const int tm = (wave - 4) >> 1, tcp = (wave - 4) & 1;
#pragma unroll
            for (int ks = 0; ks < 8; ++ks) { const bf16x8 a = *(const LAS bf16x8*)(lds + PL_K + rm_addr(32 * tm + r, 16 * ks + 8 * h)), bb = *(const LAS bf16x8*)(lds + PL_Q + rm_addr(32 * tcp + r, 16 * ks + 8 * h));
                acc = __builtin_amdgcn_mfma_f32_32x32x16_bf16(a, bb, acc, 0, 0, 0); }
#pragma unroll
            for (int hvl = 0; hvl < 2; ++hvl) { const int cp = 32 * tcp + r; const float gp = gcl_[hvl * 64 + cp]; float val[16];
                f32x4 g4[4];
#pragma unroll
                for (int g = 0; g < 4; ++g) g4[g] = *(const LAS f32x4*)(gcl_ + hvl * 64 + 32 * tm + 8 * g + 4 * h);
#pragma unroll
                for (int rho = 0; rho < 16; ++rho) { const int m = 32 * tm + rowof(rho, h); const float e = __expf(fminf(gp - g4[rho >> 2][rho & 3], 0.f)); val[rho] = (cp >= m) ? acc[rho] * e : 0.f; }
                bf16* dst = AQKf + ((size_t)(b * HV + 2 * hk + hvl) * 128 + chunk) * 4096 + ((tcp * 2 + tm) * 2) * 512 + lane * 8;
                v4u w0, w1; w0.x = pk2(val[0], val[1]); w0.y = pk2(val[2], val[3]); w0.z = pk2(val[4], val[5]); w0.w = pk2(val[6], val[7]);
                w1.x = pk2(val[8], val[9]); w1.y = pk2(val[10], val[11]); w1.z = pk2(val[12], val[13]); w1.w = pk2(val[14], val[15]);
                *(GAS v4u*)dst = w0; *(GAS v4u*)(dst + 512) = w1; } }
#pragma unroll
        for (int e = 0; e < 2; ++e) { const int f = 2 * wave + e;
            { const int t = f >> 3, i = (f >> 1) & 3, s = f & 1, row = 32 * t + r, col0 = 32 * i + 16 * s + 4 * h;
              const v2u lo = *(const LAS v2u*)(lds + PL_Q + rm_addr(row, col0)), hi = *(const LAS v2u*)(lds + PL_Q + rm_addr(row, col0 + 8));
              *(GAS v4u*)(Qf + ki * 8192 + f * 512 + lane * 8) = (v4u){lo.x, lo.y, hi.x, hi.y}; }
            { const int i = f >> 2, t = (f >> 1) & 1, s = f & 1, d = 32 * i + r, c0 = 32 * t + 16 * s + 4 * h;
              const v2u lo = *(const LAS v2u*)(lds + PL_KT + kt_addr(d, c0)), hi = *(const LAS v2u*)(lds + PL_KT + kt_addr(d, c0 + 8));
              *(GAS v4u*)(Kf + ki * 8192 + f * 512 + lane * 8) = (v4u){lo.x, lo.y, hi.x, hi.y}; } }
    }
    LDS_WAIT(); __syncthreads();
    if ((STG & 4) && wave < 2) {
        const int hvl = wave, blk = h, m = r;
        const LAS float* Ah = (const LAS float*)(lds + PL_A + hvl * 16384);
        const LAS float* Ab = Ah + (32 * blk) * 64 + 32 * blk;
        float X[32]; f32x4 ar[2][8];
        ar[1][0] = *(const LAS f32x4*)(Ab + 64);
#pragma unroll
        for (int i = 0; i < 32; ++i) {
            if (i + 1 < 32) {
#pragma unroll
                for (int c = 0; c < (i + 1 + 3) / 4; ++c) ar[(i + 1) & 1][c] = *(const LAS f32x4*)(Ab + (i + 1) * 64 + 4 * c); }
            __builtin_amdgcn_sched_barrier(0);
            float acc = (i == m) ? 1.f : 0.f, acc1 = 0.f, acc2 = 0.f, acc3 = 0.f;
#pragma unroll
            for (int j0 = 0; j0 < i; j0 += 4) { const f32x4 a = ar[i & 1][j0 >> 2];
                acc -= a.x * X[j0]; if (j0 + 1 < i) acc1 -= a.y * X[j0 + 1]; if (j0 + 2 < i) acc2 -= a.z * X[j0 + 2]; if (j0 + 3 < i) acc3 -= a.w * X[j0 + 3]; }
            X[i] = (acc + acc1) + (acc2 + acc3);
            __builtin_amdgcn_sched_barrier(0); }
        LAS unsigned char* t0 = lds + PL_T0 + hvl * 4096;
        if (blk == 0) {
#pragma unroll
            for (int q = 0; q < 4; ++q) { v4u w; w.x = pk2(X[8 * q + 0], X[8 * q + 1]); w.y = pk2(X[8 * q + 2], X[8 * q + 3]); w.z = pk2(X[8 * q + 4], X[8 * q + 5]); w.w = pk2(X[8 * q + 6], X[8 * q + 7]);
                *(LAS v4u*)(t0 + m * 64 + q * 16) = w; }
        } else {
#pragma unroll
            for (int i = 0; i < 32; ++i) *(LAS unsigned short*)(t0 + 2048 + i * 64 + m * 2) = bf1(X[i]);
        }
        LDS_WAIT();
        f32x16 Yv = {}, T10 = {};
#pragma unroll
        for (int sidx = 0; sidx < 2; ++sidx) { const LAS float* ap = Ah + (32 + r) * 64 + 16 * sidx + 8 * h; const f32x4 a0 = *(const LAS f32x4*)ap, a1 = *(const LAS f32x4*)(ap + 4);
            const bf16x8 af = __builtin_bit_cast(bf16x8, (v4u){pk2(a0.x, a0.y), pk2(a0.z, a0.w), pk2(a1.x, a1.y), pk2(a1.z, a1.w)});
            const bf16x8 bq = *(const LAS bf16x8*)(t0 + r * 64 + (16 * sidx + 8 * h) * 2);
            Yv = __builtin_amdgcn_mfma_f32_32x32x16_bf16(af, bq, Yv, 0, 0, 0); }
#pragma unroll
        for (int sidx = 0; sidx < 2; ++sidx) { const v2u lo = *(const LAS v2u*)(t0 + 2048 + r * 64 + (16 * sidx + 4 * h) * 2), hi = *(const LAS v2u*)(t0 + 2048 + r * 64 + (16 * sidx + 8 + 4 * h) * 2);
            const bf16x8 af = __builtin_bit_cast(bf16x8, (v4u){lo.x, lo.y, hi.x, hi.y});
            const bf16x8 bq = __builtin_bit_cast(bf16x8, (v4u){pk2(Yv[8 * sidx + 0], Yv[8 * sidx + 1]), pk2(Yv[8 * sidx + 2], Yv[8 * sidx + 3]), pk2(Yv[8 * sidx + 4], Yv[8 * sidx + 5]), pk2(Yv[8 * sidx + 6], Yv[8 * sidx + 7])});
            T10 = __builtin_amdgcn_mfma_f32_32x32x16_bf16(af, bq, T10, 0, 0, 0); }
        LAS unsigned char* tb = lds + PL_TB + (hvl * 2) * 8192; LAS unsigned char* tbg = tb + 8192;
        { const float bm = betl[hvl * 64 + lane], bgm = facl[(hvl * 2 + 1) * 64 + lane];
#pragma unroll
          for (int i = 0; i < 32; ++i) { const int a = kt_addr(32 * blk + i, lane); *(LAS unsigned short*)(tb + a) = bf1(X[i] * bm); *(LAS unsigned short*)(tbg + a) = bf1(X[i] * bgm); }
          if (blk == 1) {
#pragma unroll
              for (int i = 0; i < 32; ++i) { const int a = kt_addr(i, lane); *(LAS unsigned short*)(tb + a) = 0; *(LAS unsigned short*)(tbg + a) = 0; } } }
        { const float bm = betl[hvl * 64 + m], bgm = facl[(hvl * 2 + 1) * 64 + m];
#pragma unroll
          for (int rho = 0; rho < 16; ++rho) { const int a = kt_addr(32 + rowof(rho, h), m); *(LAS unsigned short*)(tb + a) = bf1(-T10[rho] * bm); *(LAS unsigned short*)(tbg + a) = bf1(-T10[rho] * bgm); } }
    }
    LDS_WAIT(); __syncthreads();
    if (STG & 8)
#pragma unroll
    for (int e = 0; e < 4; ++e) { const int idx = wave * 4 + e, hvl = idx >> 4, job = idx & 15;
        const LAS unsigned char* tb = lds + PL_TB + (hvl * 2) * 8192; const LAS unsigned char* tbg = tb + 8192;
        const size_t ci = (size_t)(b * HV + 2 * hk + hvl) * 128 + chunk;
        f32x16 acc = {};
        if (job < 8) { const int tc = job >> 2, jd = job & 3;
#pragma unroll
            for (int ks = 0; ks < 4; ++ks) { const bf16x8 a = *(const LAS bf16x8*)(tb + kt_addr(32 * tc + r, 16 * ks + 8 * h)), bq = *(const LAS bf16x8*)(lds + PL_VT + kt_addr(hvl * 128 + 32 * jd + r, 16 * ks + 8 * h));
                acc = __builtin_amdgcn_mfma_f32_32x32x16_bf16(a, bq, acc, 0, 0, 0); }
            v4u w0, w1; w0.x = pk2(acc[0], acc[1]); w0.y = pk2(acc[2], acc[3]); w0.z = pk2(acc[4], acc[5]); w0.w = pk2(acc[6], acc[7]);
            w1.x = pk2(acc[8], acc[9]); w1.y = pk2(acc[10], acc[11]); w1.z = pk2(acc[12], acc[13]); w1.w = pk2(acc[14], acc[15]);
            bf16* dst = Uf + ci * 8192 + (size_t)(((jd * 2 + tc) * 64 + lane) * 16);
            *(GAS v4u*)dst = w0; *(GAS v4u*)(dst + 8) = w1;
        } else { const int i = (job - 8) >> 1, t = (job - 8) & 1;
#pragma unroll
            for (int ks = 0; ks < 4; ++ks) { const bf16x8 a = *(const LAS bf16x8*)(lds + PL_KT + kt_addr(32 * i + r, 16 * ks + 8 * h)), bq = *(const LAS bf16x8*)(tbg + kt_addr(32 * t + r, 16 * ks + 8 * h));
                acc = __builtin_amdgcn_mfma_f32_32x32x16_bf16(a, bq, acc, 0, 0, 0); }
            v4u w0, w1; w0.x = pk2(-acc[0], -acc[1]); w0.y = pk2(-acc[2], -acc[3]); w0.z = pk2(-acc[4], -acc[5]); w0.w = pk2(-acc[6], -acc[7]);
            w1.x = pk2(-acc[8], -acc[9]); w1.y = pk2(-acc[10], -acc[11]); w1.z = pk2(-acc[12], -acc[13]); w1.w = pk2(-acc[14], -acc[15]);
            bf16* dst = Wf + ci * 8192 + ((t * 4 + i) * 2) * 512 + lane * 8;
            *(GAS v4u*)dst = w0; *(GAS v4u*)(dst + 512) = w1;
        }
    }
    LDS_WAIT(); __syncthreads();
}

__device__ __forceinline__ void dn_scan_phase(const bf16* Wf, const bf16* Qf, const bf16* Kf, const bf16* AQKf, const bf16* Uf, const float* SC, float* O, LAS unsigned char* lds, int unit, int wave, int lane) {
    constexpr int BUFB = 58368, NST = SEQ / 64;
    const int bh = unit >> 2, jd = unit & 3, b = bh >> 5, hv = bh & 31, hk = hv >> 1;
    const size_t ci0 = (size_t)(b * HV + hv) * 128, ki0 = (size_t)(b * HK + hk) * 128;
    const int r = lane & 31, h = lane >> 5;
    if (wave > 0) {
        const bf16* src; size_t stride;
        if (wave <= 2) { src = Wf + ci0 * 8192 + (wave - 1) * 4096; stride = 8192; }
        else if (wave <= 4) { src = Qf + ki0 * 8192 + (wave - 3) * 4096; stride = 8192; }
        else if (wave <= 6) { src = Kf + ki0 * 8192 + (wave - 5) * 4096; stride = 8192; }
        else { src = AQKf + ci0 * 4096; stride = 4096; }
        src += lane * 8;
        const float* ssrc = SC + ci0 * 256 + lane * 4;
        const int dofs = (wave - 1) * 8192 + lane * 16;
        v4u RA[8], RB[8]; f32x4 RsA = {0.f, 0.f, 0.f, 0.f}, RsB = {0.f, 0.f, 0.f, 0.f};
#define LD_SET(R, Rs, st) do { const bf16* sp_ = src + (size_t)(st) * stride; _Pragma("unroll") for (int e = 0; e < 8; ++e) R[e] = *(const GAS v4u*)(sp_ + e * 512); if (wave == 1) Rs = *(const GAS f32x4*)(ssrc + (size_t)(st) * 256); } while (0)
#define ST_SET(R, Rs, st) do { LAS unsigned char* bp_ = lds + ((st) & 1) * BUFB; _Pragma("unroll") for (int e = 0; e < 8; ++e) *(LAS v4u*)(bp_ + dofs + e * 1024) = R[e]; if (wave == 1) *(LAS f32x4*)(bp_ + 57344 + lane * 16) = Rs; } while (0)
        LD_SET(RA, RsA, 0); ST_SET(RA, RsA, 0);
        LD_SET(RA, RsA, 1); LD_SET(RB, RsB, 2);
        for (int n = 0; n < NST; n += 2) {
            LDS_WAIT(); __builtin_amdgcn_s_barrier(); asm volatile("" ::: "memory");
            if (n + 1 < NST) ST_SET(RA, RsA, n + 1);
            if (n + 3 < NST) LD_SET(RA, RsA, n + 3);
            LDS_WAIT(); __builtin_amdgcn_s_barrier(); asm volatile("" ::: "memory");
            if (n + 2 < NST) ST_SET(RB, RsB, n + 2);
            if (n + 4 < NST) LD_SET(RB, RsB, n + 4);
        }
#undef LD_SET
#undef ST_SET
    } else {
        f32x16 S0 = {}, S1 = {}, S2 = {}, S3 = {};
        const bf16* usrc = Uf + ci0 * 8192 + (size_t)((jd * 2) * 64 + lane) * 16;
        v4u un[4];
        un[0] = *(const GAS v4u*)usrc; un[1] = *(const GAS v4u*)(usrc + 8); un[2] = *(const GAS v4u*)(usrc + 1024); un[3] = *(const GAS v4u*)(usrc + 1032);
        GAS float* obase = (GAS float*)(O + ((size_t)b * SEQ) * VDIM + hv * HD + jd * 32 + r);
#define MF(a, bq, c) __builtin_amdgcn_mfma_f32_32x32x16_bf16(a, bq, c, 0, 0, 0)
#define FRAG(off) (*(const LAS bf16x8*)(bp + (off) + lane * 16))
#define PK8(V, s) __builtin_bit_cast(bf16x8, (v4u){pk2(V[8 * (s) + 0], V[8 * (s) + 1]), pk2(V[8 * (s) + 2], V[8 * (s) + 3]), pk2(V[8 * (s) + 4], V[8 * (s) + 5]), pk2(V[8 * (s) + 6], V[8 * (s) + 7])})
#define SBAR() __builtin_amdgcn_sched_barrier(0)
#define RD4(D, o0, o1, o2, o3) do { D[0] = FRAG(o0); D[1] = FRAG(o1); D[2] = FRAG(o2); D[3] = FRAG(o3); } while (0)
#define WF(f) ((f) * 1024)
#define QF(f) (16384 + (f) * 1024)
#define KF(f) (32768 + (f) * 1024)
#define AF(f) (49152 + (f) * 1024)
        for (int n = 0; n < NST; ++n) {
            LDS_WAIT(); __builtin_amdgcn_s_barrier(); asm volatile("" ::: "memory");
            const LAS unsigned char* bp = lds + (n & 1) * BUFB;
            const LAS float* scl = (const LAS float*)(bp + 57344);
            bf16x8 X[4], Y[4];
            RD4(X, WF(0), WF(1), WF(2), WF(3));
            f32x16 P0, P1;
            { float uu[8]; unpack8(un[0], uu);
#pragma unroll
              for (int e = 0; e < 8; ++e) P0[e] = uu[e];
              unpack8(un[1], uu);
#pragma unroll
              for (int e = 0; e < 8; ++e) P0[8 + e] = uu[e];
              unpack8(un[2], uu);
#pragma unroll
              for (int e = 0; e < 8; ++e) P1[e] = uu[e];
              unpack8(un[3], uu);
#pragma unroll
              for (int e = 0; e < 8; ++e) P1[8 + e] = uu[e]; }
            if (n + 1 < NST) { const bf16* up = usrc + (size_t)(n + 1) * 8192; un[0] = *(const GAS v4u*)up; un[1] = *(const GAS v4u*)(up + 8); un[2] = *(const GAS v4u*)(up + 1024); un[3] = *(const GAS v4u*)(up + 1032); }
            const bf16x8 Sb00 = PK8(S0, 0), Sb01 = PK8(S0, 1), Sb10 = PK8(S1, 0), Sb11 = PK8(S1, 1), Sb20 = PK8(S2, 0), Sb21 = PK8(S2, 1), Sb30 = PK8(S3, 0), Sb31 = PK8(S3, 1);
            SBAR();
            RD4(Y, WF(4), WF(5), WF(6), WF(7));
            P0 = MF(X[0], Sb00, P0); P0 = MF(X[1], Sb01, P0); P0 = MF(X[2], Sb10, P0); P0 = MF(X[3], Sb11, P0);
            SBAR();
            RD4(X, WF(8), WF(9), WF(10), WF(11));
            P0 = MF(Y[0], Sb20, P0); P0 = MF(Y[1], Sb21, P0); P0 = MF(Y[2], Sb30, P0); P0 = MF(Y[3], Sb31, P0);
            SBAR();
            RD4(Y, WF(12), WF(13), WF(14), WF(15));
            P1 = MF(X[0], Sb00, P1); P1 = MF(X[1], Sb01, P1); P1 = MF(X[2], Sb10, P1); P1 = MF(X[3], Sb11, P1);
            SBAR();
            RD4(X, QF(0), QF(1), QF(2), QF(3));
            P1 = MF(Y[0], Sb20, P1); P1 = MF(Y[1], Sb21, P1); P1 = MF(Y[2], Sb30, P1); P1 = MF(Y[3], Sb31, P1);
            bf16x8 Vb00, Vb01, Ve00, Ve01, Vb10, Vb11, Ve10, Ve11;
            { float E[16];
#pragma unroll
              for (int g = 0; g < 4; ++g) { const f32x4 k0 = *(const LAS f32x4*)(scl + 64 + 8 * g + 4 * h);
                  E[4 * g + 0] = P0[4 * g + 0] * k0.x; E[4 * g + 1] = P0[4 * g + 1] * k0.y; E[4 * g + 2] = P0[4 * g + 2] * k0.z; E[4 * g + 3] = P0[4 * g + 3] * k0.w; }
              Vb00 = PK8(P0, 0); Vb01 = PK8(P0, 1); Ve00 = PK8(E, 0); Ve01 = PK8(E, 1); }
            SBAR();
            RD4(Y, QF(4), QF(5), QF(6), QF(7));
            f32x16 oa0 = {}, oa1 = {};
            oa0 = MF(X[0], Sb00, oa0); oa0 = MF(X[1], Sb01, oa0); oa0 = MF(X[2], Sb10, oa0); oa0 = MF(X[3], Sb11, oa0);
            { float E[16];
#pragma unroll
              for (int g = 0; g < 4; ++g) { const f32x4 k1 = *(const LAS f32x4*)(scl + 64 + 32 + 8 * g + 4 * h);
                  E[4 * g + 0] = P1[4 * g + 0] * k1.x; E[4 * g + 1] = P1[4 * g + 1] * k1.y; E[4 * g + 2] = P1[4 * g + 2] * k1.z; E[4 * g + 3] = P1[4 * g + 3] * k1.w; }
              Vb10 = PK8(P1, 0); Vb11 = PK8(P1, 1); Ve10 = PK8(E, 0); Ve11 = PK8(E, 1); }
            SBAR();
            RD4(X, QF(8), QF(9), QF(10), QF(11));
            oa0 = MF(Y[0], Sb20, oa0); oa0 = MF(Y[1], Sb21, oa0); oa0 = MF(Y[2], Sb30, oa0); oa0 = MF(Y[3], Sb31, oa0);
            SBAR();
            RD4(Y, QF(12), QF(13), QF(14), QF(15));
            oa1 = MF(X[0], Sb00, oa1); oa1 = MF(X[1], Sb01, oa1); oa1 = MF(X[2], Sb10, oa1); oa1 = MF(X[3], Sb11, oa1);
            SBAR();
            RD4(X, AF(0), AF(1), AF(4), AF(5));
            oa1 = MF(Y[0], Sb20, oa1); oa1 = MF(Y[1], Sb21, oa1); oa1 = MF(Y[2], Sb30, oa1); oa1 = MF(Y[3], Sb31, oa1);
            SBAR();
            bf16x8 Z[2]; Z[0] = FRAG(AF(6)); Z[1] = FRAG(AF(7));
#pragma unroll
            for (int g = 0; g < 4; ++g) { const f32x4 e0 = *(const LAS f32x4*)(scl + 8 * g + 4 * h), e1 = *(const LAS f32x4*)(scl + 32 + 8 * g + 4 * h);
                oa0[4 * g + 0] *= e0.x; oa0[4 * g + 1] *= e0.y; oa0[4 * g + 2] *= e0.z; oa0[4 * g + 3] *= e0.w;
                oa1[4 * g + 0] *= e1.x; oa1[4 * g + 1] *= e1.y; oa1[4 * g + 2] *= e1.z; oa1[4 * g + 3] *= e1.w; }
            oa0 = MF(X[0], Vb00, oa0); oa0 = MF(X[1], Vb01, oa0);
            oa1 = MF(X[2], Vb00, oa1); oa1 = MF(X[3], Vb01, oa1);
            const float cd = scl[128];
            S0 = S0 * cd; S1 = S1 * cd; S2 = S2 * cd; S3 = S3 * cd;
            SBAR();
            RD4(X, KF(0), KF(1), KF(2), KF(3));
            oa1 = MF(Z[0], Vb10, oa1); oa1 = MF(Z[1], Vb11, oa1);
            { const size_t orow = (size_t)n * 64;
#pragma unroll
              for (int rho = 0; rho < 16; ++rho) obase[(orow + rowof(rho, h)) * VDIM] = oa0[rho]; }
            SBAR();
            RD4(Y, KF(4), KF(5), KF(6), KF(7));
            S0 = MF(X[0], Ve00, S0); S0 = MF(X[1], Ve01, S0); S0 = MF(X[2], Ve10, S0); S0 = MF(X[3], Ve11, S0);
            { const size_t orow = (size_t)n * 64 + 32;
#pragma unroll
              for (int rho = 0; rho < 16; ++rho) obase[(orow + rowof(rho, h)) * VDIM] = oa1[rho]; }
            SBAR();
            RD4(X, KF(8), KF(9), KF(10), KF(11));
            S1 = MF(Y[0], Ve00, S1); S1 = MF(Y[1], Ve01, S1); S1 = MF(Y[2], Ve10, S1); S1 = MF(Y[3], Ve11, S1);
            SBAR();
            RD4(Y, KF(12), KF(13), KF(14), KF(15));
            S2 = MF(X[0], Ve00, S2); S2 = MF(X[1], Ve01, S2); S2 = MF(X[2], Ve10, S2); S2 = MF(X[3], Ve11, S2);
            SBAR();
            S3 = MF(Y[0], Ve00, S3); S3 = MF(Y[1], Ve01, S3); S3 = MF(Y[2], Ve10, S3); S3 = MF(Y[3], Ve11, S3);
            SBAR();
        }
#undef SBAR
#undef RD4
#undef WF
#undef QF
#undef KF
#undef AF
#undef MF
#undef FRAG
#undef PK8
    }
    LDS_WAIT(); __syncthreads();
}

__device__ __forceinline__ void dn_gnorm_phase(const float* O, const bf16* Z, const float* nw, bf16* A3, int gw, int NGW, int lane) {
    constexpr int NCG = VDIM / 512, NITEMS = M * NCG;
    float wv[8];
    { const f32x4 a = *(const GAS f32x4*)(nw + (lane & 15) * 8), b = *(const GAS f32x4*)(nw + (lane & 15) * 8 + 4); wv[0] = a.x; wv[1] = a.y; wv[2] = a.z; wv[3] = a.w; wv[4] = b.x; wv[5] = b.y; wv[6] = b.z; wv[7] = b.w; }
#pragma unroll 4
    for (int it = gw; it < NITEMS; it += NGW) {
        const int cgp = it % NCG, row = it / NCG, c0 = cgp * 512 + lane * 8;
        const f32x4 a = *(const GAS f32x4*)(O + (size_t)row * VDIM + c0), b = *(const GAS f32x4*)(O + (size_t)row * VDIM + c0 + 4);
        float z[8]; unpack8(*(const GAS v4u*)(Z + (size_t)row * VDIM + c0), z);
        float o[8] = {a.x, a.y, a.z, a.w, b.x, b.y, b.z, b.w};
        float ss = 0.f;
#pragma unroll
        for (int e = 0; e < 8; ++e) ss += o[e] * o[e];
        ss = sum16(ss);
        const float rs = 1.f / sqrtf(ss * (1.f / HD) + RMS_EPS);
#pragma unroll
        for (int e = 0; e < 8; ++e) o[e] = o[e] * rs * wv[e] * silu_f(z[e]);
        *(GAS v4u*)(A3 + (size_t)row * VDIM + c0) = pack8(o);
    }
}

struct Args { const float* in[14]; float* out; unsigned char* ws; int ph_lo, ph_hi, li, pad; };
__device__ __forceinline__ unsigned long long ptab_get(LAS unsigned char* lds, int i) {
    volatile LAS unsigned* p = (volatile LAS unsigned*)(lds + PTAB_OFF) + 2 * i;
    const unsigned lo = __builtin_amdgcn_readfirstlane(p[0]), hi = __builtin_amdgcn_readfirstlane(p[1]);
    return ((unsigned long long)hi << 32) | lo;
}
#ifndef PREP_PROBE
#define PREP_PROBE 0
#endif
#ifndef REP_MASK
#define REP_MASK 0
#endif
#define REPS(t) for (int rep_ = 0; rep_ < 1 + ((REP_MASK >> (t)) & 1); ++rep_)
#define PIN(i) ((const float*)ptab_get(lds, (i)))
#define POUT ((float*)ptab_get(lds, 14))
#define PWS ((unsigned char*)ptab_get(lds, 15))
#define LOCAL_IDS int tid = threadIdx.x; asm volatile("" : "+v"(tid)); const int lane = tid & 63, wave = __builtin_amdgcn_readfirstlane(tid >> 6); const int G = gridDim.x, bx = blockIdx.x; \
    const int vcu = (G % 8 == 0) ? (bx % 8) * (G / 8) + bx / 8 : bx; const int gw = vcu * NWAVES + wave, NGW = G * NWAVES, gt = vcu * (NWAVES * 64) + tid, NGT = G * NWAVES * 64; \
    unsigned char* const ws = PWS; (void)lane; (void)gw; (void)NGW; (void)gt; (void)NGT; (void)ws
__global__ void __launch_bounds__(NWAVES * 64, 2) fwd(Args args) {
    extern __shared__ __attribute__((aligned(16))) unsigned char lds_raw[];
    LAS unsigned char* lds = (LAS unsigned char*)lds_raw;
    volatile LAS unsigned* MISC = (volatile LAS unsigned*)(lds + MISC_OFF);
    for (int u = threadIdx.x; u < (LDS_BYTES - LDSCTL_OFF) / 4; u += NWAVES * 64) ((LAS unsigned*)(lds + LDSCTL_OFF))[u] = 0u;
    __syncthreads();
    if (threadIdx.x == 0) {
        LAS unsigned long long* pt = (LAS unsigned long long*)(lds + PTAB_OFF);
#pragma unroll
        for (int i = 0; i < 14; ++i) pt[i] = (unsigned long long)args.in[i];
        pt[14] = (unsigned long long)args.out; pt[15] = (unsigned long long)args.ws;
    }
    __syncthreads();
    if (threadIdx.x == 0) { LAS unsigned* pw = (LAS unsigned*)(lds + PTAB_OFF) + 32; pw[0] = (unsigned)args.ph_lo; pw[1] = (unsigned)args.ph_hi; }
    if (!MK_PER_PHASE) (void)xcd_barrier_post((unsigned*)(args.ws + WS_CTL) + CW_BAR, MISC + 8);
    __syncthreads();
#define PH_LO ((int)__builtin_amdgcn_readfirstlane(((volatile LAS unsigned*)(lds + PTAB_OFF))[32]))
#define PH_HI ((int)__builtin_amdgcn_readfirstlane(((volatile LAS unsigned*)(lds + PTAB_OFF))[33]))
#define IN(k) (PH_LO <= (k) && (k) < PH_HI)
#define SEAM(k) do { if (!MK_PER_PHASE) { if (IN(k) && IN((k) + 1)) { XcdBarrier bar_; bar_.bar = (unsigned*)(PWS + WS_CTL) + CW_BAR; bar_.x = xb_xcc_id(); bar_.st = MISC + 8; xcd_barrier(bar_); } } } while (0)

    if (IN(0)) REPS(0) { LOCAL_IDS; Ptrs P; P.x = PIN(0); P.sc_w_in = PIN(1); P.sc_w_out = PIN(3); P.dn_w_in = PIN(4); P.dn_w_out = PIN(9); P.ffn_gu = PIN(10); P.ffn_down = PIN(11); P.ws = ws;
        p0_prologue(P, lds, gw, NGW, wave, lane); }
    SEAM(0);

    for (int L = 0; L < DEPTH; ++L) {
        const int j = L >> 1;
        const int pb = 1 + 17 * j + ((L & 1) ? 7 : 0);
        int fb;
        if ((L & 1) == 0) {
            if (IN(pb + 0)) REPS(1) {
                LOCAL_IDS;
                pg8::Gemm g{(const bf16*)(ws + WS_XB), (const bf16*)(ws + WS_W_SCIN) + (size_t)j * 3 * DM * DM, M, 3 * DM, DM}; pg8::StaticOrder S; S.init(M, 3 * DM, G, bx);
                pg8::EpiGate<0> E{(bf16*)(ws + WS_GB), DM, (bf16*)(ws + WS_CU), DM, DM / 256};
                pg8::gemm_phase<pg8::EpiGate<0>, pg8::StaticOrder, PG8_ALIGN, PG8_SP2>(lds + RING_OFF, g, S, E);
            }
            SEAM(pb + 0);
            if (IN(pb + 1)) REPS(2) { LOCAL_IDS; sc_conv_phase((const bf16*)(ws + WS_GB), (const bf16*)(ws + WS_CU), PIN(2) + (size_t)j * 3 * DM, (bf16*)(ws + WS_A2), gt, NGT); }
            SEAM(pb + 1);
            if (IN(pb + 2)) REPS(3) {
                LOCAL_IDS;
                pg8::Gemm g{(const bf16*)(ws + WS_A2), (const bf16*)(ws + WS_W_SCOUT) + (size_t)j * DM * DM, M, DM, DM}; pg8::StaticOrder S; S.init(M, DM, G, bx);
                pg8::EpiStore2 E{(bf16*)(ws + WS_H1), DM, (bf16*)(ws + WS_H1), DM, 1 << 30};
                pg8::gemm_phase<pg8::EpiStore2, pg8::StaticOrder, PG8_ALIGN, PG8_SP2>(lds + RING_OFF, g, S, E);
            }
            SEAM(pb + 2);
            if (IN(pb + 3)) { LOCAL_IDS; ln_phase((L == 0) ? PIN(0) : (const float*)POUT, (const bf16*)(ws + WS_H1), PIN(12) + (size_t)(L * 2) * DM, PIN(13) + (size_t)(L * 2) * DM, POUT, (bf16*)(ws + WS_XB), gw, NGW, lane); }
            SEAM(pb + 3);
            fb = pb + 4;
        } else {
            if (IN(pb + 0)) REPS(5) {
                LOCAL_IDS;
                pg8::Gemm g{(const bf16*)(ws + WS_XB), (const bf16*)(ws + WS_W_DNIN) + (size_t)j * DNP_MAIN * DM, M, DNP_MAIN, DM}; pg8::StaticOrder S; S.init(M, DNP_MAIN, G, bx);
                pg8::EpiStore2 E{(bf16*)(ws + WS_QKV), QKV, (bf16*)(ws + WS_Z), VDIM, QKV};
                pg8::gemm_phase<pg8::EpiStore2, pg8::StaticOrder, PG8_ALIGN, PG8_SP2>(lds + RING_OFF, g, S, E);
            }
            if (IN(pb + 0)) {
                LOCAL_IDS;
                for (int u = bx; u < M / 64; u += G) ba_phase((const bf16*)(ws + WS_XB), (const bf16*)(ws + WS_W_BA) + (size_t)j * 64 * DM, (float*)(ws + WS_BA), lds, u, wave, lane);
            }
            SEAM(pb + 0);
#if DN_CHUNKED
            if (IN(pb + 2)) { LOCAL_IDS; constexpr int NIT = BATCH * HK * (SEQ / 64);
                v4u rowv[11];
                prep_load_rows((const bf16*)(ws + WS_QKV), vcu < NIT ? vcu : 0, tid, rowv);
                for (int it = vcu; it < NIT; it += G)
                    dn_prep_item<15>((const bf16*)(ws + WS_QKV), PIN(5) + (size_t)j * 4 * QKV, (const float*)(ws + WS_BA), PIN(6) + j * HV, PIN(7) + j * HV,
                                     (bf16*)(ws + WS_WF2), (bf16*)(ws + WS_QF), (bf16*)(ws + WS_KF), (bf16*)(ws + WS_AQKF), (bf16*)(ws + WS_UF2), (float*)(ws + WS_SC), lds, it, (it + G < NIT) ? it + G : -1, rowv, tid, wave, lane); }
            SEAM(pb + 2);
            if (IN(pb + 3)) REPS(12) { LOCAL_IDS; for (int u = vcu; u < BATCH * HV * 4; u += G)
                dn_scan_phase((const bf16*)(ws + WS_WF2), (const bf16*)(ws + WS_QF), (const bf16*)(ws + WS_KF), (const bf16*)(ws + WS_AQKF), (const bf16*)(ws + WS_UF2), (const float*)(ws + WS_SC), (float*)(ws + WS_O), lds, u, wave, lane); }
            SEAM(pb + 3);
            if (IN(pb + 4)) REPS(8) { LOCAL_IDS; dn_gnorm_phase((const float*)(ws + WS_O), (const bf16*)(ws + WS_Z), PIN(8) + j * HD, (bf16*)(ws + WS_A3), gw, NGW, lane); }
#else
            if (IN(pb + 1)) REPS(6) { LOCAL_IDS; dn_pre_phase((const bf16*)(ws + WS_QKV), PIN(5) + (size_t)j * 4 * QKV, (bf16*)(ws + WS_QC), (bf16*)(ws + WS_KC), (bf16*)(ws + WS_VC), (const float*)(ws + WS_BA), PIN(6) + j * HV, PIN(7) + j * HV,
                                                       (float*)(ws + WS_BETA), (float*)(ws + WS_DEC), (float*)(ws + WS_GL), gw, NGW, lane, gt, NGT); }
            SEAM(pb + 1);
            if (IN(pb + 2)) REPS(7) { LOCAL_IDS; for (int u = vcu; u < BATCH * HV * 4; u += G) dn_naive_phase((const bf16*)(ws + WS_QC), (const bf16*)(ws + WS_KC), (const bf16*)(ws + WS_VC), (const float*)(ws + WS_BETA), (const float*)(ws + WS_DEC), (float*)(ws + WS_O), lds, u, tid); }
            SEAM(pb + 2);
            SEAM(pb + 3);
            if (IN(pb + 4)) REPS(8) { LOCAL_IDS; dn_gnorm_phase((const float*)(ws + WS_O), (const bf16*)(ws + WS_Z), PIN(8) + j * HD, (bf16*)(ws + WS_A3), gw, NGW, lane); }
#endif
            SEAM(pb + 4);
            if (IN(pb + 5)) REPS(9) {
                LOCAL_IDS;
                pg8::Gemm g{(const bf16*)(ws + WS_A3), (const bf16*)(ws + WS_W_DNOUT) + (size_t)j * DM * VDIM, M, DM, VDIM}; pg8::StaticOrder S; S.init(M, DM, G, bx);
                pg8::EpiStore2 E{(bf16*)(ws + WS_H1), DM, (bf16*)(ws + WS_H1), DM, 1 << 30};
                pg8::gemm_phase<pg8::EpiStore2, pg8::StaticOrder, PG8_ALIGN, PG8_SP2>(lds + RING_OFF, g, S, E);
            }
            SEAM(pb + 5);
            if (IN(pb + 6)) { LOCAL_IDS; ln_phase((const float*)POUT, (const bf16*)(ws + WS_H1), PIN(12) + (size_t)(L * 2) * DM, PIN(13) + (size_t)(L * 2) * DM, POUT, (bf16*)(ws + WS_XB), gw, NGW, lane); }
            SEAM(pb + 6);
            fb = pb + 7;
        }
        if (IN(fb + 0)) REPS(10) {
            LOCAL_IDS;
            pg8::Gemm g{(const bf16*)(ws + WS_XB), (const bf16*)(ws + WS_W_GU) + (size_t)L * 2 * FF * DM, M, 2 * FF, DM}; pg8::StaticOrder S; S.init(M, 2 * FF, G, bx);
            pg8::EpiGate<1> E{(bf16*)(ws + WS_HID), FF, (bf16*)(ws + WS_HID), FF, 0};
            pg8::gemm_phase<pg8::EpiGate<1>, pg8::StaticOrder, PG8_ALIGN, PG8_SP2>(lds + RING_OFF, g, S, E);
        }
        SEAM(fb + 0);
        if (IN(fb + 1)) REPS(11) {
            LOCAL_IDS;
            pg8::Gemm g{(const bf16*)(ws + WS_HID), (const bf16*)(ws + WS_W_DOWN) + (size_t)L * DM * FF, M, DM, FF}; pg8::StaticOrder S; S.init(M, DM, G, bx);
            pg8::EpiStore2 E{(bf16*)(ws + WS_H1), DM, (bf16*)(ws + WS_H1), DM, 1 << 30};
            pg8::gemm_phase<pg8::EpiStore2, pg8::StaticOrder, PG8_ALIGN, PG8_SP2>(lds + RING_OFF, g, S, E);
        }
        SEAM(fb + 1);
        if (IN(fb + 2)) { LOCAL_IDS; ln_phase((const float*)POUT, (const bf16*)(ws + WS_H1), PIN(12) + (size_t)(L * 2 + 1) * DM, PIN(13) + (size_t)(L * 2 + 1) * DM, POUT, (bf16*)(ws + WS_XB), gw, NGW, lane); }
        SEAM(fb + 2);
    }
#undef IN
#undef SEAM
}

extern "C" void kernel_launch(void* const* d_in, const int* in_sizes, int n_in, void* d_out, int out_size, void* d_ws, size_t ws_size, hipStream_t stream) {
    static int grid = 0;
    if (grid == 0) {
        if (n_in != 14 || in_sizes[0] != M * DM || out_size != M * DM || ws_size < WS_END) { fprintf(stderr, "kernel_launch: unexpected shapes (n_in %d, in0 %d, out %d, ws %zu < %zu); nothing launched\n", n_in, n_in > 0 ? in_sizes[0] : -1, out_size, ws_size, (size_t)WS_END); grid = -1; return; }
        int dev = 0, cus = 0, per_cu = 0;
        if (hipGetDevice(&dev) != hipSuccess || hipDeviceGetAttribute(&cus, hipDeviceAttributeMultiprocessorCount, dev) != hipSuccess) { grid = -1; return; }
        if (hipFuncSetAttribute((const void*)fwd, hipFuncAttributeMaxDynamicSharedMemorySize, LDS_BYTES) != hipSuccess) { fprintf(stderr, "kernel_launch: hipFuncSetAttribute failed\n"); grid = -1; return; }
        if (hipOccupancyMaxActiveBlocksPerMultiprocessor(&per_cu, (const void*)fwd, NWAVES * 64, LDS_BYTES) != hipSuccess || per_cu < 1) fprintf(stderr, "kernel_launch: occupancy query reports %d\n", per_cu);
        (void)hipGetLastError();
        grid = cus;
        if (grid > 256) grid = 256;
    }
    if (grid < 0) return;
    if (hipMemsetAsync((char*)d_ws + WS_CTL, 0, CTL_ZERO_BYTES, stream) != hipSuccess) return;
    Args a{};
    for (int i = 0; i < 14; ++i) a.in[i] = (const float*)d_in[i];
    a.out = (float*)d_out; a.ws = (unsigned char*)d_ws;
#if MK_PER_PHASE
    for (int p = 0; p < N_PHASES; ++p) { a.ph_lo = p; a.ph_hi = p + 1; a.li = p; hipLaunchKernelGGL(fwd, dim3(grid), dim3(NWAVES * 64), LDS_BYTES, stream, a); }
#else
    a.ph_lo = 0; a.ph_hi = N_PHASES; a.li = 0;
    hipLaunchKernelGGL(fwd, dim3(grid), dim3(NWAVES * 64), LDS_BYTES, stream, a);
#endif
}
```

```cpp
#include <hip/hip_runtime.h>
#include <cstdio>
#include <cstdint>
namespace pg8 {
#define PG8_LAS __attribute__((address_space(3)))
typedef unsigned short bf16_t;
typedef short bf16x8 __attribute__((ext_vector_type(8)));
typedef float f32x4 __attribute__((ext_vector_type(4)));
typedef unsigned u32x4 __attribute__((ext_vector_type(4)));
constexpr int BM = 256, BK = 64, HALF = 128, HTB = HALF * BK * 2  , STAGE_BYTES = 8 * HTB, NXCD = 8, WGM = 4;

__host__ __device__ __forceinline__ int lds_byte(int r, int c) { const int st = (r >> 4) * 2 + (c >> 5), rr = r & 15, cc = c & 31, ob = rr * 64 + cc * 2; return st * 1024 + (ob ^ (((ob >> 9) & 1) << 5)); }
__host__ __device__ __forceinline__ void stage_rc(int b, int& R, int& C) { const int st = b / 1024, sb = b % 1024, swz = sb ^ (((sb >> 9) & 1) << 5); R = (st >> 1) * 16 + swz / 64; C = (st & 1) * 32 + (swz % 64) / 2; }
__host__ __device__ __forceinline__ int perm32(int rho) { const int n = rho >> 4, i = rho & 15; return 8 * (i >> 2) + 4 * n + (i & 3); }

struct Unit { int pm, pn; };
struct Gemm { const bf16_t* A; const bf16_t* Bt; int M, N, K; };

struct StaticOrder {
    int nM, nN, nwg, G, c;
    __host__ __device__ void init(int M, int N, int G_, int c_) { nM = M / BM; nN = N / BM; nwg = nM * nN; G = G_; c = c_; }
    __host__ __device__ bool next(int i, Unit& u) const {
        const long L = (long)i * G + c; if (L >= nwg) return false;
        int wgid = (int)L; { const int q = nwg / NXCD, r = nwg % NXCD, xcd = wgid % NXCD, off = wgid / NXCD; wgid = (xcd < r ? xcd * (q + 1) : r * (q + 1) + (xcd - r) * q) + off; }
        const int nig = WGM * nN, gid = wgid / nig, fm = gid * WGM, gsz = (nM - fm) < WGM ? (nM - fm) : WGM;
        u.pm = fm + ((wgid % nig) % gsz); u.pn = (wgid % nig) / gsz; return true;
    }
    __device__ __forceinline__ void a_ready(const Unit&) const {}
    __device__ __forceinline__ void done(const Unit&) const {}
};


typedef float f32x2_t __attribute__((ext_vector_type(2)));
typedef __bf16 bf16x2_t __attribute__((ext_vector_type(2)));
__device__ __forceinline__ unsigned cvt_pk_bf16(float lo, float hi) { f32x2_t v = {lo, hi}; bf16x2_t b = __builtin_convertvector(v, bf16x2_t); return __builtin_bit_cast(unsigned, b); }
__device__ __forceinline__ float silu_f(float v) { return v * __builtin_amdgcn_rcpf(1.0f + __expf(-v)); }

struct EpiStore2 {
    static constexpr bool PERM = true, AFTER_DRAIN = false;
    bf16_t* O0; int ld0; bf16_t* O1; int ld1; int split;
    __device__ __forceinline__ void operator()(const f32x4 (&acc)[2][2][4][2], const Unit& u, int wr, int wc, int fr, int fq) const {
        int colt = u.pn * BM; bf16_t* base = O0; int ld = ld0;
        if (colt >= split) { base = O1; ld = ld1; colt -= split; }
        const int row0 = u.pm * BM + wr * 64 + fr, col0 = colt + wc * 32 + 8 * fq;
#pragma unroll
        for (int ai = 0; ai < 2; ++ai)
#pragma unroll
            for (int m = 0; m < 4; ++m) { bf16_t* rowp = base + (size_t)(row0 + ai * HALF + m * 16) * ld + col0;
#pragma unroll
                for (int bj = 0; bj < 2; ++bj) { const f32x4 v0 = acc[ai][bj][m][0], v1 = acc[ai][bj][m][1];
                    u32x4 w; w.x = cvt_pk_bf16(v0[0], v0[1]); w.y = cvt_pk_bf16(v0[2], v0[3]); w.z = cvt_pk_bf16(v1[0], v1[1]); w.w = cvt_pk_bf16(v1[2], v1[3]);
                    *(u32x4*)(rowp + bj * HALF) = w; } }
    }
};
template <int ACT> struct EpiGate {
    static constexpr bool PERM = true, AFTER_DRAIN = false;
    bf16_t* P; int ldp; bf16_t* G; int ldg; int pn_plain;
    __device__ __forceinline__ void operator()(const f32x4 (&acc)[2][2][4][2], const Unit& u, int wr, int wc, int fr, int fq) const {
        const int row0 = u.pm * BM + wr * 64 + fr;
        if (u.pn < pn_plain) {
            const int col0 = u.pn * BM + wc * 32 + 8 * fq;
#pragma unroll
            for (int ai = 0; ai < 2; ++ai)
#pragma unroll
                for (int m = 0; m < 4; ++m) { bf16_t* rowp = P + (size_t)(row0 + ai * HALF + m * 16) * ldp + col0;
#pragma unroll
                    for (int bj = 0; bj < 2; ++bj) { const f32x4 v0 = acc[ai][bj][m][0], v1 = acc[ai][bj][m][1];
                        u32x4 w; w.x = cvt_pk_bf16(v0[0], v0[1]); w.y = cvt_pk_bf16(v0[2], v0[3]); w.z = cvt_pk_bf16(v1[0], v1[1]); w.w = cvt_pk_bf16(v1[2], v1[3]);
                        *(u32x4*)(rowp + bj * HALF) = w; } }
        } else {
            const int col0 = (u.pn - pn_plain) * HALF + wc * 32 + 8 * fq;
#pragma unroll
            for (int ai = 0; ai < 2; ++ai)
#pragma unroll
                for (int m = 0; m < 4; ++m) { bf16_t* rowp = G + (size_t)(row0 + ai * HALF + m * 16) * ldg + col0;
                    f32x4 a0 = acc[ai][0][m][0], a1 = acc[ai][0][m][1]; const f32x4 b0 = acc[ai][1][m][0], b1 = acc[ai][1][m][1];
                    if (ACT == 1) {
#pragma unroll
                        for (int e = 0; e < 4; ++e) { a0[e] = silu_f(a0[e]); a1[e] = silu_f(a1[e]); } }
                    a0 = a0 * b0; a1 = a1 * b1;
                    u32x4 w; w.x = cvt_pk_bf16(a0[0], a0[1]); w.y = cvt_pk_bf16(a0[2], a0[3]); w.z = cvt_pk_bf16(a1[0], a1[1]); w.w = cvt_pk_bf16(a1[2], a1[3]);
                    *(u32x4*)rowp = w; }
        }
    }
};

template <class Epi, class Sched, bool ALIGN_EPI = false, bool SP2 = false>
__device__ __forceinline__ void gemm_phase(PG8_LAS unsigned char* lds, const Gemm g, const Sched& S, const Epi& E) {
    int tid_o = threadIdx.x; asm volatile("" : "+v"(tid_o));
    const int tid = tid_o, wid = __builtin_amdgcn_readfirstlane(tid >> 6), lane = tid & 63, wr = wid >> 2, wc = wid & 3, fr = lane & 15, fq = lane >> 4;
    const int K = g.K, nt = K / BK;
    unsigned voffA[2], voffB[2];
#pragma unroll
    for (int i = 0; i < 2; ++i) { int R, C; stage_rc(tid * 16 + i * 8192, R, C); const int Rb = Epi::PERM ? ((R & ~31) + perm32(R & 31)) : R;
        voffA[i] = (unsigned)(R * K + C) * 2u; voffB[i] = (unsigned)(Rb * K + C) * 2u; }
    const size_t kstep = (size_t)(BK * 2);
    const size_t hstep = (size_t)HALF * K * 2;
    const size_t tstep = 2 * hstep;
    const unsigned ldsw = (unsigned)wid * 1024u;
    const int aoff = lds_byte(wr * 64 + fr, fq * 8), boff = lds_byte(wc * 32 + fr, fq * 8);
#define PG8_SA(b, h) (((b) * 2 + (h)) * HTB)
#define PG8_SB(b, h) ((4 + (b) * 2 + (h)) * HTB)
#define PG8_STAGE(bufoff, gbase, voff) do { _Pragma("unroll") for (int _i = 0; _i < 2; ++_i) \
        __builtin_amdgcn_global_load_lds((const unsigned*)((const char*)(gbase) + (voff)[_i]), (PG8_LAS unsigned*)(lds + (bufoff) + ldsw + _i * 8192), 16, 0, 0); } while (0)
#define PG8_LDA(dst, b, h) do { _Pragma("unroll") for (int m = 0; m < 4; ++m) _Pragma("unroll") for (int k = 0; k < 2; ++k) dst[m][k] = *(const PG8_LAS bf16x8*)(lds + PG8_SA(b, h) + aoff + m * 2048 + k * 1024); } while (0)
#define PG8_LDB(dst, b, h) do { _Pragma("unroll") for (int n = 0; n < 2; ++n) _Pragma("unroll") for (int k = 0; k < 2; ++k) dst[n][k] = *(const PG8_LAS bf16x8*)(lds + PG8_SB(b, h) + boff + n * 2048 + k * 1024); } while (0)
#define PG8_MMA(ai, bj, At, Bt) do { __builtin_amdgcn_s_setprio(1); _Pragma("unroll") for (int m = 0; m < 4; ++m) _Pragma("unroll") for (int n = 0; n < 2; ++n) _Pragma("unroll") for (int k = 0; k < 2; ++k) \
        acc[ai][bj][m][n] = __builtin_amdgcn_mfma_f32_16x16x32_bf16(Bt[n][k], At[m][k], acc[ai][bj][m][n], 0, 0, 0); __builtin_amdgcn_s_setprio(0); } while (0)
#define PG8_WAIT_V(n) asm volatile("s_waitcnt vmcnt(" #n ")" ::: "memory")
#define PG8_WAIT_L(n) asm volatile("s_waitcnt lgkmcnt(" #n ")" ::: "memory")
#define PG8_BAR __builtin_amdgcn_s_barrier()
#define PG8_SCHED __builtin_amdgcn_sched_barrier(0)
    Unit cur, nxt; int ui = 0;
    if (!S.next(0, cur)) return;
    f32x4 acc[2][2][4][2];
#pragma unroll
    for (int a = 0; a < 2; ++a)
#pragma unroll
        for (int b = 0; b < 2; ++b)
#pragma unroll
            for (int m = 0; m < 4; ++m)
#pragma unroll
                for (int n = 0; n < 2; ++n) acc[a][b][m][n] = (f32x4){0.f, 0.f, 0.f, 0.f};
    bf16x8 At[4][2], B0[2][2], B1[2][2];
    const char* cA = (const char*)g.A + (size_t)cur.pm * tstep; const char* cB = (const char*)g.Bt + (size_t)cur.pn * tstep;
    S.a_ready(cur);
    if constexpr (SP2) {
        PG8_STAGE(PG8_SB(0, 0), cB, voffB); PG8_STAGE(PG8_SB(0, 1), cB + hstep, voffB); PG8_STAGE(PG8_SA(0, 0), cA, voffA); PG8_STAGE(PG8_SA(0, 1), cA + hstep, voffA);
        if (wr == 1) PG8_BAR;
        PG8_WAIT_V(2); PG8_BAR;
        PG8_STAGE(PG8_SB(1, 0), cB + kstep, voffB); PG8_STAGE(PG8_SA(1, 0), cA + kstep, voffA); PG8_STAGE(PG8_SB(1, 1), cB + hstep + kstep, voffB);
        PG8_WAIT_V(6); PG8_BAR;
    } else {
        PG8_STAGE(PG8_SB(0, 0), cB, voffB); PG8_STAGE(PG8_SA(0, 0), cA, voffA); PG8_STAGE(PG8_SB(0, 1), cB + hstep, voffB); PG8_STAGE(PG8_SA(0, 1), cA + hstep, voffA);
        if (wr == 1) PG8_BAR;
        PG8_WAIT_V(4); PG8_BAR;
        PG8_STAGE(PG8_SB(1, 0), cB + kstep, voffB); PG8_STAGE(PG8_SA(1, 0), cA + kstep, voffA); PG8_STAGE(PG8_SB(1, 1), cB + hstep + kstep, voffB);
        PG8_WAIT_V(6); PG8_BAR;
    }
    for (;;) {
        const bool has_next = S.next(ui + 1, nxt);
        const char* nA = has_next ? (const char*)g.A + (size_t)nxt.pm * tstep : cA; const char* nB = has_next ? (const char*)g.Bt + (size_t)nxt.pn * tstep : cB;
        for (int t = 0; t < nt; t += 2) {
            const bool last = (t == nt - 2);
            const char* a1 = cA + (size_t)(t + 1) * kstep;
            const char* a2 = last ? nA : cA + (size_t)(t + 2) * kstep; const char* b2 = last ? nB : cB + (size_t)(t + 2) * kstep;
            const char* a3 = a2 + kstep; const char* b3 = b2 + kstep;
            if (last && has_next) S.a_ready(nxt);
            if constexpr (SP2) {
            PG8_LDB(B0, 0, 0); PG8_LDB(B1, 0, 1); PG8_SCHED; PG8_LDA(At, 0, 0); PG8_STAGE(PG8_SA(1, 1), a1 + hstep, voffA);
            PG8_WAIT_V(8); PG8_WAIT_L(0); PG8_BAR; PG8_MMA(0, 0, At, B0); PG8_MMA(0, 1, At, B1); PG8_BAR; PG8_SCHED;
            PG8_LDA(At, 0, 1); PG8_STAGE(PG8_SB(0, 0), b2, voffB); PG8_STAGE(PG8_SB(0, 1), b2 + hstep, voffB); PG8_STAGE(PG8_SA(0, 0), a2, voffA);
            PG8_WAIT_V(8); PG8_WAIT_L(0); PG8_BAR; PG8_MMA(1, 0, At, B0); PG8_MMA(1, 1, At, B1); PG8_BAR; PG8_SCHED;
            PG8_LDB(B0, 1, 0); PG8_LDB(B1, 1, 1); PG8_SCHED; PG8_LDA(At, 1, 0); PG8_STAGE(PG8_SA(0, 1), a2 + hstep, voffA);
            PG8_WAIT_V(8); PG8_WAIT_L(0); PG8_BAR; PG8_MMA(0, 0, At, B0); PG8_MMA(0, 1, At, B1); PG8_BAR; PG8_SCHED;
            PG8_LDA(At, 1, 1); PG8_STAGE(PG8_SB(1, 0), b3, voffB); PG8_STAGE(PG8_SB(1, 1), b3 + hstep, voffB); PG8_STAGE(PG8_SA(1, 0), a3, voffA);
            PG8_WAIT_V(8); PG8_WAIT_L(0); PG8_BAR; PG8_MMA(1, 0, At, B0); PG8_MMA(1, 1, At, B1); PG8_BAR; PG8_SCHED;
            } else {
            PG8_LDB(B0, 0, 0); PG8_SCHED; PG8_LDA(At, 0, 0); PG8_STAGE(PG8_SA(1, 1), a1 + hstep, voffA);
            PG8_WAIT_L(8); PG8_BAR; PG8_WAIT_L(0); PG8_MMA(0, 0, At, B0); PG8_BAR; PG8_SCHED;
            PG8_LDB(B1, 0, 1); PG8_STAGE(PG8_SB(0, 0), b2, voffB);
            PG8_BAR; PG8_WAIT_L(0); PG8_MMA(0, 1, At, B1); PG8_BAR;
            PG8_LDA(At, 0, 1); PG8_STAGE(PG8_SA(0, 0), a2, voffA);
            PG8_BAR; PG8_WAIT_L(0); PG8_MMA(1, 0, At, B0); PG8_BAR; PG8_SCHED;
            PG8_STAGE(PG8_SB(0, 1), b2 + hstep, voffB);
            PG8_WAIT_V(6); PG8_BAR; PG8_MMA(1, 1, At, B1); PG8_BAR;
            PG8_LDB(B0, 1, 0); PG8_SCHED; PG8_LDA(At, 1, 0); PG8_STAGE(PG8_SA(0, 1), a2 + hstep, voffA);
            PG8_WAIT_L(8); PG8_BAR; PG8_WAIT_L(0); PG8_MMA(0, 0, At, B0); PG8_BAR; PG8_SCHED;
            PG8_LDB(B1, 1, 1); PG8_STAGE(PG8_SB(1, 0), b3, voffB);
            PG8_BAR; PG8_WAIT_L(0); PG8_MMA(0, 1, At, B1); PG8_BAR;
            PG8_LDA(At, 1, 1); PG8_STAGE(PG8_SA(1, 0), a3, voffA);
            PG8_BAR; PG8_WAIT_L(0); PG8_MMA(1, 0, At, B0); PG8_BAR; PG8_SCHED;
            PG8_STAGE(PG8_SB(1, 1), b3 + hstep, voffB);
            PG8_WAIT_V(6); PG8_BAR; PG8_MMA(1, 1, At, B1); PG8_BAR;
            }
        }
        if constexpr (ALIGN_EPI) { if (wr == 0) PG8_BAR; }
        if constexpr (!Epi::AFTER_DRAIN) { E(acc, cur, wr, wc, fr, fq); S.done(cur); }
        if (!has_next) break;
#pragma unroll
        for (int a = 0; a < 2; ++a)
#pragma unroll
            for (int b = 0; b < 2; ++b)
#pragma unroll
                for (int m = 0; m < 4; ++m)
#pragma unroll
                    for (int n = 0; n < 2; ++n) acc[a][b][m][n] = (f32x4){0.f, 0.f, 0.f, 0.f};
        cur = nxt; cA = nA; cB = nB; ++ui;
        if constexpr (ALIGN_EPI) { if (wr == 1) PG8_BAR; }
    }
    PG8_WAIT_V(0);
    if constexpr (!ALIGN_EPI) { if (wr == 0) PG8_BAR; }
    PG8_BAR;
    if constexpr (Epi::AFTER_DRAIN) { E.fused(acc, cur, wr, wc, fr, fq, lds, wid, lane); S.done(cur); }
#undef PG8_SA
#undef PG8_SB
#undef PG8_STAGE
#undef PG8_LDA
#undef PG8_LDB
#undef PG8_MMA
#undef PG8_WAIT_V
#undef PG8_WAIT_L
#undef PG8_BAR
#undef PG8_SCHED
}
}

#ifndef PG8_SP2
#define PG8_SP2 true
#endif
#ifndef PG8_ALIGN
#define PG8_ALIGN true
#endif
#ifndef MK_PER_PHASE
#define MK_PER_PHASE 0
#endif

constexpr int NWAVES = 8;
constexpr int DM = 2048, BATCH = 2, SEQ = 8192, M = BATCH * SEQ, DEPTH = 4;
constexpr int HD = 128, HK = 16, HV = 32, KDIM = 2048, VDIM = 4096, QKV = 8192;
constexpr int DNP = 12352, DNP_MAIN = 12288;
constexpr int FF = 5632;
constexpr float LN_EPS = 1e-5f, RMS_EPS = 1e-6f;
constexpr float ALPHA = 1.6817928305074290f;
#ifndef XRES_BF16
#define XRES_BF16 1
#endif
#ifndef DN_CHUNKED
#define DN_CHUNKED 1
#endif
constexpr int N_PHASES = 35;

constexpr size_t MiB = 1u << 20;
constexpr size_t WS_CTL = 0, CTL_ZERO_BYTES = 1 * MiB;
constexpr size_t WS_W_SCIN = 1 * MiB;
constexpr size_t WS_W_SCOUT = WS_W_SCIN + 48 * MiB;
constexpr size_t WS_W_DNIN = WS_W_SCOUT + 16 * MiB;
constexpr size_t WS_W_BA = WS_W_DNIN + 96 * MiB;
constexpr size_t WS_W_DNOUT = WS_W_BA + 1 * MiB;
constexpr size_t WS_W_GU = WS_W_DNOUT + 32 * MiB;
constexpr size_t WS_W_DOWN = WS_W_GU + 176 * MiB;
constexpr size_t WS_XB = WS_W_DOWN + 88 * MiB;
constexpr size_t WS_BIGA = WS_XB + 64 * MiB;
constexpr size_t WS_QKV = WS_BIGA, WS_Z = WS_BIGA + 256 * MiB, WS_O = WS_BIGA;
constexpr size_t WS_GB = WS_BIGA, WS_CU = WS_BIGA + 64 * MiB, WS_A2 = WS_BIGA + 128 * MiB, WS_HID = WS_BIGA;
constexpr size_t WS_BIGB = WS_BIGA + 384 * MiB;
constexpr size_t WS_QC = WS_BIGB, WS_KC = WS_BIGB + 64 * MiB, WS_VC = WS_BIGB + 128 * MiB, WS_A3 = WS_BIGB + 256 * MiB, WS_H1 = WS_BIGB;
constexpr size_t WS_BA = WS_BIGB + 384 * MiB;
constexpr size_t WS_BETA = WS_BA + 4 * MiB, WS_DEC = WS_BETA + 2 * MiB;
constexpr size_t WS_GL = WS_DEC + 2 * MiB;
constexpr size_t WS_KF = WS_GL + 2 * MiB;
constexpr size_t WS_SC = WS_KF + 64 * MiB;
constexpr size_t WS_END = WS_SC + 8 * MiB;
constexpr size_t WS_WF = WS_BIGA, WS_UF = WS_BIGA + 128 * MiB, WS_QF = WS_BIGB + 256 * MiB, WS_AQKF = WS_BIGB + 320 * MiB;
constexpr size_t WS_WF2 = WS_BIGB, WS_UF2 = WS_BIGB + 128 * MiB;
static_assert(WS_END <= (size_t)1476395008ull, "d_ws map exceeds the guaranteed workspace");
constexpr int CW_BAR = 4096;

constexpr int RING_OFF = 0, RING_BYTES = 131072;
constexpr int LDSCTL_OFF = RING_BYTES, MISC_OFF = LDSCTL_OFF + 320, PTAB_OFF = LDSCTL_OFF + 1024;
constexpr int LDS_BYTES = 147456;

#define GAS __attribute__((address_space(1)))
#define LAS __attribute__((address_space(3)))
typedef unsigned short bf16;
typedef unsigned v4u __attribute__((ext_vector_type(4)));
typedef unsigned v2u __attribute__((ext_vector_type(2)));
typedef float f32x4 __attribute__((ext_vector_type(4)));
typedef float f32x16 __attribute__((ext_vector_type(16)));
typedef short bf16x8 __attribute__((ext_vector_type(8)));
typedef GAS unsigned gu32;
#define RLX_AGENT __ATOMIC_RELAXED, __HIP_MEMORY_SCOPE_AGENT
#define LDS_WAIT() asm volatile("s_waitcnt lgkmcnt(0)" ::: "memory")
#define VM_WAIT() asm volatile("s_waitcnt vmcnt(0)" ::: "memory")
__device__ __forceinline__ unsigned pk2(float lo, float hi) { return pg8::cvt_pk_bf16(lo, hi); }
__device__ __forceinline__ float bf_lo(unsigned w) { return __uint_as_float(w << 16); }
__device__ __forceinline__ float bf_hi(unsigned w) { return __uint_as_float(w & 0xffff0000u); }
__device__ __forceinline__ float silu_f(float v) { return v * __builtin_amdgcn_rcpf(1.0f + __expf(-v)); }
#define XB_TMO      128
#define XB_XCNT(j)  (256  + 64 * (j))
#define XB_XSUB(j)  (1280 + 64 * (j))
#define XB_XGEN(j)  (2304 + 64 * (j))
#define XB_TOP      3328
#define XB_TOPGEN   3392
#define XCD_BAR_WORDS 3456
#define XB_SPIN_CAP (1u << 21)

__device__ __forceinline__ unsigned xb_ld(unsigned* p)              { return __hip_atomic_load(p, __ATOMIC_RELAXED, __HIP_MEMORY_SCOPE_AGENT); }
__device__ __forceinline__ unsigned xb_add(unsigned* p, unsigned v) { return __hip_atomic_fetch_add(p, v, __ATOMIC_RELAXED, __HIP_MEMORY_SCOPE_AGENT); }
__device__ __forceinline__ unsigned xb_xcc_id() { return (unsigned)__builtin_amdgcn_s_getreg((3 << 11) | 20) & 0xFu; }
#define XB_SPIN(cond, bar) do { unsigned _sp = 0; while (cond) { __builtin_amdgcn_s_sleep(1); \
    if ((++_sp & 255u) == 0u) { if (xb_ld(&(bar)[XB_TMO])) break; if (_sp > XB_SPIN_CAP) { atomicAdd(&(bar)[XB_TMO], 1u); break; } } } } while (0)

struct XcdBarrier {
    unsigned* bar; unsigned x;
    volatile LAS unsigned* st;
};

__device__ __forceinline__ XcdBarrier xcd_barrier_post(unsigned* bar, volatile LAS unsigned* st) {
    XcdBarrier b; b.bar = bar; b.x = xb_xcc_id(); b.st = st;
    if (threadIdx.x == 0) (void)xb_add(&bar[XB_XCNT(b.x)], 1u);
    return b;
}
__device__ __forceinline__ void xcd_barrier_complete(unsigned* bar, unsigned x, unsigned& nloc, unsigned& nx) {
    const unsigned G = gridDim.x * gridDim.y * gridDim.z;
    unsigned sum, cnt, mine, sp = 0u;
    for (;;) {
        sum = 0u; cnt = 0u; mine = 0u;
#pragma unroll
        for (unsigned j = 0; j < 16; ++j) { const unsigned c = xb_ld(&bar[XB_XCNT(j)]); sum += c; cnt += (c > 0u) ? 1u : 0u; mine = (j == x) ? c : mine; }
        if (sum == G) break;
        __builtin_amdgcn_s_sleep(1);
        if ((++sp & 255u) == 0u) { if (xb_ld(&bar[XB_TMO])) break; if (sp > XB_SPIN_CAP) { atomicAdd(&bar[XB_TMO], 1u); break; } }
    }
    nloc = mine > 0u ? mine : 1u; nx = cnt > 0u ? cnt : 1u;
}

__device__ __forceinline__ void xcd_barrier(const XcdBarrier& b) {
    asm volatile("s_waitcnt vmcnt(0)" ::: "memory");
    __syncthreads();
    if (threadIdx.x == 0) {
        unsigned* bar = b.bar;
        __builtin_amdgcn_s_waitcnt(0);
        unsigned nloc = b.st[0], nx = b.st[1];
        if (nloc == 0u) { xcd_barrier_complete(bar, b.x, nloc, nx); b.st[0] = nloc; b.st[1] = nx; }
        const unsigned old = xb_add(&bar[XB_XSUB(b.x)], 1u);
        const unsigned gen = old / nloc;
        if (old + 1u == (gen + 1u) * nloc) {
            __builtin_amdgcn_fence(__ATOMIC_RELEASE, "agent");
            asm volatile("s_waitcnt vmcnt(0)" ::: "memory");
            const unsigned og = xb_add(&bar[XB_TOP], 1u);
            const unsigned tg = og / nx;
            if (og + 1u == (tg + 1u) * nx) xb_add(&bar[XB_TOPGEN], 1u);
            else XB_SPIN(xb_ld(&bar[XB_TOPGEN]) == tg, bar);
            __builtin_amdgcn_fence(__ATOMIC_ACQUIRE, "agent");
            xb_add(&bar[XB_XGEN(b.x)], 1u);
            asm volatile("s_waitcnt vmcnt(0)" ::: "memory");
        } else {
            XB_SPIN(xb_ld(&bar[XB_XGEN(b.x)]) == gen, bar);
            __builtin_amdgcn_fence(__ATOMIC_ACQUIRE, "agent");
            asm volatile("s_waitcnt vmcnt(0)" ::: "memory");
        }
    }
    __syncthreads();
}

__device__ __forceinline__ float wave_sum(float v) {
#pragma unroll
    for (int o = 1; o < 64; o <<= 1) v += __shfl_xor(v, o);
    return v;
}
__device__ __forceinline__ float sum16(float v) {
    v += __shfl_xor(v, 1); v += __shfl_xor(v, 2); v += __shfl_xor(v, 4); v += __shfl_xor(v, 8);
    return v;
}
template <int CTRL> __device__ __forceinline__ float dppf(float v) { return __builtin_bit_cast(float, __builtin_amdgcn_update_dpp(0, __builtin_bit_cast(int, v), CTRL, 0xF, 0xF, false)); }
__device__ __forceinline__ float rowsum16(float v) {
    v += dppf<0x128>(v); v += dppf<0x124>(v); v += dppf<0x122>(v); v += dppf<0x121>(v);
    return v;
}
__device__ __forceinline__ void unpack8(const v4u w, float (&f)[8]) {
    f[0] = bf_lo(w.x); f[1] = bf_hi(w.x); f[2] = bf_lo(w.y); f[3] = bf_hi(w.y); f[4] = bf_lo(w.z); f[5] = bf_hi(w.z); f[6] = bf_lo(w.w); f[7] = bf_hi(w.w);
}
__device__ __forceinline__ v4u pack8(const float (&f)[8]) { v4u o; o.x = pk2(f[0], f[1]); o.y = pk2(f[2], f[3]); o.z = pk2(f[4], f[5]); o.w = pk2(f[6], f[7]); return o; }

struct Ptrs {
    const float *x, *sc_w_in, *sc_conv_w, *sc_w_out, *dn_w_in, *dn_conv_w, *dn_a_log, *dn_dt_bias, *dn_norm_w, *dn_w_out, *ffn_gu, *ffn_down, *ln_gain, *ln_bias;
    float* out; unsigned char* ws;
};
struct P0Desc { const float* W; bf16* WT; int ldw, src, K, n0, k0, pad; };
constexpr int I_SCIN = 32 * 192, I_SCOUT = 32 * 64, I_DNIN = 32 * 384, I_BA = 32 * 2, I_DNOUT = 64 * 64, I_GU = 32 * 352, I_DOWN = 88 * 64;
constexpr int P0_NITEMS = 2 * (I_SCIN + I_SCOUT + I_DNIN + I_BA + I_DNOUT) + 4 * (I_GU + I_DOWN);
__device__ __forceinline__ P0Desc p0_desc(const Ptrs& P, int it) {
    int r = it; const float* W; int ldw, K, nblk, mode; bf16* WT; int layer;
    if (r < 2 * I_SCIN) { layer = r / I_SCIN; r -= layer * I_SCIN; W = P.sc_w_in + (size_t)layer * DM * 3 * DM; ldw = 3 * DM; K = DM; nblk = 192; mode = 1; WT = (bf16*)(P.ws + WS_W_SCIN) + (size_t)layer * 3 * DM * DM; }
    else { r -= 2 * I_SCIN;
    if (r < 2 * I_SCOUT) { layer = r / I_SCOUT; r -= layer * I_SCOUT; W = P.sc_w_out + (size_t)layer * DM * DM; ldw = DM; K = DM; nblk = 64; mode = 0; WT = (bf16*)(P.ws + WS_W_SCOUT) + (size_t)layer * DM * DM; }
    else { r -= 2 * I_SCOUT;
    if (r < 2 * I_DNIN) { layer = r / I_DNIN; r -= layer * I_DNIN; W = P.dn_w_in + (size_t)layer * DM * DNP; ldw = DNP; K = DM; nblk = 384; mode = 0; WT = (bf16*)(P.ws + WS_W_DNIN) + (size_t)layer * DNP_MAIN * DM; }
    else { r -= 2 * I_DNIN;
    if (r < 2 * I_BA) { layer = r / I_BA; r -= layer * I_BA; W = P.dn_w_in + (size_t)layer * DM * DNP; ldw = DNP; K = DM; nblk = 2; mode = 3; WT = (bf16*)(P.ws + WS_W_BA) + (size_t)layer * 64 * DM; }
    else { r -= 2 * I_BA;
    if (r < 2 * I_DNOUT) { layer = r / I_DNOUT; r -= layer * I_DNOUT; W = P.dn_w_out + (size_t)layer * VDIM * DM; ldw = DM; K = VDIM; nblk = 64; mode = 0; WT = (bf16*)(P.ws + WS_W_DNOUT) + (size_t)layer * DM * VDIM; }
    else { r -= 2 * I_DNOUT;
    if (r < 4 * I_GU) { layer = r / I_GU; r -= layer * I_GU; W = P.ffn_gu + (size_t)layer * DM * 2 * FF; ldw = 2 * FF; K = DM; nblk = 352; mode = 2; WT = (bf16*)(P.ws + WS_W_GU) + (size_t)layer * 2 * FF * DM; }
    else { r -= 4 * I_GU; layer = r / I_DOWN; r -= layer * I_DOWN; W = P.ffn_down + (size_t)layer * FF * DM; ldw = DM; K = FF; nblk = 64; mode = 0; WT = (bf16*)(P.ws + WS_W_DOWN) + (size_t)layer * DM * FF; } } } } } }
    const int kb = r / nblk, nb = r % nblk, n0 = 32 * nb;
    int src;
    if (mode == 0) src = n0;
    else if (mode == 1) { if (n0 < DM) src = n0; else { const int n2 = n0 - DM; src = DM + ((n2 >> 7) & 1) * DM + (n2 >> 8) * 128 + (n2 & 127); } }
    else if (mode == 2) src = ((n0 >> 7) & 1) * FF + (n0 >> 8) * 128 + (n0 & 127);
    else src = DNP_MAIN + n0;
    P0Desc d; d.W = W; d.WT = WT; d.ldw = ldw; d.src = src; d.K = K; d.n0 = n0; d.k0 = 64 * kb; d.pad = 0; return d;
}
__device__ __forceinline__ void p0_load(const P0Desc& d, int lane, float (&tv)[32]) {
#pragma unroll
    for (int i = 0; i < 32; ++i) tv[i] = __builtin_nontemporal_load(&d.W[(size_t)(d.k0 + 2 * i + (lane >> 5)) * d.ldw + d.src + (lane & 31)]);
}
__device__ __forceinline__ void p0_store(const P0Desc& d, LAS float* scr, int lane, const float (&tv)[32]) {
#pragma unroll
    for (int i = 0; i < 32; ++i) scr[(2 * i + (lane >> 5)) * 33 + (lane & 31)] = tv[i];
    LDS_WAIT(); asm volatile("" ::: "memory");
    const int c = lane & 7;
#pragma unroll
    for (int j = 0; j < 4; ++j) { const int n = (lane >> 3) + 8 * j; const LAS float* s = scr + (8 * c) * 33 + n;
        v4u o; o.x = pk2(s[0 * 33], s[1 * 33]); o.y = pk2(s[2 * 33], s[3 * 33]); o.z = pk2(s[4 * 33], s[5 * 33]); o.w = pk2(s[6 * 33], s[7 * 33]);
        *(GAS v4u*)(d.WT + (size_t)(d.n0 + n) * d.K + d.k0 + 8 * c) = o; }
    LDS_WAIT(); asm volatile("" ::: "memory");
}
__device__ __forceinline__ void p0_prologue(const Ptrs& P, LAS unsigned char* lds, int gw, int NGW, int wave, int lane) {
    LAS float* scr = (LAS float*)(lds + RING_OFF + wave * 16384);
    float ta[32], tb[32];
    int it = gw;
    P0Desc da = p0_desc(P, it < P0_NITEMS ? it : 0), db = da;
    if (it < P0_NITEMS) p0_load(da, lane, ta);
    for (; it < P0_NITEMS; it += 2 * NGW) {
        const int i1 = it + NGW, i2 = it + 2 * NGW;
        if (i1 < P0_NITEMS) { db = p0_desc(P, i1); p0_load(db, lane, tb); }
        p0_store(da, scr, lane, ta);
        if (i2 < P0_NITEMS) { da = p0_desc(P, i2); p0_load(da, lane, ta); }
        if (i1 < P0_NITEMS) p0_store(db, scr, lane, tb);
    }
    bf16* XB = (bf16*)(P.ws + WS_XB);
    for (int m = gw; m < M; m += NGW) {
        const GAS f32x4* xr = (const GAS f32x4*)(P.x + (size_t)m * DM) + lane;
        GAS v2u* o8 = (GAS v2u*)(XB + (size_t)m * DM) + lane;
#pragma unroll
        for (int j = 0; j < 8; ++j) { const f32x4 v = xr[64 * j]; v2u o; o.x = pk2(v.x, v.y); o.y = pk2(v.z, v.w); o8[64 * j] = o; }
    }
}

template <bool XIN_F32, bool OUT_F32, bool OUT_BF16>
__device__ __forceinline__ void ln_phase(const float* xin, const bf16* XBin, const bf16* H, const float* gain, const float* bias, float* xout, bf16* XB, int gw, int NGW, int lane) {
    f32x4 g[8], bb[8];
#pragma unroll
    for (int j = 0; j < 8; ++j) { g[j] = ((const GAS f32x4*)gain)[lane + 64 * j]; bb[j] = ((const GAS f32x4*)bias)[lane + 64 * j]; }
    for (int m = gw; m < M; m += 2 * NGW) {
        const int m2 = m + NGW; const bool two = m2 < M; const int mb = two ? m2 : m;
        const GAS v2u* hra = (const GAS v2u*)(H + (size_t)m * DM) + lane; const GAS v2u* hrb = (const GAS v2u*)(H + (size_t)mb * DM) + lane;
        f32x4 va[8], vb[8]; float sa = 0.f, sb = 0.f;
        f32x4 xa[8], xb[8]; v2u ha[8], hb[8];
        if (XIN_F32) { const GAS f32x4* xra = (const GAS f32x4*)(xin + (size_t)m * DM) + lane; const GAS f32x4* xrb = (const GAS f32x4*)(xin + (size_t)mb * DM) + lane;
#pragma unroll
            for (int j = 0; j < 8; ++j) { xa[j] = xra[64 * j]; ha[j] = __builtin_nontemporal_load(&hra[64 * j]); }
#pragma unroll
            for (int j = 0; j < 8; ++j) { xb[j] = xrb[64 * j]; hb[j] = __builtin_nontemporal_load(&hrb[64 * j]); }
        } else { const GAS v2u* xra = (const GAS v2u*)(XBin + (size_t)m * DM) + lane; const GAS v2u* xrb = (const GAS v2u*)(XBin + (size_t)mb * DM) + lane; v2u ta[8], tb2[8];
#pragma unroll
            for (int j = 0; j < 8; ++j) { ta[j] = xra[64 * j]; ha[j] = __builtin_nontemporal_load(&hra[64 * j]); }
#pragma unroll
            for (int j = 0; j < 8; ++j) { tb2[j] = xrb[64 * j]; hb[j] = __builtin_nontemporal_load(&hrb[64 * j]); }
#pragma unroll
            for (int j = 0; j < 8; ++j) { xa[j] = (f32x4){bf_lo(ta[j].x), bf_hi(ta[j].x), bf_lo(ta[j].y), bf_hi(ta[j].y)}; xb[j] = (f32x4){bf_lo(tb2[j].x), bf_hi(tb2[j].x), bf_lo(tb2[j].y), bf_hi(tb2[j].y)}; } }
#pragma unroll
        for (int j = 0; j < 8; ++j) {
            va[j].x = ALPHA * xa[j].x + bf_lo(ha[j].x); va[j].y = ALPHA * xa[j].y + bf_hi(ha[j].x); va[j].z = ALPHA * xa[j].z + bf_lo(ha[j].y); va[j].w = ALPHA * xa[j].w + bf_hi(ha[j].y);
            vb[j].x = ALPHA * xb[j].x + bf_lo(hb[j].x); vb[j].y = ALPHA * xb[j].y + bf_hi(hb[j].x); vb[j].z = ALPHA * xb[j].z + bf_lo(hb[j].y); vb[j].w = ALPHA * xb[j].w + bf_hi(hb[j].y);
            sa += (va[j].x + va[j].y) + (va[j].z + va[j].w); sb += (vb[j].x + vb[j].y) + (vb[j].z + vb[j].w); }
#pragma unroll
        for (int o = 1; o < 64; o <<= 1) { sa += __shfl_xor(sa, o); sb += __shfl_xor(sb, o); }
        const float meana = sa * (1.f / DM), meanb = sb * (1.f / DM); float qa = 0.f, qb = 0.f;
#pragma unroll
        for (int j = 0; j < 8; ++j) { va[j] = va[j] - meana; vb[j] = vb[j] - meanb;
            qa += (va[j].x * va[j].x + va[j].y * va[j].y) + (va[j].z * va[j].z + va[j].w * va[j].w); qb += (vb[j].x * vb[j].x + vb[j].y * vb[j].y) + (vb[j].z * vb[j].z + vb[j].w * vb[j].w); }
#pragma unroll
        for (int o = 1; o < 64; o <<= 1) { qa += __shfl_xor(qa, o); qb += __shfl_xor(qb, o); }
        const float rsa = 1.f / sqrtf(qa * (1.f / DM) + LN_EPS), rsb = 1.f / sqrtf(qb * (1.f / DM) + LN_EPS);
#pragma unroll
        for (int j = 0; j < 8; ++j) { const f32x4 o = va[j] * rsa * g[j] + bb[j];
            if (OUT_F32) ((GAS f32x4*)(xout + (size_t)m * DM) + lane)[64 * j] = o; if (OUT_BF16) { v2u w; w.x = pk2(o.x, o.y); w.y = pk2(o.z, o.w); ((GAS v2u*)(XB + (size_t)m * DM) + lane)[64 * j] = w; } }
        if (two) {
#pragma unroll
            for (int j = 0; j < 8; ++j) { const f32x4 o = vb[j] * rsb * g[j] + bb[j];
                if (OUT_F32) ((GAS f32x4*)(xout + (size_t)m2 * DM) + lane)[64 * j] = o; if (OUT_BF16) { v2u w; w.x = pk2(o.x, o.y); w.y = pk2(o.z, o.w); ((GAS v2u*)(XB + (size_t)m2 * DM) + lane)[64 * j] = w; } } }
    }
}

__device__ __forceinline__ void sc_conv_phase(const bf16* GB, const bf16* CU, const float* cw  , bf16* A2, int gt, int NGT) {
    constexpr int RB = 16, NCG = DM / 8, NITEMS = (M / RB) * NCG;
    for (int it = gt; it < NITEMS; it += NGT) {
        const int cgp = it % NCG, rb = it / NCG, c0 = cgp * 8, r0 = rb * RB;
        float w0[8], w1[8], w2[8];
#pragma unroll
        for (int e = 0; e < 8; e += 4) { const f32x4 a = *(const GAS f32x4*)(cw + c0 + e), b = *(const GAS f32x4*)(cw + DM + c0 + e), c = *(const GAS f32x4*)(cw + 2 * DM + c0 + e);
            w0[e] = a.x; w0[e + 1] = a.y; w0[e + 2] = a.z; w0[e + 3] = a.w; w1[e] = b.x; w1[e + 1] = b.y; w1[e + 2] = b.z; w1[e + 3] = b.w; w2[e] = c.x; w2[e + 1] = c.y; w2[e + 2] = c.z; w2[e + 3] = c.w; }
        float um2[8], um1[8];
        const bool first = (r0 % SEQ) == 0;
        if (first) {
#pragma unroll
            for (int e = 0; e < 8; ++e) { um2[e] = 0.f; um1[e] = 0.f; } }
        else { unpack8(*(const GAS v4u*)(CU + (size_t)(r0 - 2) * DM + c0), um2); unpack8(*(const GAS v4u*)(CU + (size_t)(r0 - 1) * DM + c0), um1); }
#pragma unroll 4
        for (int r = 0; r < RB; ++r) {
            float u0[8], gb[8], o[8];
            unpack8(*(const GAS v4u*)(CU + (size_t)(r0 + r) * DM + c0), u0);
            unpack8(*(const GAS v4u*)(GB + (size_t)(r0 + r) * DM + c0), gb);
#pragma unroll
            for (int e = 0; e < 8; ++e) { o[e] = gb[e] * (w0[e] * um2[e] + w1[e] * um1[e] + w2[e] * u0[e]); um2[e] = um1[e]; um1[e] = u0[e]; }
            *(GAS v4u*)(A2 + (size_t)(r0 + r) * DM + c0) = pack8(o);
        }
    }
}

__device__ __forceinline__ void dn_pre_phase(const bf16* QKVr, const float* cw  , bf16* QC, bf16* KC, bf16* VC, const float* BA, const float* a_log, const float* dt_bias, float* BETA, float* DEC, float* GL,
                                             int gw, int NGW, int lane, int gt, int NGT) {
    constexpr int RB = 8, NCG = QKV / 512, NITEMS = (M / RB) * NCG;
    for (int it = gw; it < NITEMS; it += NGW) {
        const int cgp = it % NCG, rb = it / NCG, c0 = cgp * 512 + lane * 8, r0 = rb * RB;
        float w[4][8];
#pragma unroll
        for (int j = 0; j < 4; ++j)
#pragma unroll
            for (int e = 0; e < 8; e += 4) { const f32x4 a = *(const GAS f32x4*)(cw + (size_t)j * QKV + c0 + e); w[j][e] = a.x; w[j][e + 1] = a.y; w[j][e + 2] = a.z; w[j][e + 3] = a.w; }
        float h3[8], h2[8], h1[8];
        const bool first = (r0 % SEQ) == 0;
        if (first) {
#pragma unroll
            for (int e = 0; e < 8; ++e) { h3[e] = 0.f; h2[e] = 0.f; h1[e] = 0.f; } }
        else { unpack8(*(const GAS v4u*)(QKVr + (size_t)(r0 - 3) * QKV + c0), h3); unpack8(*(const GAS v4u*)(QKVr + (size_t)(r0 - 2) * QKV + c0), h2); unpack8(*(const GAS v4u*)(QKVr + (size_t)(r0 - 1) * QKV + c0), h1); }
        bf16* dst; int ldd, cd; float qs = 1.f; bool norm;
        if (c0 < KDIM) { dst = QC; ldd = KDIM; cd = c0; norm = true; qs = 0.08838834764831845f; }
        else if (c0 < 2 * KDIM) { dst = KC; ldd = KDIM; cd = c0 - KDIM; norm = true; }
        else { dst = VC; ldd = VDIM; cd = c0 - 2 * KDIM; norm = false; }
        v4u rowv[RB];
#pragma unroll
        for (int r = 0; r < RB; ++r) rowv[r] = *(const GAS v4u*)(QKVr + (size_t)(r0 + r) * QKV + c0);
#pragma unroll
        for (int r = 0; r < RB; ++r) {
            float u0[8], o[8]; float ss = 0.f;
            unpack8(rowv[r], u0);
#pragma unroll
            for (int e = 0; e < 8; ++e) { const float c = w[0][e] * h3[e] + w[1][e] * h2[e] + w[2][e] * h1[e] + w[3][e] * u0[e]; o[e] = silu_f(c); ss += o[e] * o[e]; h3[e] = h2[e]; h2[e] = h1[e]; h1[e] = u0[e]; }
            if (norm) { ss = sum16(ss); const float sc = qs / sqrtf(ss + RMS_EPS);
#pragma unroll
                for (int e = 0; e < 8; ++e) o[e] *= sc; }
            *(GAS v4u*)(dst + (size_t)(r0 + r) * ldd + cd) = pack8(o);
        }
    }
    for (int i = gt; i < M * HV; i += NGT) {
        const int hv = i & (HV - 1), row = i >> 5;
        const float br = BA[(size_t)row * 64 + hv], ar = BA[(size_t)row * 64 + HV + hv];
        const float xx = ar + dt_bias[hv];
        const float sp = fmaxf(xx, 0.f) + log1pf(__expf(-fabsf(xx)));
        const float gg = -__expf(a_log[hv]) * sp;
        BETA[i] = 1.f / (1.f + __expf(-br));
        DEC[i] = __expf(gg);
        GL[i] = gg;
    }
}

__device__ __forceinline__ void ba_phase(const bf16* XB, const bf16* Wba, float* BA, LAS unsigned char* lds, int unit, int wave, int lane) {
    const int mt = wave & 1, nt = (wave >> 1) & 1, kh = wave >> 2, r = lane & 31, h = lane >> 5;
    const bf16* ap = XB + (size_t)(unit * 64 + mt * 32 + r) * DM + kh * 1024 + 8 * h;
    const bf16* bp = Wba + (size_t)(nt * 32 + r) * DM + kh * 1024 + 8 * h;
    f32x16 acc = {};
#pragma unroll 8
    for (int ks = 0; ks < 64; ++ks) {
        const bf16x8 a = *(const GAS bf16x8*)(ap + ks * 16), b = *(const GAS bf16x8*)(bp + ks * 16);
        acc = __builtin_amdgcn_mfma_f32_32x32x16_bf16(a, b, acc, 0, 0, 0);
    }
    LAS float* red = (LAS float*)(lds + RING_OFF);
    if (kh == 1) {
#pragma unroll
        for (int i = 0; i < 16; ++i) red[((wave - 4) * 16 + i) * 64 + lane] = acc[i]; }
    __syncthreads();
    if (kh == 0) {
#pragma unroll
        for (int i = 0; i < 16; ++i) { const float v = acc[i] + red[(wave * 16 + i) * 64 + lane];
            const int row = unit * 64 + mt * 32 + (i & 3) + 8 * (i >> 2) + 4 * h;
            BA[(size_t)row * 64 + nt * 32 + r] = v; } }
    __syncthreads();
}

__device__ __forceinline__ void dn_naive_phase(const bf16* QC, const bf16* KC, const bf16* VC, const float* BETA, const float* DEC, float* O, LAS unsigned char* lds, int unit, int tid) {
    constexpr int CT = 32, NCH = SEQ / CT;
    constexpr int BUF = 16384 + 16384 + 4096 + 256;
    const int bh = unit >> 2, vq = unit & 3, b = bh >> 5, hv = bh & 31, hk = hv >> 1;
    const int vl = tid >> 4, p = tid & 15;
    LAS float* ob = (LAS float*)(lds + 2 * BUF);
    const size_t row0 = (size_t)b * SEQ;
    const int lr = tid >> 4, lp = tid & 15;
    const bf16* qsrc = QC + (row0 + lr) * KDIM + hk * HD + lp * 8;
    const bf16* ksrc = KC + (row0 + lr) * KDIM + hk * HD + lp * 8;
    const int vr = (tid & 127) >> 2, vp = tid & 3;
    const bf16* vsrc = VC + (row0 + vr) * VDIM + hv * HD + vq * 32 + vp * 8;
    const float* gsrc = (tid < 32 ? BETA : DEC) + (row0 + (tid & 31)) * HV + hv;
    v4u rq, rk, rv = {0u, 0u, 0u, 0u}; float rg = 0.f;
    rq = *(const GAS v4u*)qsrc; rk = *(const GAS v4u*)ksrc; if (tid < 128) rv = *(const GAS v4u*)vsrc; if (tid < 64) rg = *gsrc;
    float S[8];
#pragma unroll
    for (int i = 0; i < 8; ++i) S[i] = 0.f;
    for (int c = 0; c < NCH; ++c) {
        LAS unsigned char* buf = lds + (c & 1) * BUF;
        { float f[8]; unpack8(rq, f); LAS f32x4* d = (LAS f32x4*)(buf + (lr * 128 + lp * 8) * 4); d[0] = (f32x4){f[0], f[1], f[2], f[3]}; d[1] = (f32x4){f[4], f[5], f[6], f[7]};
          unpack8(rk, f); d = (LAS f32x4*)(buf + 16384 + (lr * 128 + lp * 8) * 4); d[0] = (f32x4){f[0], f[1], f[2], f[3]}; d[1] = (f32x4){f[4], f[5], f[6], f[7]};
          if (tid < 128) { unpack8(rv, f); d = (LAS f32x4*)(buf + 32768 + (vr * 32 + vp * 8) * 4); d[0] = (f32x4){f[0], f[1], f[2], f[3]}; d[1] = (f32x4){f[4], f[5], f[6], f[7]}; }
          if (tid < 64) ((LAS float*)(buf + 36864))[tid] = rg; }
        __syncthreads();
        if (c + 1 < NCH) { const size_t adv = (size_t)(c + 1) * CT;
            rq = *(const GAS v4u*)(qsrc + adv * KDIM); rk = *(const GAS v4u*)(ksrc + adv * KDIM); if (tid < 128) rv = *(const GAS v4u*)(vsrc + adv * VDIM); if (tid < 64) rg = gsrc[adv * HV]; }
        const LAS float* qf = (const LAS float*)buf; const LAS float* kf = (const LAS float*)(buf + 16384); const LAS float* vf = (const LAS float*)(buf + 32768); const LAS float* gf = (const LAS float*)(buf + 36864);
#pragma unroll 4
        for (int tt = 0; tt < CT; ++tt) {
            const f32x4 k0 = *(const LAS f32x4*)(kf + tt * 128 + 8 * p), k1 = *(const LAS f32x4*)(kf + tt * 128 + 8 * p + 4);
            const f32x4 q0 = *(const LAS f32x4*)(qf + tt * 128 + 8 * p), q1 = *(const LAS f32x4*)(qf + tt * 128 + 8 * p + 4);
            const float vt = vf[tt * 32 + vl], bt = gf[tt], at = gf[32 + tt];
            float pred = (S[0] * k0.x + S[1] * k0.y) + (S[2] * k0.z + S[3] * k0.w) + (S[4] * k1.x + S[5] * k1.y) + (S[6] * k1.z + S[7] * k1.w);
            pred = rowsum16(pred);
            const float delta = bt * (vt - at * pred);
            S[0] = at * S[0] + k0.x * delta; S[1] = at * S[1] + k0.y * delta; S[2] = at * S[2] + k0.z * delta; S[3] = at * S[3] + k0.w * delta;
            S[4] = at * S[4] + k1.x * delta; S[5] = at * S[5] + k1.y * delta; S[6] = at * S[6] + k1.z * delta; S[7] = at * S[7] + k1.w * delta;
            float o = (S[0] * q0.x + S[1] * q0.y) + (S[2] * q0.z + S[3] * q0.w) + (S[4] * q1.x + S[5] * q1.y) + (S[6] * q1.z + S[7] * q1.w);
            o = rowsum16(o);
            if (p == 0) ob[tt * 32 + vl] = o;
        }
        __syncthreads();
        if (tid < 256) { const int orow = tid >> 3, oc = (tid & 7) * 4; const f32x4 v = *(const LAS f32x4*)(ob + orow * 32 + oc);
            *(GAS f32x4*)(O + (row0 + (size_t)c * CT + orow) * VDIM + hv * HD + vq * 32 + oc) = v; }
    }
    __syncthreads();
}


constexpr int PL_Q = 0, PL_K = 16384, PL_KT = 32768, PL_VT = 49152, PL_A = 81920, PL_SM = 114688, PL_T0 = 116736, PL_TB = 0;
__device__ __forceinline__ int rm_addr(int row, int col) { return row * 256 + (((col >> 3) ^ (row & 15)) << 4) + (col & 7) * 2; }
__device__ __forceinline__ int kt_addr(int d, int c) { return d * 128 + ((((c >> 3) ^ (d >> 3)) & 7) << 4) + (c & 7) * 2; }
__device__ __forceinline__ int rowof(int rho, int h) { return (rho & 3) + 8 * (rho >> 2) + 4 * h; }
__device__ __forceinline__ unsigned short bf1(float v) { return (unsigned short)(pk2(v, v) & 0xffffu); }

__device__ __forceinline__ void prep_load_rows(const bf16* QKVr, int item, int tid, v4u (&rowv)[11]) {
    const int chunk = item & 127, bk = item >> 7, hk = bk & 15, b = bk >> 4;
    int c0, run;
    if (tid < 256) { const int tq = tid & 127; run = tq >> 4; c0 = (tid >> 7) * KDIM + hk * HD + (tq & 15) * 8; }
    else { const int tv = tid - 256; run = tv >> 5; c0 = 2 * KDIM + hk * 2 * HD + (tv & 31) * 8; }
    const size_t rr0 = (size_t)b * SEQ + (size_t)chunk * 64 + run * 8;
    const bool first = (chunk == 0) && (run == 0);
#pragma unroll
    for (int q = 0; q < 11; ++q) rowv[q] = (first && q < 3) ? (v4u){0u, 0u, 0u, 0u} : __builtin_nontemporal_load((const GAS v4u*)(QKVr + (rr0 + q - 3) * QKV + c0));
}
template <int STG> __device__ __forceinline__ void dn_prep_item(const bf16* QKVr, const float* cw  , const float* BA, const float* a_log, const float* dt_bias, bf16* Wf, bf16* Qf, bf16* Kf, bf16* AQKf, bf16* Uf, float* SC,
                                             LAS unsigned char* lds, int item, int next_item, v4u (&rowv)[11], int tid, int wave, int lane) {
    asm volatile("" : "+v"(tid), "+v"(lane));
    const int chunk = item & 127, bk = item >> 7, hk = bk & 15, b = bk >> 4;
    const size_t tok0 = (size_t)b * SEQ + (size_t)chunk * 64;
    const size_t ki = (size_t)item;
    const int r = lane & 31, h = lane >> 5;
    LAS float* betl = (LAS float*)(lds + PL_SM);
    LAS float* gcl_ = (LAS float*)(lds + PL_SM + 512);
    LAS float* facl = (LAS float*)(lds + PL_SM + 1024);
    if (STG & 1) {
    {   int c0, run, kind;
        if (tid < 256) { const int tq = tid & 127; kind = tid >> 7; run = tq >> 4; c0 = kind * KDIM + hk * HD + (tq & 15) * 8; }
        else { const int tv = tid - 256; kind = 2; run = tv >> 5; c0 = 2 * KDIM + hk * 2 * HD + (tv & 31) * 8; }
        const int lc = (kind == 2) ? (tid & 31) * 8 : (tid & 15) * 8;
        float w[4][8];
#pragma unroll
        for (int j = 0; j < 4; ++j)
#pragma unroll
            for (int e = 0; e < 8; e += 4) { const f32x4 a = *(const GAS f32x4*)(cw + (size_t)j * QKV + c0 + e); w[j][e] = a.x; w[j][e + 1] = a.y; w[j][e + 2] = a.z; w[j][e + 3] = a.w; }
        float h3[8], h2[8], h1[8];
        unpack8(rowv[0], h3); unpack8(rowv[1], h2); unpack8(rowv[2], h1);
        const float qs = (kind == 0) ? 0.08838834764831845f : 1.0f;
        unsigned pw[8][4];
#pragma unroll
        for (int q = 0; q < 8; ++q) {
            float u0[8], o[8]; float ss = 0.f;
            unpack8(rowv[3 + q], u0);
#pragma unroll
            for (int e = 0; e < 8; ++e) { const float c = w[0][e] * h3[e] + w[1][e] * h2[e] + w[2][e] * h1[e] + w[3][e] * u0[e]; o[e] = silu_f(c); ss += o[e] * o[e]; h3[e] = h2[e]; h2[e] = h1[e]; h1[e] = u0[e]; }
            ss = rowsum16(ss);
            const float sc = (kind == 2) ? 1.0f : qs / sqrtf(ss + RMS_EPS);
#pragma unroll
            for (int e = 0; e < 8; ++e) o[e] *= sc;
            const v4u pv = pack8(o); const int row = run * 8 + q;
            pw[q][0] = pv.x; pw[q][1] = pv.y; pw[q][2] = pv.z; pw[q][3] = pv.w;
            if (kind == 0) *(LAS v4u*)(lds + PL_Q + rm_addr(row, lc)) = pv;
            else if (kind == 1) *(LAS v4u*)(lds + PL_K + rm_addr(row, lc)) = pv;
        }
        if (next_item >= 0) prep_load_rows(QKVr, next_item, tid, rowv);
        if (kind != 0) {
            const int tbase = (kind == 1) ? PL_KT : PL_VT;
#pragma unroll
            for (int e2 = 0; e2 < 8; ++e2) { v4u t; unsigned tw[4];
#pragma unroll
                for (int pr = 0; pr < 4; ++pr) { const unsigned a = pw[2 * pr][e2 >> 1], bq = pw[2 * pr + 1][e2 >> 1]; tw[pr] = (e2 & 1) ? ((a >> 16) | (bq & 0xffff0000u)) : ((a & 0xffffu) | (bq << 16)); }
                t.x = tw[0]; t.y = tw[1]; t.z = tw[2]; t.w = tw[3];
                *(LAS v4u*)(lds + tbase + kt_addr(lc + e2, run * 8)) = t; }
        }
    }
    if (wave < 2) { const int hv = 2 * hk + wave; const size_t tk = tok0 + lane;
        const float br = BA[tk * 64 + hv], ar = BA[tk * 64 + HV + hv];
        const float xx = ar + dt_bias[hv];
        const float sp = fmaxf(xx, 0.f) + log1pf(__expf(-fabsf(xx)));
        const float bt = 1.f / (1.f + __expf(-br)); float gc = -__expf(a_log[hv]) * sp;
#pragma unroll
        for (int o = 1; o < 64; o <<= 1) { const float t = __shfl_up(gc, o); if (lane >= o) gc += t; }
        const float gl = __shfl(gc, 63);
        betl[wave * 64 + lane] = bt; gcl_[wave * 64 + lane] = gc; const float eg = __expf(gc);
        facl[(wave * 2 + 0) * 64 + lane] = bt; facl[(wave * 2 + 1) * 64 + lane] = bt * eg;
        float* sc = SC + ((size_t)(b * HV + hv) * 128 + chunk) * 256;
        sc[lane] = eg; sc[64 + lane] = __expf(gl - gc); if (lane == 0) sc[128] = __expf(gl); }
    }
    LDS_WAIT(); __syncthreads();
    if (STG & 2)
    {   f32x16 acc = {};
        if (wave < 4) { const int tc = wave >> 1, tm = wave & 1;
#pragma unroll
            for (int ks = 0; ks < 8; ++ks) { const bf16x8 a = *(const LAS bf16x8*)(lds + PL_K + rm_addr(32 * tc + r, 16 * ks + 8 * h)), bb = *(const LAS bf16x8*)(lds + PL_K + rm_addr(32 * tm + r, 16 * ks + 8 * h));
                acc = __builtin_amdgcn_mfma_f32_32x32x16_bf16(a, bb, acc, 0, 0, 0); }
#pragma unroll
            for (int hvl = 0; hvl < 2; ++hvl) { const int m = 32 * tm + r; const float gm = gcl_[hvl * 64 + m];
                f32x4 g4[4], b4[4];
#pragma unroll
                for (int g = 0; g < 4; ++g) { g4[g] = *(const LAS f32x4*)(gcl_ + hvl * 64 + 32 * tc + 8 * g + 4 * h); b4[g] = *(const LAS f32x4*)(betl + hvl * 64 + 32 * tc + 8 * g + 4 * h); }
#pragma unroll
                for (int rho = 0; rho < 16; ++rho) { const int c = 32 * tc + rowof(rho, h); const float e = __expf(fminf(g4[rho >> 2][rho & 3] - gm, 0.f));
                    const float val = (c > m) ? b4[rho >> 2][rho & 3] * acc[rho] * e : 0.f;
                    *(LAS float*)(lds + PL_A + hvl * 16384 + (c * 64 + m) * 4) = val; } }
        } else { const int tm = (wave - 4) >> 1, tcp = (wave - 4) & 1;
#pragma unroll
            for (int ks = 0; ks < 8; ++ks) { const bf16x8 a = *(const LAS bf16x8*)(lds + PL_K + rm_addr(32 * tm + r, 16 * ks + 8 * h)), bb = *(const LAS bf16x8*)(lds + PL_Q + rm_addr(32 * tcp + r, 16 * ks + 8 * h));
                acc = __builtin_amdgcn_mfma_f32_32x32x16_bf16(a, bb, acc, 0, 0, 0); }
#pragma unroll
            for (int hvl = 0; hvl < 2; ++hvl) { const int cp = 32 * tcp + r; const float gp = gcl_[hvl * 64 + cp]; float val[16];
                f32x4 g4[4];
#pragma unroll
                for (int g = 0; g < 4; ++g) g4[g] = *(const LAS f32x4*)(gcl_ + hvl * 64 + 32 * tm + 8 * g + 4 * h);
#pragma unroll
                for (int rho = 0; rho < 16; ++rho) { const int m = 32 * tm + rowof(rho, h); const float e = __expf(fminf(gp - g4[rho >> 2][rho & 3], 0.f)); val[rho] = (cp >= m) ? acc[rho] * e : 0.f; }
                bf16* dst = AQKf + ((size_t)(b * HV + 2 * hk + hvl) * 128 + chunk) * 4096 + ((tcp * 2 + tm) * 2) * 512 + lane * 8;
                v4u w0, w1; w0.x = pk2(val[0], val[1]); w0.y = pk2(val[2], val[3]); w0.z = pk2(val[4], val[5]); w0.w = pk2(val[6], val[7]);
                w1.x = pk2(val[8], val[9]); w1.y = pk2(val[10], val[11]); w1.z = pk2(val[12], val[13]); w1.w = pk2(val[14], val[15]);
                *(GAS v4u*)dst = w0; *(GAS v4u*)(dst + 512) = w1; } }
#pragma unroll
        for (int e = 0; e < 2; ++e) { const int f = 2 * wave + e;
            { const int t = f >> 3, i = (f >> 1) & 3, s = f & 1, row = 32 * t + r, col0 = 32 * i + 16 * s + 4 * h;
              const v2u lo = *(const LAS v2u*)(lds + PL_Q + rm_addr(row, col0)), hi = *(const LAS v2u*)(lds + PL_Q + rm_addr(row, col0 + 8));
              *(GAS v4u*)(Qf + ki * 8192 + f * 512 + lane * 8) = (v4u){lo.x, lo.y, hi.x, hi.y}; }
            { const int i = f >> 2, t = (f >> 1) & 1, s = f & 1, d = 32 * i + r, c0 = 32 * t + 16 * s + 4 * h;
              const v2u lo = *(const LAS v2u*)(lds + PL_KT + kt_addr(d, c0)), hi = *(const LAS v2u*)(lds + PL_KT + kt_addr(d, c0 + 8));
              *(GAS v4u*)(Kf + ki * 8192 + f * 512 + lane * 8) = (v4u){lo.x, lo.y, hi.x, hi.y}; } }
    }
    LDS_WAIT(); __syncthreads();
    if ((STG & 4) && wave < 2) {
        const int hvl = wave, blk = h, m = r;
        const LAS float* Ah = (const LAS float*)(lds + PL_A + hvl * 16384);
        const LAS float* Ab = Ah + (32 * blk) * 64 + 32 * blk;
        float X[32]; f32x4 ar[2][8];
        ar[1][0] = *(const LAS f32x4*)(Ab + 64);
#pragma unroll
        for (int i = 0; i < 32; ++i) {
            if (i + 1 < 32) {
#pragma unroll
                for (int c = 0; c < (i + 1 + 3) / 4; ++c) ar[(i + 1) & 1][c] = *(const LAS f32x4*)(Ab + (i + 1) * 64 + 4 * c); }
            __builtin_amdgcn_sched_barrier(0);
            float acc = (i == m) ? 1.f : 0.f, acc1 = 0.f, acc2 = 0.f, acc3 = 0.f;
#pragma unroll
            for (int j0 = 0; j0 < i; j0 += 4) { const f32x4 a = ar[i & 1][j0 >> 2];
                acc -= a.x * X[j0]; if (j0 + 1 < i) acc1 -= a.y * X[j0 + 1]; if (j0 + 2 < i) acc2 -= a.z * X[j0 + 2]; if (j0 + 3 < i) acc3 -= a.w * X[j0 + 3]; }
            X[i] = (acc + acc1) + (acc2 + acc3);
            __builtin_amdgcn_sched_barrier(0); }
        LAS unsigned char* t0 = lds + PL_T0 + hvl * 4096;
        if (blk == 0) {
#pragma unroll
            for (int q = 0; q < 4; ++q) { v4u w; w.x = pk2(X[8 * q + 0], X[8 * q + 1]); w.y = pk2(X[8 * q + 2], X[8 * q + 3]); w.z = pk2(X[8 * q + 4], X[8 * q + 5]); w.w = pk2(X[8 * q + 6], X[8 * q + 7]);
                *(LAS v4u*)(t0 + m * 64 + q * 16) = w; }
        } else {
#pragma unroll
            for (int i = 0; i < 32; ++i) *(LAS unsigned short*)(t0 + 2048 + i * 64 + m * 2) = bf1(X[i]);
        }
        LDS_WAIT();
        f32x16 Yv = {}, T10 = {};
#pragma unroll
        for (int sidx = 0; sidx < 2; ++sidx) { const LAS float* ap = Ah + (32 + r) * 64 + 16 * sidx + 8 * h; const f32x4 a0 = *(const LAS f32x4*)ap, a1 = *(const LAS f32x4*)(ap + 4);
            const bf16x8 af = __builtin_bit_cast(bf16x8, (v4u){pk2(a0.x, a0.y), pk2(a0.z, a0.w), pk2(a1.x, a1.y), pk2(a1.z, a1.w)});
            const bf16x8 bq = *(const LAS bf16x8*)(t0 + r * 64 + (16 * sidx + 8 * h) * 2);
            Yv = __builtin_amdgcn_mfma_f32_32x32x16_bf16(af, bq, Yv, 0, 0, 0); }
#pragma unroll
        for (int sidx = 0; sidx < 2; ++sidx) { const v2u lo = *(const LAS v2u*)(t0 + 2048 + r * 64 + (16 * sidx + 4 * h) * 2), hi = *(const LAS v2u*)(t0 + 2048 + r * 64 + (16 * sidx + 8 + 4 * h) * 2);
            const bf16x8 af = __builtin_bit_cast(bf16x8, (v4u){lo.x, lo.y, hi.x, hi.y});
            const bf16x8 bq = __builtin_bit_cast(bf16x8, (v4u){pk2(Yv[8 * sidx + 0], Yv[8 * sidx + 1]), pk2(Yv[8 * sidx + 2], Yv[8 * sidx + 3]), pk2(Yv[8 * sidx + 4], Yv[8 * sidx + 5]), pk2(Yv[8 * sidx + 6], Yv[8 * sidx + 7])});
            T10 = __builtin_amdgcn_mfma_f32_32x32x16_bf16(af, bq, T10, 0, 0, 0); }
        LAS unsigned char* tb = lds + PL_TB + (hvl * 2) * 8192; LAS unsigned char* tbg = tb + 8192;
        { const float bm = betl[hvl * 64 + lane], bgm = facl[(hvl * 2 + 1) * 64 + lane];
#pragma unroll
          for (int i = 0; i < 32; ++i) { const int a = kt_addr(32 * blk + i, lane); *(LAS unsigned short*)(tb + a) = bf1(X[i] * bm); *(LAS unsigned short*)(tbg + a) = bf1(X[i] * bgm); }
          if (blk == 1) {
#pragma unroll
              for (int i = 0; i < 32; ++i) { const int a = kt_addr(i, lane); *(LAS unsigned short*)(tb + a) = 0; *(LAS unsigned short*)(tbg + a) = 0; } } }
        { const float bm = betl[hvl * 64 + m], bgm = facl[(hvl * 2 + 1) * 64 + m];
#pragma unroll
          for (int rho = 0; rho < 16; ++rho) { const int a = kt_addr(32 + rowof(rho, h), m); *(LAS unsigned short*)(tb + a) = bf1(-T10[rho] * bm); *(LAS unsigned short*)(tbg + a) = bf1(-T10[rho] * bgm); } }
    }
    LDS_WAIT(); __syncthreads();
    if (STG & 8)
#pragma unroll
    for (int e = 0; e < 4; ++e) { const int idx = wave * 4 + e, hvl = idx >> 4, job = idx & 15;
        const LAS unsigned char* tb = lds + PL_TB + (hvl * 2) * 8192; const LAS unsigned char* tbg = tb + 8192;
        const size_t ci = (size_t)(b * HV + 2 * hk + hvl) * 128 + chunk;
        f32x16 acc = {};
        if (job < 8) { const int tc = job >> 2, jd = job & 3;
#pragma unroll
            for (int ks = 0; ks < 4; ++ks) { const bf16x8 a = *(const LAS bf16x8*)(tb + kt_addr(32 * tc + r, 16 * ks + 8 * h)), bq = *(const LAS bf16x8*)(lds + PL_VT + kt_addr(hvl * 128 + 32 * jd + r, 16 * ks + 8 * h));
                acc = __builtin_amdgcn_mfma_f32_32x32x16_bf16(a, bq, acc, 0, 0, 0); }
            v4u w0, w1; w0.x = pk2(acc[0], acc[1]); w0.y = pk2(acc[2], acc[3]); w0.z = pk2(acc[4], acc[5]); w0.w = pk2(acc[6], acc[7]);
            w1.x = pk2(acc[8], acc[9]); w1.y = pk2(acc[10], acc[11]); w1.z = pk2(acc[12], acc[13]); w1.w = pk2(acc[14], acc[15]);
            bf16* dst = Uf + ci * 8192 + (size_t)(((jd * 2 + tc) * 64 + lane) * 16);
            *(GAS v4u*)dst = w0; *(GAS v4u*)(dst + 8) = w1;
        } else { const int i = (job - 8) >> 1, t = (job - 8) & 1;
#pragma unroll
            for (int ks = 0; ks < 4; ++ks) { const bf16x8 a = *(const LAS bf16x8*)(lds + PL_KT + kt_addr(32 * i + r, 16 * ks + 8 * h)), bq = *(const LAS bf16x8*)(tbg + kt_addr(32 * t + r, 16 * ks + 8 * h));
                acc = __builtin_amdgcn_mfma_f32_32x32x16_bf16(a, bq, acc, 0, 0, 0); }
            v4u w0, w1; w0.x = pk2(-acc[0], -acc[1]); w0.y = pk2(-acc[2], -acc[3]); w0.z = pk2(-acc[4], -acc[5]); w0.w = pk2(-acc[6], -acc[7]);
            w1.x = pk2(-acc[8], -acc[9]); w1.y = pk2(-acc[10], -acc[11]); w1.z = pk2(-acc[12], -acc[13]); w1.w = pk2(-acc[14], -acc[15]);
            bf16* dst = Wf + ci * 8192 + ((t * 4 + i) * 2) * 512 + lane * 8;
            *(GAS v4u*)dst = w0; *(GAS v4u*)(dst + 512) = w1;
        }
    }
    LDS_WAIT(); __syncthreads();
}

template <int VAR> __device__ __forceinline__ void dn_scan_phase(const bf16* Wf, const bf16* Qf, const bf16* Kf, const bf16* AQKf, const bf16* Uf, const float* SC, bf16* O, LAS unsigned char* lds, int unit, int wave, int lane) {
    constexpr int BUFB = 58368, NST = SEQ / 64;
    constexpr int HOFF = 2 * BUFB, HFLAG = HOFF + 12288;
    const int bh = unit >> 2, jd = unit & 3, b = bh >> 5, hv = bh & 31, hk = hv >> 1;
    const size_t ci0 = (size_t)(b * HV + hv) * 128, ki0 = (size_t)(b * HK + hk) * 128;
    const int r = lane & 31, h = lane >> 5;
    if (wave == 0 && lane < 2) ((LAS unsigned*)(lds + HFLAG))[lane] = 0u;
#define MF(a, bq, c) __builtin_amdgcn_mfma_f32_32x32x16_bf16(a, bq, c, 0, 0, 0)
#define FRAG(off) (*(const LAS bf16x8*)(bp + (off) + lane * 16))
#define PK8(V, s) __builtin_bit_cast(bf16x8, (v4u){pk2(V[8 * (s) + 0], V[8 * (s) + 1]), pk2(V[8 * (s) + 2], V[8 * (s) + 3]), pk2(V[8 * (s) + 4], V[8 * (s) + 5]), pk2(V[8 * (s) + 6], V[8 * (s) + 7])})
#define SBAR() __builtin_amdgcn_sched_barrier(0)
#define RD4(D, o0, o1, o2, o3) do { D[0] = FRAG(o0); D[1] = FRAG(o1); D[2] = FRAG(o2); D[3] = FRAG(o3); } while (0)
#define WF(f) ((f) * 1024)
#define QF(f) (16384 + (f) * 1024)
#define KF(f) (32768 + (f) * 1024)
#define AF(f) (49152 + (f) * 1024)
#define HSB(e) (*(LAS bf16x8*)(lds + HOFF + (e) * 1024 + lane * 16))
#define HVB(e) (*(LAS bf16x8*)(lds + HOFF + 8192 + (e) * 1024 + lane * 16))
#define POLL(w_, val_) do { volatile LAS unsigned* fl_ = (volatile LAS unsigned*)(lds + HFLAG); while (fl_[w_] != (unsigned)(val_)) __builtin_amdgcn_s_sleep(0); asm volatile("" ::: "memory"); } while (0)
    if (wave > 0) {
        const bf16* src; size_t stride;
        if (wave <= 2) { src = Wf + ci0 * 8192 + (wave - 1) * 4096; stride = 8192; }
        else if (wave <= 4) { src = Qf + ki0 * 8192 + (wave - 3) * 4096; stride = 8192; }
        else if (wave <= 6) { src = Kf + ki0 * 8192 + (wave - 5) * 4096; stride = 8192; }
        else { src = AQKf + ci0 * 4096; stride = 4096; }
        src += lane * 8;
        const float* ssrc = SC + ci0 * 256 + lane * 4;
        const int dofs = (wave - 1) * 8192 + lane * 16;
        GAS v4u* obase = (GAS v4u*)(O + ((size_t)b * SEQ + (lane >> 2)) * VDIM + hv * HD + jd * 32 + (lane & 3) * 8);
        v4u RA[8], RB[8]; f32x4 RsA = {0.f, 0.f, 0.f, 0.f}, RsB = {0.f, 0.f, 0.f, 0.f};
#define LD_SET(R, Rs, st) do { const bf16* sp_ = src + (size_t)(st) * stride; _Pragma("unroll") for (int e = 0; e < 8; ++e) R[e] = *(const GAS v4u*)(sp_ + e * 512); if (wave == 1) Rs = *(const GAS f32x4*)(ssrc + (size_t)(st) * 256); } while (0)
#define ST_SET(R, Rs, st) do { LAS unsigned char* bp_ = lds + ((st) & 1) * BUFB; _Pragma("unroll") for (int e = 0; e < 8; ++e) *(LAS v4u*)(bp_ + dofs + e * 1024) = R[e]; if (wave == 1) *(LAS f32x4*)(bp_ + 57344 + lane * 16) = Rs; } while (0)
#define OSTEP(n_) do { if (wave == 1 && VAR < 2) { \
            const LAS unsigned char* bp = lds + ((n_) & 1) * BUFB; const LAS float* scl = (const LAS float*)(bp + 57344); \
            bf16x8 X[4], Y[4], Z[2], Sb[8], Vb[4]; f32x16 oa0 = {}, oa1 = {}; \
            RD4(X, QF(0), QF(1), QF(2), QF(3)); \
            POLL(0, (n_) + 1); \
            _Pragma("unroll") for (int e = 0; e < 8; ++e) Sb[e] = HSB(e); \
            SBAR(); \
            RD4(Y, QF(4), QF(5), QF(6), QF(7)); \
            oa0 = MF(X[0], Sb[0], oa0); oa0 = MF(X[1], Sb[1], oa0); oa0 = MF(X[2], Sb[2], oa0); oa0 = MF(X[3], Sb[3], oa0); \
            SBAR(); \
            RD4(X, QF(8), QF(9), QF(10), QF(11)); \
            oa0 = MF(Y[0], Sb[4], oa0); oa0 = MF(Y[1], Sb[5], oa0); oa0 = MF(Y[2], Sb[6], oa0); oa0 = MF(Y[3], Sb[7], oa0); \
            SBAR(); \
            RD4(Y, QF(12), QF(13), QF(14), QF(15)); \
            oa1 = MF(X[0], Sb[0], oa1); oa1 = MF(X[1], Sb[1], oa1); oa1 = MF(X[2], Sb[2], oa1); oa1 = MF(X[3], Sb[3], oa1); \
            SBAR(); \
            RD4(X, AF(0), AF(1), AF(4), AF(5)); \
            oa1 = MF(Y[0], Sb[4], oa1); oa1 = MF(Y[1], Sb[5], oa1); oa1 = MF(Y[2], Sb[6], oa1); oa1 = MF(Y[3], Sb[7], oa1); \
            SBAR(); \
            Z[0] = FRAG(AF(6)); Z[1] = FRAG(AF(7)); \
            _Pragma("unroll") for (int g = 0; g < 4; ++g) { const f32x4 e0 = *(const LAS f32x4*)(scl + 8 * g + 4 * h), e1 = *(const LAS f32x4*)(scl + 32 + 8 * g + 4 * h); \
                oa0[4 * g + 0] *= e0.x; oa0[4 * g + 1] *= e0.y; oa0[4 * g + 2] *= e0.z; oa0[4 * g + 3] *= e0.w; \
                oa1[4 * g + 0] *= e1.x; oa1[4 * g + 1] *= e1.y; oa1[4 * g + 2] *= e1.z; oa1[4 * g + 3] *= e1.w; } \
            POLL(1, (n_) + 1); \
            _Pragma("unroll") for (int e = 0; e < 4; ++e) Vb[e] = HVB(e); \
            SBAR(); \
            oa0 = MF(X[0], Vb[0], oa0); oa0 = MF(X[1], Vb[1], oa0); \
            oa1 = MF(X[2], Vb[0], oa1); oa1 = MF(X[3], Vb[1], oa1); oa1 = MF(Z[0], Vb[2], oa1); oa1 = MF(Z[1], Vb[3], oa1); \
            if (VAR == 0) { LAS unsigned char* stg = lds + HOFF + 8192;     \
              _Pragma("unroll") for (int rho = 0; rho < 16; ++rho) { *(LAS unsigned short*)(stg + rowof(rho, h) * 64 + r * 2) = bf1(oa0[rho]); *(LAS unsigned short*)(stg + (32 + rowof(rho, h)) * 64 + r * 2) = bf1(oa1[rho]); } \
              LDS_WAIT(); \
              _Pragma("unroll") for (int q = 0; q < 4; ++q) { const v4u ov = *(const LAS v4u*)(stg + (16 * q + (lane >> 2)) * 64 + (lane & 3) * 16); obase[(((size_t)(n_) * 64 + 16 * q) * VDIM) / 8] = ov; } } \
            else { asm volatile("" :: "v"(oa0), "v"(oa1)); } \
            SBAR(); } } while (0)
        LD_SET(RA, RsA, 0); ST_SET(RA, RsA, 0);
        LD_SET(RA, RsA, 1); LD_SET(RB, RsB, 2);
        for (int n = 0; n < NST; n += 2) {
            LDS_WAIT(); __builtin_amdgcn_s_barrier(); asm volatile("" ::: "memory");
            if (n + 1 < NST) ST_SET(RA, RsA, n + 1);
            if (n + 3 < NST) LD_SET(RA, RsA, n + 3);
            OSTEP(n);
            LDS_WAIT(); __builtin_amdgcn_s_barrier(); asm volatile("" ::: "memory");
            if (n + 2 < NST) ST_SET(RB, RsB, n + 2);
            if (n + 4 < NST) LD_SET(RB, RsB, n + 4);
            OSTEP(n + 1);
        }
#undef LD_SET
#undef ST_SET
#undef OSTEP
    } else {
        f32x16 S0 = {}, S1 = {}, S2 = {}, S3 = {};
        const bf16* usrc = Uf + ci0 * 8192 + (size_t)((jd * 2) * 64 + lane) * 16;
        v4u un[4];
        un[0] = *(const GAS v4u*)usrc; un[1] = *(const GAS v4u*)(usrc + 8); un[2] = *(const GAS v4u*)(usrc + 1024); un[3] = *(const GAS v4u*)(usrc + 1032);
        for (int n = 0; n < NST; ++n) {
            LDS_WAIT(); __builtin_amdgcn_s_barrier(); asm volatile("" ::: "memory");
            if (VAR == 3) continue;
            const LAS unsigned char* bp = lds + (n & 1) * BUFB;
            const LAS float* scl = (const LAS float*)(bp + 57344);
            bf16x8 X[4], Y[4];
            RD4(X, WF(0), WF(1), WF(2), WF(3));
            f32x16 P0, P1;
            { float uu[8]; unpack8(un[0], uu);
#pragma unroll
              for (int e = 0; e < 8; ++e) P0[e] = uu[e];
              unpack8(un[1], uu);
#pragma unroll
              for (int e = 0; e < 8; ++e) P0[8 + e] = uu[e];
              unpack8(un[2], uu);
#pragma unroll
              for (int e = 0; e < 8; ++e) P1[e] = uu[e];
              unpack8(un[3], uu);
#pragma unroll
              for (int e = 0; e < 8; ++e) P1[8 + e] = uu[e]; }
            if (n + 1 < NST) { const bf16* up = usrc + (size_t)(n + 1) * 8192; un[0] = *(const GAS v4u*)up; un[1] = *(const GAS v4u*)(up + 8); un[2] = *(const GAS v4u*)(up + 1024); un[3] = *(const GAS v4u*)(up + 1032); }
            const bf16x8 Sb00 = PK8(S0, 0), Sb01 = PK8(S0, 1), Sb10 = PK8(S1, 0), Sb11 = PK8(S1, 1), Sb20 = PK8(S2, 0), Sb21 = PK8(S2, 1), Sb30 = PK8(S3, 0), Sb31 = PK8(S3, 1);
            HSB(0) = Sb00; HSB(1) = Sb01; HSB(2) = Sb10; HSB(3) = Sb11; HSB(4) = Sb20; HSB(5) = Sb21; HSB(6) = Sb30; HSB(7) = Sb31;
            asm volatile("" ::: "memory");
            if (lane == 0) ((volatile LAS unsigned*)(lds + HFLAG))[0] = (unsigned)(n + 1);
            SBAR();
            RD4(Y, WF(4), WF(5), WF(6), WF(7));
            P0 = MF(X[0], Sb00, P0); P0 = MF(X[1], Sb01, P0); P0 = MF(X[2], Sb10, P0); P0 = MF(X[3], Sb11, P0);
            { const float cd = scl[128]; S0 = S0 * cd; S1 = S1 * cd; S2 = S2 * cd; S3 = S3 * cd; }
            SBAR();
            RD4(X, WF(8), WF(9), WF(10), WF(11));
            P0 = MF(Y[0], Sb20, P0); P0 = MF(Y[1], Sb21, P0); P0 = MF(Y[2], Sb30, P0); P0 = MF(Y[3], Sb31, P0);
            SBAR();
            RD4(Y, WF(12), WF(13), WF(14), WF(15));
            P1 = MF(X[0], Sb00, P1); P1 = MF(X[1], Sb01, P1); P1 = MF(X[2], Sb10, P1); P1 = MF(X[3], Sb11, P1);
            bf16x8 Vb00, Vb01, Ve00, Ve01, Vb10, Vb11, Ve10, Ve11;
            { float E[16];
#pragma unroll
              for (int g = 0; g < 4; ++g) { const f32x4 k0 = *(const LAS f32x4*)(scl + 64 + 8 * g + 4 * h);
                  E[4 * g + 0] = P0[4 * g + 0] * k0.x; E[4 * g + 1] = P0[4 * g + 1] * k0.y; E[4 * g + 2] = P0[4 * g + 2] * k0.z; E[4 * g + 3] = P0[4 * g + 3] * k0.w; }
              Vb00 = PK8(P0, 0); Vb01 = PK8(P0, 1); Ve00 = PK8(E, 0); Ve01 = PK8(E, 1); }
            SBAR();
            RD4(X, KF(0), KF(1), KF(4), KF(5));
            P1 = MF(Y[0], Sb20, P1); P1 = MF(Y[1], Sb21, P1); P1 = MF(Y[2], Sb30, P1); P1 = MF(Y[3], Sb31, P1);
            HVB(0) = Vb00; HVB(1) = Vb01;
            SBAR();
            RD4(Y, KF(8), KF(9), KF(12), KF(13));
            S0 = MF(X[0], Ve00, S0); S0 = MF(X[1], Ve01, S0); S1 = MF(X[2], Ve00, S1); S1 = MF(X[3], Ve01, S1);
            { float E[16];
#pragma unroll
              for (int g = 0; g < 4; ++g) { const f32x4 k1 = *(const LAS f32x4*)(scl + 64 + 32 + 8 * g + 4 * h);
                  E[4 * g + 0] = P1[4 * g + 0] * k1.x; E[4 * g + 1] = P1[4 * g + 1] * k1.y; E[4 * g + 2] = P1[4 * g + 2] * k1.z; E[4 * g + 3] = P1[4 * g + 3] * k1.w; }
              Vb10 = PK8(P1, 0); Vb11 = PK8(P1, 1); Ve10 = PK8(E, 0); Ve11 = PK8(E, 1); }
            SBAR();
            RD4(X, KF(2), KF(3), KF(6), KF(7));
            S2 = MF(Y[0], Ve00, S2); S2 = MF(Y[1], Ve01, S2); S3 = MF(Y[2], Ve00, S3); S3 = MF(Y[3], Ve01, S3);
            HVB(2) = Vb10; HVB(3) = Vb11;
            asm volatile("" ::: "memory");
            if (lane == 0) ((volatile LAS unsigned*)(lds + HFLAG))[1] = (unsigned)(n + 1);
            SBAR();
            RD4(Y, KF(10), KF(11), KF(14), KF(15));
            S0 = MF(X[0], Ve10, S0); S0 = MF(X[1], Ve11, S0); S1 = MF(X[2], Ve10, S1); S1 = MF(X[3], Ve11, S1);
            SBAR();
            S2 = MF(Y[0], Ve10, S2); S2 = MF(Y[1], Ve11, S2); S3 = MF(Y[2], Ve10, S3); S3 = MF(Y[3], Ve11, S3);
            SBAR();
        }
        asm volatile("" :: "v"(S0), "v"(S1), "v"(S2), "v"(S3));
    }
#undef MF
#undef FRAG
#undef PK8
#undef SBAR
#undef RD4
#undef WF
#undef QF
#undef KF
#undef AF
#undef HSB
#undef HVB
#undef POLL
    LDS_WAIT(); __syncthreads();
}

__device__ __forceinline__ void dn_gnorm_phase(const bf16* O, const bf16* Z, const float* nw, bf16* A3, int gw, int NGW, int lane) {
    constexpr int NCG = VDIM / 512, NITEMS = M * NCG;
    float wv[8];
    { const f32x4 a = *(const GAS f32x4*)(nw + (lane & 15) * 8), b = *(const GAS f32x4*)(nw + (lane & 15) * 8 + 4); wv[0] = a.x; wv[1] = a.y; wv[2] = a.z; wv[3] = a.w; wv[4] = b.x; wv[5] = b.y; wv[6] = b.z; wv[7] = b.w; }
#pragma unroll 4
    for (int it = gw; it < NITEMS; it += NGW) {
        const int cgp = it % NCG, row = it / NCG, c0 = cgp * 512 + lane * 8;
        float o[8]; unpack8(__builtin_nontemporal_load((const GAS v4u*)(O + (size_t)row * VDIM + c0)), o);
        float z[8]; unpack8(__builtin_nontemporal_load((const GAS v4u*)(Z + (size_t)row * VDIM + c0)), z);
        float ss = 0.f;
#pragma unroll
        for (int e = 0; e < 8; ++e) ss += o[e] * o[e];
        ss = sum16(ss);
        const float rs = 1.f / sqrtf(ss * (1.f / HD) + RMS_EPS);
#pragma unroll
        for (int e = 0; e < 8; ++e) o[e] = o[e] * rs * wv[e] * silu_f(z[e]);
        *(GAS v4u*)(A3 + (size_t)row * VDIM + c0) = pack8(o);
    }
}

struct Args { const float* in[14]; float* out; unsigned char* ws; int ph_lo, ph_hi, li, pad; };
__device__ __forceinline__ unsigned long long ptab_get(LAS unsigned char* lds, int i) {
    volatile LAS unsigned* p = (volatile LAS unsigned*)(lds + PTAB_OFF) + 2 * i;
    const unsigned lo = __builtin_amdgcn_readfirstlane(p[0]), hi = __builtin_amdgcn_readfirstlane(p[1]);
    return ((unsigned long long)hi << 32) | lo;
}
#ifndef SCAN_PROBE
#define SCAN_PROBE 0
#endif
#ifndef PREP_PROBE
#define PREP_PROBE 0
#endif
#ifndef REP_MASK
#define REP_MASK 0
#endif
#define REPS(t) for (int rep_ = 0; rep_ < 1 + ((REP_MASK >> (t)) & 1); ++rep_)
#define PIN(i) ((const float*)ptab_get(lds, (i)))
#define POUT ((float*)ptab_get(lds, 14))
#define PWS ((unsigned char*)ptab_get(lds, 15))
#define LOCAL_IDS int tid = threadIdx.x; asm volatile("" : "+v"(tid)); const int lane = tid & 63, wave = __builtin_amdgcn_readfirstlane(tid >> 6); const int G = gridDim.x, bx = blockIdx.x; \
    const int vcu = (G % 8 == 0) ? (bx % 8) * (G / 8) + bx / 8 : bx; const int gw = vcu * NWAVES + wave, NGW = G * NWAVES, gt = vcu * (NWAVES * 64) + tid, NGT = G * NWAVES * 64; \
    unsigned char* const ws = PWS; (void)lane; (void)gw; (void)NGW; (void)gt; (void)NGT; (void)ws
__global__ void __launch_bounds__(NWAVES * 64, 2) fwd(Args args) {
    extern __shared__ __attribute__((aligned(16))) unsigned char lds_raw[];
    LAS unsigned char* lds = (LAS unsigned char*)lds_raw;
    volatile LAS unsigned* MISC = (volatile LAS unsigned*)(lds + MISC_OFF);
    for (int u = threadIdx.x; u < (LDS_BYTES - LDSCTL_OFF) / 4; u += NWAVES * 64) ((LAS unsigned*)(lds + LDSCTL_OFF))[u] = 0u;
    __syncthreads();
    if (threadIdx.x == 0) {
        LAS unsigned long long* pt = (LAS unsigned long long*)(lds + PTAB_OFF);
#pragma unroll
        for (int i = 0; i < 14; ++i) pt[i] = (unsigned long long)args.in[i];
        pt[14] = (unsigned long long)args.out; pt[15] = (unsigned long long)args.ws;
    }
    __syncthreads();
    if (threadIdx.x == 0) { LAS unsigned* pw = (LAS unsigned*)(lds + PTAB_OFF) + 32; pw[0] = (unsigned)args.ph_lo; pw[1] = (unsigned)args.ph_hi; }
    if (!MK_PER_PHASE) (void)xcd_barrier_post((unsigned*)(args.ws + WS_CTL) + CW_BAR, MISC + 8);
    __syncthreads();
#define PH_LO ((int)__builtin_amdgcn_readfirstlane(((volatile LAS unsigned*)(lds + PTAB_OFF))[32]))
#define PH_HI ((int)__builtin_amdgcn_readfirstlane(((volatile LAS unsigned*)(lds + PTAB_OFF))[33]))
#define IN(k) (PH_LO <= (k) && (k) < PH_HI)
#define SEAM(k) do { if (!MK_PER_PHASE) { if (IN(k) && IN((k) + 1)) { XcdBarrier bar_; bar_.bar = (unsigned*)(PWS + WS_CTL) + CW_BAR; bar_.x = xb_xcc_id(); bar_.st = MISC + 8; xcd_barrier(bar_); } } } while (0)

    if (IN(0)) REPS(0) { LOCAL_IDS; Ptrs P; P.x = PIN(0); P.sc_w_in = PIN(1); P.sc_w_out = PIN(3); P.dn_w_in = PIN(4); P.dn_w_out = PIN(9); P.ffn_gu = PIN(10); P.ffn_down = PIN(11); P.ws = ws;
        p0_prologue(P, lds, gw, NGW, wave, lane); }
    SEAM(0);

    for (int L = 0; L < DEPTH; ++L) {
        const int j = L >> 1;
        const int pb = 1 + 17 * j + ((L & 1) ? 7 : 0);
        int fb;
        if ((L & 1) == 0) {
            if (IN(pb + 0)) REPS(1) {
                LOCAL_IDS;
                pg8::Gemm g{(const bf16*)(ws + WS_XB), (const bf16*)(ws + WS_W_SCIN) + (size_t)j * 3 * DM * DM, M, 3 * DM, DM}; pg8::StaticOrder S; S.init(M, 3 * DM, G, bx);
                pg8::EpiGate<0> E{(bf16*)(ws + WS_GB), DM, (bf16*)(ws + WS_CU), DM, DM / 256};
                pg8::gemm_phase<pg8::EpiGate<0>, pg8::StaticOrder, PG8_ALIGN, PG8_SP2>(lds + RING_OFF, g, S, E);
            }
            SEAM(pb + 0);
            if (IN(pb + 1)) REPS(2) { LOCAL_IDS; sc_conv_phase((const bf16*)(ws + WS_GB), (const bf16*)(ws + WS_CU), PIN(2) + (size_t)j * 3 * DM, (bf16*)(ws + WS_A2), gt, NGT); }
            SEAM(pb + 1);
            if (IN(pb + 2)) REPS(3) {
                LOCAL_IDS;
                pg8::Gemm g{(const bf16*)(ws + WS_A2), (const bf16*)(ws + WS_W_SCOUT) + (size_t)j * DM * DM, M, DM, DM}; pg8::StaticOrder S; S.init(M, DM, G, bx);
                pg8::EpiStore2 E{(bf16*)(ws + WS_H1), DM, (bf16*)(ws + WS_H1), DM, 1 << 30};
                pg8::gemm_phase<pg8::EpiStore2, pg8::StaticOrder, PG8_ALIGN, PG8_SP2>(lds + RING_OFF, g, S, E);
            }
            SEAM(pb + 2);
#define LN_ARGS(s_) (const bf16*)(ws + WS_XB), (const bf16*)(ws + WS_H1), PIN(12) + (size_t)(L * 2 + (s_)) * DM, PIN(13) + (size_t)(L * 2 + (s_)) * DM, POUT, (rep_ ? (bf16*)POUT : (bf16*)(ws + WS_XB)), gw, NGW, lane
#if XRES_BF16
            if (IN(pb + 3)) REPS(4) { LOCAL_IDS; if (L == 0) ln_phase<true, false, true>(PIN(0), LN_ARGS(0)); else ln_phase<false, false, true>(PIN(0), LN_ARGS(0)); }
#else
            if (IN(pb + 3)) { LOCAL_IDS; const int rep_ = 0; ln_phase<true, true, true>((L == 0) ? PIN(0) : (const float*)POUT, LN_ARGS(0)); }
#endif
            SEAM(pb + 3);
            fb = pb + 4;
        } else {
            if (IN(pb + 0)) REPS(5) {
                LOCAL_IDS;
                pg8::Gemm g{(const bf16*)(ws + WS_XB), (const bf16*)(ws + WS_W_DNIN) + (size_t)j * DNP_MAIN * DM, M, DNP_MAIN, DM}; pg8::StaticOrder S; S.init(M, DNP_MAIN, G, bx);
                pg8::EpiStore2 E{(bf16*)(ws + WS_QKV), QKV, (bf16*)(ws + WS_Z), VDIM, QKV};
                pg8::gemm_phase<pg8::EpiStore2, pg8::StaticOrder, PG8_ALIGN, PG8_SP2>(lds + RING_OFF, g, S, E);
            }
            if (IN(pb + 0)) {
                LOCAL_IDS;
                for (int u = bx; u < M / 64; u += G) ba_phase((const bf16*)(ws + WS_XB), (const bf16*)(ws + WS_W_BA) + (size_t)j * 64 * DM, (float*)(ws + WS_BA), lds, u, wave, lane);
            }
            SEAM(pb + 0);
#if DN_CHUNKED
            if (IN(pb + 2)) { LOCAL_IDS; constexpr int NIT = BATCH * HK * (SEQ / 64);
                v4u rowv[11];
                prep_load_rows((const bf16*)(ws + WS_QKV), vcu < NIT ? vcu : 0, tid, rowv);
                for (int it = vcu; it < NIT; it += G) {
                    dn_prep_item<15>((const bf16*)(ws + WS_QKV), PIN(5) + (size_t)j * 4 * QKV, (const float*)(ws + WS_BA), PIN(6) + j * HV, PIN(7) + j * HV,
                                     (bf16*)(ws + WS_WF2), (bf16*)(ws + WS_QF), (bf16*)(ws + WS_KF), (bf16*)(ws + WS_AQKF), (bf16*)(ws + WS_UF2), (float*)(ws + WS_SC), lds, it, (it + G < NIT) ? it + G : -1, rowv, tid, wave, lane);
#if PREP_PROBE
                    { v4u rowp[11]; prep_load_rows((const bf16*)(ws + WS_QKV), it, tid, rowp);
                      dn_prep_item<PREP_PROBE>((const bf16*)(ws + WS_QKV), PIN(5) + (size_t)j * 4 * QKV, (const float*)(ws + WS_BA), PIN(6) + j * HV, PIN(7) + j * HV,
                                     (bf16*)(ws + WS_WF2), (bf16*)(ws + WS_QF), (bf16*)(ws + WS_KF), (bf16*)(ws + WS_AQKF), (bf16*)(ws + WS_UF2), (float*)(ws + WS_SC), lds, it, -1, rowp, tid, wave, lane); }
#endif
                } }
            SEAM(pb + 2);
            if (IN(pb + 3)) REPS(12) { LOCAL_IDS; for (int u = vcu; u < BATCH * HV * 4; u += G)
                dn_scan_phase<0>((const bf16*)(ws + WS_WF2), (const bf16*)(ws + WS_QF), (const bf16*)(ws + WS_KF), (const bf16*)(ws + WS_AQKF), (const bf16*)(ws + WS_UF2), (const float*)(ws + WS_SC), (bf16*)(ws + WS_O), lds, u, wave, lane); }
#if SCAN_PROBE
            if (IN(pb + 3)) { LOCAL_IDS; for (int u = vcu; u < BATCH * HV * 4; u += G)
                dn_scan_phase<SCAN_PROBE>((const bf16*)(ws + WS_WF2), (const bf16*)(ws + WS_QF), (const bf16*)(ws + WS_KF), (const bf16*)(ws + WS_AQKF), (const bf16*)(ws + WS_UF2), (const float*)(ws + WS_SC), (bf16*)(ws + WS_O), lds, u, wave, lane); }
#endif
            SEAM(pb + 3);
            if (IN(pb + 4)) REPS(8) { LOCAL_IDS; dn_gnorm_phase((const bf16*)(ws + WS_O), (const bf16*)(ws + WS_Z), PIN(8) + j * HD, (bf16*)(ws + WS_A3), gw, NGW, lane); }
#else
#error "the token-recurrent reference path was removed (see the earlier versions); build with DN_CHUNKED = 1"
#endif
            SEAM(pb + 4);
            if (IN(pb + 5)) REPS(9) {
                LOCAL_IDS;
                pg8::Gemm g{(const bf16*)(ws + WS_A3), (const bf16*)(ws + WS_W_DNOUT) + (size_t)j * DM * VDIM, M, DM, VDIM}; pg8::StaticOrder S; S.init(M, DM, G, bx);
                pg8::EpiStore2 E{(bf16*)(ws + WS_H1), DM, (bf16*)(ws + WS_H1), DM, 1 << 30};
                pg8::gemm_phase<pg8::EpiStore2, pg8::StaticOrder, PG8_ALIGN, PG8_SP2>(lds + RING_OFF, g, S, E);
            }
            SEAM(pb + 5);
#if XRES_BF16
            if (IN(pb + 6)) REPS(4) { LOCAL_IDS; ln_phase<false, false, true>(PIN(0), LN_ARGS(0)); }
#else
            if (IN(pb + 6)) { LOCAL_IDS; const int rep_ = 0; ln_phase<true, true, true>((const float*)POUT, LN_ARGS(0)); }
#endif
            SEAM(pb + 6);
            fb = pb + 7;
        }
        if (IN(fb + 0)) REPS(10) {
            LOCAL_IDS;
            pg8::Gemm g{(const bf16*)(ws + WS_XB), (const bf16*)(ws + WS_W_GU) + (size_t)L * 2 * FF * DM, M, 2 * FF, DM}; pg8::StaticOrder S; S.init(M, 2 * FF, G, bx);
            pg8::EpiGate<1> E{(bf16*)(ws + WS_HID), FF, (bf16*)(ws + WS_HID), FF, 0};
            pg8::gemm_phase<pg8::EpiGate<1>, pg8::StaticOrder, PG8_ALIGN, PG8_SP2>(lds + RING_OFF, g, S, E);
        }
        SEAM(fb + 0);
        if (IN(fb + 1)) REPS(11) {
            LOCAL_IDS;
            pg8::Gemm g{(const bf16*)(ws + WS_HID), (const bf16*)(ws + WS_W_DOWN) + (size_t)L * DM * FF, M, DM, FF}; pg8::StaticOrder S; S.init(M, DM, G, bx);
            pg8::EpiStore2 E{(bf16*)(ws + WS_H1), DM, (bf16*)(ws + WS_H1), DM, 1 << 30};
            pg8::gemm_phase<pg8::EpiStore2, pg8::StaticOrder, PG8_ALIGN, PG8_SP2>(lds + RING_OFF, g, S, E);
        }
        SEAM(fb + 1);
#if XRES_BF16
        if (IN(fb + 2)) REPS(4) { LOCAL_IDS; if (L == DEPTH - 1) { if (rep_ == 0) ln_phase<false, true, false>(PIN(0), LN_ARGS(1)); } else ln_phase<false, false, true>(PIN(0), LN_ARGS(1)); }
#else
        if (IN(fb + 2)) { LOCAL_IDS; const int rep_ = 0; ln_phase<true, true, true>((const float*)POUT, LN_ARGS(1)); }
#endif
        SEAM(fb + 2);
    }
#undef IN
#undef SEAM
}

extern "C" void kernel_launch(void* const* d_in, const int* in_sizes, int n_in, void* d_out, int out_size, void* d_ws, size_t ws_size, hipStream_t stream) {
    static int grid = 0;
    if (grid == 0) {
        if (n_in != 14 || in_sizes[0] != M * DM || out_size != M * DM || ws_size < WS_END) { fprintf(stderr, "kernel_launch: unexpected shapes (n_in %d, in0 %d, out %d, ws %zu < %zu); nothing launched\n", n_in, n_in > 0 ? in_sizes[0] : -1, out_size, ws_size, (size_t)WS_END); grid = -1; return; }
        int dev = 0, cus = 0, per_cu = 0;
        if (hipGetDevice(&dev) != hipSuccess || hipDeviceGetAttribute(&cus, hipDeviceAttributeMultiprocessorCount, dev) != hipSuccess) { grid = -1; return; }
        if (hipFuncSetAttribute((const void*)fwd, hipFuncAttributeMaxDynamicSharedMemorySize, LDS_BYTES) != hipSuccess) { fprintf(stderr, "kernel_launch: hipFuncSetAttribute failed\n"); grid = -1; return; }
        if (hipOccupancyMaxActiveBlocksPerMultiprocessor(&per_cu, (const void*)fwd, NWAVES * 64, LDS_BYTES) != hipSuccess || per_cu < 1) fprintf(stderr, "kernel_launch: occupancy query reports %d\n", per_cu);
        (void)hipGetLastError();
        grid = cus;
        if (grid > 256) grid = 256;
    }
    if (grid < 0) return;
    if (hipMemsetAsync((char*)d_ws + WS_CTL, 0, CTL_ZERO_BYTES, stream) != hipSuccess) return;
    Args a{};
    for (int i = 0; i < 14; ++i) a.in[i] = (const float*)d_in[i];
    a.out = (float*)d_out; a.ws = (unsigned char*)d_ws;
#if MK_PER_PHASE
    for (int p = 0; p < N_PHASES; ++p) { a.ph_lo = p; a.ph_hi = p + 1; a.li = p; hipLaunchKernelGGL(fwd, dim3(grid), dim3(NWAVES * 64), LDS_BYTES, stream, a); }
#else
    a.ph_lo = 0; a.ph_hi = N_PHASES; a.li = 0;
    hipLaunchKernelGGL(fwd, dim3(grid), dim3(NWAVES * 64), LDS_BYTES, stream, a);
#endif
}
```

```cpp
#include <hip/hip_runtime.h>
#include <cstdio>
#include <cstdint>
namespace pg8 {
#define PG8_LAS __attribute__((address_space(3)))
typedef unsigned short bf16_t;
typedef short bf16x8 __attribute__((ext_vector_type(8)));
typedef float f32x4 __attribute__((ext_vector_type(4)));
typedef unsigned u32x4 __attribute__((ext_vector_type(4)));
constexpr int BM = 256, BK = 64, HALF = 128, HTB = HALF * BK * 2  , STAGE_BYTES = 8 * HTB, NXCD = 8, WGM = 4;

__host__ __device__ __forceinline__ int lds_byte(int r, int c) { const int st = (r >> 4) * 2 + (c >> 5), rr = r & 15, cc = c & 31, ob = rr * 64 + cc * 2; return st * 1024 + (ob ^ (((ob >> 9) & 1) << 5)); }
__host__ __device__ __forceinline__ void stage_rc(int b, int& R, int& C) { const int st = b / 1024, sb = b % 1024, swz = sb ^ (((sb >> 9) & 1) << 5); R = (st >> 1) * 16 + swz / 64; C = (st & 1) * 32 + (swz % 64) / 2; }
__host__ __device__ __forceinline__ int perm32(int rho) { const int n = rho >> 4, i = rho & 15; return 8 * (i >> 2) + 4 * n + (i & 3); }

struct Unit { int pm, pn; };
struct Gemm { const bf16_t* A; const bf16_t* Bt; int M, N, K; };

struct StaticOrder {
    int nM, nN, nwg, G, c;
    __host__ __device__ void init(int M, int N, int G_, int c_) { nM = M / BM; nN = N / BM; nwg = nM * nN; G = G_; c = c_; }
    __host__ __device__ bool next(int i, Unit& u) const {
        const long L = (long)i * G + c; if (L >= nwg) return false;
        int wgid = (int)L; { const int q = nwg / NXCD, r = nwg % NXCD, xcd = wgid % NXCD, off = wgid / NXCD; wgid = (xcd < r ? xcd * (q + 1) : r * (q + 1) + (xcd - r) * q) + off; }
        const int nig = WGM * nN, gid = wgid / nig, fm = gid * WGM, gsz = (nM - fm) < WGM ? (nM - fm) : WGM;
        u.pm = fm + ((wgid % nig) % gsz); u.pn = (wgid % nig) / gsz; return true;
    }
    __device__ __forceinline__ void a_ready(const Unit&) const {}
    __device__ __forceinline__ void done(const Unit&) const {}
};


typedef float f32x2_t __attribute__((ext_vector_type(2)));
typedef __bf16 bf16x2_t __attribute__((ext_vector_type(2)));
__device__ __forceinline__ unsigned cvt_pk_bf16(float lo, float hi) { f32x2_t v = {lo, hi}; bf16x2_t b = __builtin_convertvector(v, bf16x2_t); return __builtin_bit_cast(unsigned, b); }
__device__ __forceinline__ float silu_f(float v) { return v * __builtin_amdgcn_rcpf(1.0f + __expf(-v)); }

struct EpiStore2 {
    static constexpr bool PERM = true, AFTER_DRAIN = false;
    bf16_t* O0; int ld0; bf16_t* O1; int ld1; int split;
    __device__ __forceinline__ void operator()(const f32x4 (&acc)[2][2][4][2], const Unit& u, int wr, int wc, int fr, int fq) const {
        int colt = u.pn * BM; bf16_t* base = O0; int ld = ld0;
        if (colt >= split) { base = O1; ld = ld1; colt -= split; }
        const int row0 = u.pm * BM + wr * 64 + fr, col0 = colt + wc * 32 + 8 * fq;
#pragma unroll
        for (int ai = 0; ai < 2; ++ai)
#pragma unroll
            for (int m = 0; m < 4; ++m) { bf16_t* rowp = base + (size_t)(row0 + ai * HALF + m * 16) * ld + col0;
#pragma unroll
                for (int bj = 0; bj < 2; ++bj) { const f32x4 v0 = acc[ai][bj][m][0], v1 = acc[ai][bj][m][1];
                    u32x4 w; w.x = cvt_pk_bf16(v0[0], v0[1]); w.y = cvt_pk_bf16(v0[2], v0[3]); w.z = cvt_pk_bf16(v1[0], v1[1]); w.w = cvt_pk_bf16(v1[2], v1[3]);
                    *(u32x4*)(rowp + bj * HALF) = w; } }
    }
};
template <int ACT> struct EpiGate {
    static constexpr bool PERM = true, AFTER_DRAIN = false;
    bf16_t* P; int ldp; bf16_t* G; int ldg; int pn_plain;
    __device__ __forceinline__ void operator()(const f32x4 (&acc)[2][2][4][2], const Unit& u, int wr, int wc, int fr, int fq) const {
        const int row0 = u.pm * BM + wr * 64 + fr;
        if (u.pn < pn_plain) {
            const int col0 = u.pn * BM + wc * 32 + 8 * fq;
#pragma unroll
            for (int ai = 0; ai < 2; ++ai)
#pragma unroll
                for (int m = 0; m < 4; ++m) { bf16_t* rowp = P + (size_t)(row0 + ai * HALF + m * 16) * ldp + col0;
#pragma unroll
                    for (int bj = 0; bj < 2; ++bj) { const f32x4 v0 = acc[ai][bj][m][0], v1 = acc[ai][bj][m][1];
                        u32x4 w; w.x = cvt_pk_bf16(v0[0], v0[1]); w.y = cvt_pk_bf16(v0[2], v0[3]); w.z = cvt_pk_bf16(v1[0], v1[1]); w.w = cvt_pk_bf16(v1[2], v1[3]);
                        *(u32x4*)(rowp + bj * HALF) = w; } }
        } else {
            const int col0 = (u.pn - pn_plain) * HALF + wc * 32 + 8 * fq;
#pragma unroll
            for (int ai = 0; ai < 2; ++ai)
#pragma unroll
                for (int m = 0; m < 4; ++m) { bf16_t* rowp = G + (size_t)(row0 + ai * HALF + m * 16) * ldg + col0;
                    f32x4 a0 = acc[ai][0][m][0], a1 = acc[ai][0][m][1]; const f32x4 b0 = acc[ai][1][m][0], b1 = acc[ai][1][m][1];
                    if (ACT == 1) {
#pragma unroll
                        for (int e = 0; e < 4; ++e) { a0[e] = silu_f(a0[e]); a1[e] = silu_f(a1[e]); } }
                    a0 = a0 * b0; a1 = a1 * b1;
                    u32x4 w; w.x = cvt_pk_bf16(a0[0], a0[1]); w.y = cvt_pk_bf16(a0[2], a0[3]); w.z = cvt_pk_bf16(a1[0], a1[1]); w.w = cvt_pk_bf16(a1[2], a1[3]);
                    *(u32x4*)rowp = w; }
        }
    }
};

template <class Epi, class Sched, bool ALIGN_EPI = false, bool SP2 = false>
__device__ __forceinline__ void gemm_phase(PG8_LAS unsigned char* lds, const Gemm g, const Sched& S, const Epi& E) {
    int tid_o = threadIdx.x; asm volatile("" : "+v"(tid_o));
    const int tid = tid_o, wid = __builtin_amdgcn_readfirstlane(tid >> 6), lane = tid & 63, wr = wid >> 2, wc = wid & 3, fr = lane & 15, fq = lane >> 4;
    const int K = g.K, nt = K / BK;
    unsigned voffA[2], voffB[2];
#pragma unroll
    for (int i = 0; i < 2; ++i) { int R, C; stage_rc(tid * 16 + i * 8192, R, C); const int Rb = Epi::PERM ? ((R & ~31) + perm32(R & 31)) : R;
        voffA[i] = (unsigned)(R * K + C) * 2u; voffB[i] = (unsigned)(Rb * K + C) * 2u; }
    const size_t kstep = (size_t)(BK * 2);
    const size_t hstep = (size_t)HALF * K * 2;
    const size_t tstep = 2 * hstep;
    const unsigned ldsw = (unsigned)wid * 1024u;
    const int aoff = lds_byte(wr * 64 + fr, fq * 8), boff = lds_byte(wc * 32 + fr, fq * 8);
#define PG8_SA(b, h) (((b) * 2 + (h)) * HTB)
#define PG8_SB(b, h) ((4 + (b) * 2 + (h)) * HTB)
#define PG8_STAGE(bufoff, gbase, voff) do { _Pragma("unroll") for (int _i = 0; _i < 2; ++_i) \
        __builtin_amdgcn_global_load_lds((const unsigned*)((const char*)(gbase) + (voff)[_i]), (PG8_LAS unsigned*)(lds + (bufoff) + ldsw + _i * 8192), 16, 0, 0); } while (0)
#define PG8_LDA(dst, b, h) do { _Pragma("unroll") for (int m = 0; m < 4; ++m) _Pragma("unroll") for (int k = 0; k < 2; ++k) dst[m][k] = *(const PG8_LAS bf16x8*)(lds + PG8_SA(b, h) + aoff + m * 2048 + k * 1024); } while (0)
#define PG8_LDB(dst, b, h) do { _Pragma("unroll") for (int n = 0; n < 2; ++n) _Pragma("unroll") for (int k = 0; k < 2; ++k) dst[n][k] = *(const PG8_LAS bf16x8*)(lds + PG8_SB(b, h) + boff + n * 2048 + k * 1024); } while (0)
#define PG8_MMA(ai, bj, At, Bt) do { __builtin_amdgcn_s_setprio(1); _Pragma("unroll") for (int m = 0; m < 4; ++m) _Pragma("unroll") for (int n = 0; n < 2; ++n) _Pragma("unroll") for (int k = 0; k < 2; ++k) \
        acc[ai][bj][m][n] = __builtin_amdgcn_mfma_f32_16x16x32_bf16(Bt[n][k], At[m][k], acc[ai][bj][m][n], 0, 0, 0); __builtin_amdgcn_s_setprio(0); } while (0)
#define PG8_WAIT_V(n) asm volatile("s_waitcnt vmcnt(" #n ")" ::: "memory")
#define PG8_WAIT_L(n) asm volatile("s_waitcnt lgkmcnt(" #n ")" ::: "memory")
#define PG8_BAR __builtin_amdgcn_s_barrier()
#define PG8_SCHED __builtin_amdgcn_sched_barrier(0)
    Unit cur, nxt; int ui = 0;
    if (!S.next(0, cur)) return;
    f32x4 acc[2][2][4][2];
#pragma unroll
    for (int a = 0; a < 2; ++a)
#pragma unroll
        for (int b = 0; b < 2; ++b)
#pragma unroll
            for (int m = 0; m < 4; ++m)
#pragma unroll
                for (int n = 0; n < 2; ++n) acc[a][b][m][n] = (f32x4){0.f, 0.f, 0.f, 0.f};
    bf16x8 At[4][2], B0[2][2], B1[2][2];
    const char* cA = (const char*)g.A + (size_t)cur.pm * tstep; const char* cB = (const char*)g.Bt + (size_t)cur.pn * tstep;
    S.a_ready(cur);
    if constexpr (SP2) {
        PG8_STAGE(PG8_SB(0, 0), cB, voffB); PG8_STAGE(PG8_SB(0, 1), cB + hstep, voffB); PG8_STAGE(PG8_SA(0, 0), cA, voffA); PG8_STAGE(PG8_SA(0, 1), cA + hstep, voffA);
        if (wr == 1) PG8_BAR;
        PG8_WAIT_V(2); PG8_BAR;
        PG8_STAGE(PG8_SB(1, 0), cB + kstep, voffB); PG8_STAGE(PG8_SA(1, 0), cA + kstep, voffA); PG8_STAGE(PG8_SB(1, 1), cB + hstep + kstep, voffB);
        PG8_WAIT_V(6); PG8_BAR;
    } else {
        PG8_STAGE(PG8_SB(0, 0), cB, voffB); PG8_STAGE(PG8_SA(0, 0), cA, voffA); PG8_STAGE(PG8_SB(0, 1), cB + hstep, voffB); PG8_STAGE(PG8_SA(0, 1), cA + hstep, voffA);
        if (wr == 1) PG8_BAR;
        PG8_WAIT_V(4); PG8_BAR;
        PG8_STAGE(PG8_SB(1, 0), cB + kstep, voffB); PG8_STAGE(PG8_SA(1, 0), cA + kstep, voffA); PG8_STAGE(PG8_SB(1, 1), cB + hstep + kstep, voffB);
        PG8_WAIT_V(6); PG8_BAR;
    }
    for (;;) {
        const bool has_next = S.next(ui + 1, nxt);
        const char* nA = has_next ? (const char*)g.A + (size_t)nxt.pm * tstep : cA; const char* nB = has_next ? (const char*)g.Bt + (size_t)nxt.pn * tstep : cB;
        for (int t = 0; t < nt; t += 2) {
            const bool last = (t == nt - 2);
            const char* a1 = cA + (size_t)(t + 1) * kstep;
            const char* a2 = last ? nA : cA + (size_t)(t + 2) * kstep; const char* b2 = last ? nB : cB + (size_t)(t + 2) * kstep;
            const char* a3 = a2 + kstep; const char* b3 = b2 + kstep;
            if (last && has_next) S.a_ready(nxt);
            if constexpr (SP2) {
            PG8_LDB(B0, 0, 0); PG8_LDB(B1, 0, 1); PG8_SCHED; PG8_LDA(At, 0, 0); PG8_STAGE(PG8_SA(1, 1), a1 + hstep, voffA);
            PG8_WAIT_V(8); PG8_WAIT_L(0); PG8_BAR; PG8_MMA(0, 0, At, B0); PG8_MMA(0, 1, At, B1); PG8_BAR; PG8_SCHED;
            PG8_LDA(At, 0, 1); PG8_STAGE(PG8_SB(0, 0), b2, voffB); PG8_STAGE(PG8_SB(0, 1), b2 + hstep, voffB); PG8_STAGE(PG8_SA(0, 0), a2, voffA);
            PG8_WAIT_V(8); PG8_WAIT_L(0); PG8_BAR; PG8_MMA(1, 0, At, B0); PG8_MMA(1, 1, At, B1); PG8_BAR; PG8_SCHED;
            PG8_LDB(B0, 1, 0); PG8_LDB(B1, 1, 1); PG8_SCHED; PG8_LDA(At, 1, 0); PG8_STAGE(PG8_SA(0, 1), a2 + hstep, voffA);
            PG8_WAIT_V(8); PG8_WAIT_L(0); PG8_BAR; PG8_MMA(0, 0, At, B0); PG8_MMA(0, 1, At, B1); PG8_BAR; PG8_SCHED;
            PG8_LDA(At, 1, 1); PG8_STAGE(PG8_SB(1, 0), b3, voffB); PG8_STAGE(PG8_SB(1, 1), b3 + hstep, voffB); PG8_STAGE(PG8_SA(1, 0), a3, voffA);
            PG8_WAIT_V(8); PG8_WAIT_L(0); PG8_BAR; PG8_MMA(1, 0, At, B0); PG8_MMA(1, 1, At, B1); PG8_BAR; PG8_SCHED;
            } else {
            PG8_LDB(B0, 0, 0); PG8_SCHED; PG8_LDA(At, 0, 0); PG8_STAGE(PG8_SA(1, 1), a1 + hstep, voffA);
            PG8_WAIT_L(8); PG8_BAR; PG8_WAIT_L(0); PG8_MMA(0, 0, At, B0); PG8_BAR; PG8_SCHED;
            PG8_LDB(B1, 0, 1); PG8_STAGE(PG8_SB(0, 0), b2, voffB);
            PG8_BAR; PG8_WAIT_L(0); PG8_MMA(0, 1, At, B1); PG8_BAR;
            PG8_LDA(At, 0, 1); PG8_STAGE(PG8_SA(0, 0), a2, voffA);
            PG8_BAR; PG8_WAIT_L(0); PG8_MMA(1, 0, At, B0); PG8_BAR; PG8_SCHED;
            PG8_STAGE(PG8_SB(0, 1), b2 + hstep, voffB);
            PG8_WAIT_V(6); PG8_BAR; PG8_MMA(1, 1, At, B1); PG8_BAR;
            PG8_LDB(B0, 1, 0); PG8_SCHED; PG8_LDA(At, 1, 0); PG8_STAGE(PG8_SA(0, 1), a2 + hstep, voffA);
            PG8_WAIT_L(8); PG8_BAR; PG8_WAIT_L(0); PG8_MMA(0, 0, At, B0); PG8_BAR; PG8_SCHED;
            PG8_LDB(B1, 1, 1); PG8_STAGE(PG8_SB(1, 0), b3, voffB);
            PG8_BAR; PG8_WAIT_L(0); PG8_MMA(0, 1, At, B1); PG8_BAR;
            PG8_LDA(At, 1, 1); PG8_STAGE(PG8_SA(1, 0), a3, voffA);
            PG8_BAR; PG8_WAIT_L(0); PG8_MMA(1, 0, At, B0); PG8_BAR; PG8_SCHED;
            PG8_STAGE(PG8_SB(1, 1), b3 + hstep, voffB);
            PG8_WAIT_V(6); PG8_BAR; PG8_MMA(1, 1, At, B1); PG8_BAR;
            }
        }
        if constexpr (ALIGN_EPI) { if (wr == 0) PG8_BAR; }
        if constexpr (!Epi::AFTER_DRAIN) { E(acc, cur, wr, wc, fr, fq); S.done(cur); }
        if (!has_next) break;
#pragma unroll
        for (int a = 0; a < 2; ++a)
#pragma unroll
            for (int b = 0; b < 2; ++b)
#pragma unroll
                for (int m = 0; m < 4; ++m)
#pragma unroll
                    for (int n = 0; n < 2; ++n) acc[a][b][m][n] = (f32x4){0.f, 0.f, 0.f, 0.f};
        cur = nxt; cA = nA; cB = nB; ++ui;
        if constexpr (ALIGN_EPI) { if (wr == 1) PG8_BAR; }
    }
    PG8_WAIT_V(0);
    if constexpr (!ALIGN_EPI) { if (wr == 0) PG8_BAR; }
    PG8_BAR;
    if constexpr (Epi::AFTER_DRAIN) { E.fused(acc, cur, wr, wc, fr, fq, lds, wid, lane); S.done(cur); }
#undef PG8_SA
#undef PG8_SB
#undef PG8_STAGE
#undef PG8_LDA
#undef PG8_LDB
#undef PG8_MMA
#undef PG8_WAIT_V
#undef PG8_WAIT_L
#undef PG8_BAR
#undef PG8_SCHED
}
}

#ifndef PG8_SP2
#define PG8_SP2 true
#endif
#ifndef PG8_ALIGN
#define PG8_ALIGN true
#endif
#ifndef MK_PER_PHASE
#define MK_PER_PHASE 0
#endif

constexpr int NWAVES = 8;
constexpr int DM = 2048, BATCH = 2, SEQ = 8192, M = BATCH * SEQ, DEPTH = 4;
constexpr int HD = 128, HK = 16, HV = 32, KDIM = 2048, VDIM = 4096, QKV = 8192;
constexpr int DNP = 12352, DNP_MAIN = 12288;
constexpr int FF = 5632;
constexpr float LN_EPS = 1e-5f, RMS_EPS = 1e-6f;
constexpr float ALPHA = 1.6817928305074290f;
#ifndef XRES_BF16
#define XRES_BF16 1
#endif
#ifndef DN_CHUNKED
#define DN_CHUNKED 1
#endif
constexpr int N_PHASES = 35;

constexpr size_t MiB = 1u << 20;
constexpr size_t WS_CTL = 0, CTL_ZERO_BYTES = 1 * MiB;
constexpr size_t WS_W_SCIN = 1 * MiB;
constexpr size_t WS_W_SCOUT = WS_W_SCIN + 48 * MiB;
constexpr size_t WS_W_DNIN = WS_W_SCOUT + 16 * MiB;
constexpr size_t WS_W_BA = WS_W_DNIN + 96 * MiB;
constexpr size_t WS_W_DNOUT = WS_W_BA + 1 * MiB;
constexpr size_t WS_W_GU = WS_W_DNOUT + 32 * MiB;
constexpr size_t WS_W_DOWN = WS_W_GU + 176 * MiB;
constexpr size_t WS_XB = WS_W_DOWN + 88 * MiB;
constexpr size_t WS_BIGA = WS_XB + 64 * MiB;
constexpr size_t WS_QKV = WS_BIGA, WS_Z = WS_BIGA + 256 * MiB, WS_O = WS_BIGA;
constexpr size_t WS_GB = WS_BIGA, WS_CU = WS_BIGA + 64 * MiB, WS_A2 = WS_BIGA + 128 * MiB, WS_HID = WS_BIGA;
constexpr size_t WS_BIGB = WS_BIGA + 384 * MiB;
constexpr size_t WS_QC = WS_BIGB, WS_KC = WS_BIGB + 64 * MiB, WS_VC = WS_BIGB + 128 * MiB, WS_A3 = WS_BIGB + 256 * MiB, WS_H1 = WS_BIGB;
constexpr size_t WS_BA = WS_BIGB + 384 * MiB;
constexpr size_t WS_BETA = WS_BA + 4 * MiB, WS_DEC = WS_BETA + 2 * MiB;
constexpr size_t WS_GL = WS_DEC + 2 * MiB;
constexpr size_t WS_KF = WS_GL + 2 * MiB;
constexpr size_t WS_SC = WS_KF + 64 * MiB;
constexpr size_t WS_END = WS_SC + 8 * MiB;
constexpr size_t WS_WF = WS_BIGA, WS_UF = WS_BIGA + 128 * MiB, WS_QF = WS_BIGB + 256 * MiB, WS_AQKF = WS_BIGB + 320 * MiB;
constexpr size_t WS_WF2 = WS_BIGB, WS_UF2 = WS_BIGB + 128 * MiB;
static_assert(WS_END <= (size_t)1476395008ull, "d_ws map exceeds the guaranteed workspace");
constexpr int CW_BAR = 4096;

constexpr int RING_OFF = 0, RING_BYTES = 131072;
constexpr int LDSCTL_OFF = RING_BYTES, MISC_OFF = LDSCTL_OFF + 320, PTAB_OFF = LDSCTL_OFF + 1024;
constexpr int LDS_BYTES = 147456;

#define GAS __attribute__((address_space(1)))
#define LAS __attribute__((address_space(3)))
typedef unsigned short bf16;
typedef unsigned v4u __attribute__((ext_vector_type(4)));
typedef unsigned v2u __attribute__((ext_vector_type(2)));
typedef float f32x4 __attribute__((ext_vector_type(4)));
typedef float f32x16 __attribute__((ext_vector_type(16)));
typedef short bf16x8 __attribute__((ext_vector_type(8)));
typedef GAS unsigned gu32;
#define RLX_AGENT __ATOMIC_RELAXED, __HIP_MEMORY_SCOPE_AGENT
#define LDS_WAIT() asm volatile("s_waitcnt lgkmcnt(0)" ::: "memory")
#define VM_WAIT() asm volatile("s_waitcnt vmcnt(0)" ::: "memory")
__device__ __forceinline__ unsigned pk2(float lo, float hi) { return pg8::cvt_pk_bf16(lo, hi); }
__device__ __forceinline__ float bf_lo(unsigned w) { return __uint_as_float(w << 16); }
__device__ __forceinline__ float bf_hi(unsigned w) { return __uint_as_float(w & 0xffff0000u); }
__device__ __forceinline__ float silu_f(float v) { return v * __builtin_amdgcn_rcpf(1.0f + __expf(-v)); }
#define XB_TMO      128
#define XB_XCNT(j)  (256  + 64 * (j))
#define XB_XSUB(j)  (1280 + 64 * (j))
#define XB_XGEN(j)  (2304 + 64 * (j))
#define XB_TOP      3328
#define XB_TOPGEN   3392
#define XCD_BAR_WORDS 3456
#define XB_SPIN_CAP (1u << 21)

__device__ __forceinline__ unsigned xb_ld(unsigned* p)              { return __hip_atomic_load(p, __ATOMIC_RELAXED, __HIP_MEMORY_SCOPE_AGENT); }
__device__ __forceinline__ unsigned xb_add(unsigned* p, unsigned v) { return __hip_atomic_fetch_add(p, v, __ATOMIC_RELAXED, __HIP_MEMORY_SCOPE_AGENT); }
__device__ __forceinline__ unsigned xb_xcc_id() { return (unsigned)__builtin_amdgcn_s_getreg((3 << 11) | 20) & 0xFu; }
#define XB_SPIN(cond, bar) do { unsigned _sp = 0; while (cond) { __builtin_amdgcn_s_sleep(1); \
    if ((++_sp & 255u) == 0u) { if (xb_ld(&(bar)[XB_TMO])) break; if (_sp > XB_SPIN_CAP) { atomicAdd(&(bar)[XB_TMO], 1u); break; } } } } while (0)

struct XcdBarrier {
    unsigned* bar; unsigned x;
    volatile LAS unsigned* st;
};

__device__ __forceinline__ XcdBarrier xcd_barrier_post(unsigned* bar, volatile LAS unsigned* st) {
    XcdBarrier b; b.bar = bar; b.x = xb_xcc_id(); b.st = st;
    if (threadIdx.x == 0) (void)xb_add(&bar[XB_XCNT(b.x)], 1u);
    return b;
}
__device__ __forceinline__ void xcd_barrier_complete(unsigned* bar, unsigned x, unsigned& nloc, unsigned& nx) {
    const unsigned G = gridDim.x * gridDim.y * gridDim.z;
    unsigned sum, cnt, mine, sp = 0u;
    for (;;) {
        sum = 0u; cnt = 0u; mine = 0u;
#pragma unroll
        for (unsigned j = 0; j < 16; ++j) { const unsigned c = xb_ld(&bar[XB_XCNT(j)]); sum += c; cnt += (c > 0u) ? 1u : 0u; mine = (j == x) ? c : mine; }
        if (sum == G) break;
        __builtin_amdgcn_s_sleep(1);
        if ((++sp & 255u) == 0u) { if (xb_ld(&bar[XB_TMO])) break; if (sp > XB_SPIN_CAP) { atomicAdd(&bar[XB_TMO], 1u); break; } }
    }
    nloc = mine > 0u ? mine : 1u; nx = cnt > 0u ? cnt : 1u;
}

__device__ __forceinline__ void xcd_barrier(const XcdBarrier& b) {
    asm volatile("s_waitcnt vmcnt(0)" ::: "memory");
    __syncthreads();
    if (threadIdx.x == 0) {
        unsigned* bar = b.bar;
        __builtin_amdgcn_s_waitcnt(0);
        unsigned nloc = b.st[0], nx = b.st[1];
        if (nloc == 0u) { xcd_barrier_complete(bar, b.x, nloc, nx); b.st[0] = nloc; b.st[1] = nx; }
        const unsigned old = xb_add(&bar[XB_XSUB(b.x)], 1u);
        const unsigned gen = old / nloc;
        if (old + 1u == (gen + 1u) * nloc) {
            __builtin_amdgcn_fence(__ATOMIC_RELEASE, "agent");
            asm volatile("s_waitcnt vmcnt(0)" ::: "memory");
            const unsigned og = xb_add(&bar[XB_TOP], 1u);
            const unsigned tg = og / nx;
            if (og + 1u == (tg + 1u) * nx) xb_add(&bar[XB_TOPGEN], 1u);
            else XB_SPIN(xb_ld(&bar[XB_TOPGEN]) == tg, bar);
            __builtin_amdgcn_fence(__ATOMIC_ACQUIRE, "agent");
            xb_add(&bar[XB_XGEN(b.x)], 1u);
            asm volatile("s_waitcnt vmcnt(0)" ::: "memory");
        } else {
            XB_SPIN(xb_ld(&bar[XB_XGEN(b.x)]) == gen, bar);
            __builtin_amdgcn_fence(__ATOMIC_ACQUIRE, "agent");
            asm volatile("s_waitcnt vmcnt(0)" ::: "memory");
        }
    }
    __syncthreads();
}

__device__ __forceinline__ float wave_sum(float v) {
#pragma unroll
    for (int o = 1; o < 64; o <<= 1) v += __shfl_xor(v, o);
    return v;
}
__device__ __forceinline__ float sum16(float v) {
    v += __shfl_xor(v, 1); v += __shfl_xor(v, 2); v += __shfl_xor(v, 4); v += __shfl_xor(v, 8);
    return v;
}
template <int CTRL> __device__ __forceinline__ float dppf(float v) { return __builtin_bit_cast(float, __builtin_amdgcn_update_dpp(0, __builtin_bit_cast(int, v), CTRL, 0xF, 0xF, false)); }
__device__ __forceinline__ float rowsum16(float v) {
    v += dppf<0x128>(v); v += dppf<0x124>(v); v += dppf<0x122>(v); v += dppf<0x121>(v);
    return v;
}
__device__ __forceinline__ void unpack8(const v4u w, float (&f)[8]) {
    f[0] = bf_lo(w.x); f[1] = bf_hi(w.x); f[2] = bf_lo(w.y); f[3] = bf_hi(w.y); f[4] = bf_lo(w.z); f[5] = bf_hi(w.z); f[6] = bf_lo(w.w); f[7] = bf_hi(w.w);
}
__device__ __forceinline__ v4u pack8(const float (&f)[8]) { v4u o; o.x = pk2(f[0], f[1]); o.y = pk2(f[2], f[3]); o.z = pk2(f[4], f[5]); o.w = pk2(f[6], f[7]); return o; }

struct Ptrs {
    const float *x, *sc_w_in, *sc_conv_w, *sc_w_out, *dn_w_in, *dn_conv_w, *dn_a_log, *dn_dt_bias, *dn_norm_w, *dn_w_out, *ffn_gu, *ffn_down, *ln_gain, *ln_bias;
    float* out; unsigned char* ws;
};
struct P0Desc { const float* W; bf16* WT; int ldw, src, K, n0, k0, pad; };
constexpr int I_SCIN = 32 * 192, I_SCOUT = 32 * 64, I_DNIN = 32 * 384, I_BA = 32 * 2, I_DNOUT = 64 * 64, I_GU = 32 * 352, I_DOWN = 88 * 64;
constexpr int P0_NITEMS = 2 * (I_SCIN + I_SCOUT + I_DNIN + I_BA + I_DNOUT) + 4 * (I_GU + I_DOWN);
__device__ __forceinline__ P0Desc p0_desc(const Ptrs& P, int it) {
    int r = it; const float* W; int ldw, K, nblk, mode; bf16* WT; int layer;
    if (r < 2 * I_SCIN) { layer = r / I_SCIN; r -= layer * I_SCIN; W = P.sc_w_in + (size_t)layer * DM * 3 * DM; ldw = 3 * DM; K = DM; nblk = 192; mode = 1; WT = (bf16*)(P.ws + WS_W_SCIN) + (size_t)layer * 3 * DM * DM; }
    else { r -= 2 * I_SCIN;
    if (r < 2 * I_SCOUT) { layer = r / I_SCOUT; r -= layer * I_SCOUT; W = P.sc_w_out + (size_t)layer * DM * DM; ldw = DM; K = DM; nblk = 64; mode = 0; WT = (bf16*)(P.ws + WS_W_SCOUT) + (size_t)layer * DM * DM; }
    else { r -= 2 * I_SCOUT;
    if (r < 2 * I_DNIN) { layer = r / I_DNIN; r -= layer * I_DNIN; W = P.dn_w_in + (size_t)layer * DM * DNP; ldw = DNP; K = DM; nblk = 384; mode = 0; WT = (bf16*)(P.ws + WS_W_DNIN) + (size_t)layer * DNP_MAIN * DM; }
    else { r -= 2 * I_DNIN;
    if (r < 2 * I_BA) { layer = r / I_BA; r -= layer * I_BA; W = P.dn_w_in + (size_t)layer * DM * DNP; ldw = DNP; K = DM; nblk = 2; mode = 3; WT = (bf16*)(P.ws + WS_W_BA) + (size_t)layer * 64 * DM; }
    else { r -= 2 * I_BA;
    if (r < 2 * I_DNOUT) { layer = r / I_DNOUT; r -= layer * I_DNOUT; W = P.dn_w_out + (size_t)layer * VDIM * DM; ldw = DM; K = VDIM; nblk = 64; mode = 0; WT = (bf16*)(P.ws + WS_W_DNOUT) + (size_t)layer * DM * VDIM; }
    else { r -= 2 * I_DNOUT;
    if (r < 4 * I_GU) { layer = r / I_GU; r -= layer * I_GU; W = P.ffn_gu + (size_t)layer * DM * 2 * FF; ldw = 2 * FF; K = DM; nblk = 352; mode = 2; WT = (bf16*)(P.ws + WS_W_GU) + (size_t)layer * 2 * FF * DM; }
    else { r -= 4 * I_GU; layer = r / I_DOWN; r -= layer * I_DOWN; W = P.ffn_down + (size_t)layer * FF * DM; ldw = DM; K = FF; nblk = 64; mode = 0; WT = (bf16*)(P.ws + WS_W_DOWN) + (size_t)layer * DM * FF; } } } } } }
    const int kb = r / nblk, nb = r % nblk, n0 = 32 * nb;
    int src;
    if (mode == 0) src = n0;
    else if (mode == 1) { if (n0 < DM) src = n0; else { const int n2 = n0 - DM; src = DM + ((n2 >> 7) & 1) * DM + (n2 >> 8) * 128 + (n2 & 127); } }
    else if (mode == 2) src = ((n0 >> 7) & 1) * FF + (n0 >> 8) * 128 + (n0 & 127);
    else src = DNP_MAIN + n0;
    P0Desc d; d.W = W; d.WT = WT; d.ldw = ldw; d.src = src; d.K = K; d.n0 = n0; d.k0 = 64 * kb; d.pad = 0; return d;
}
__device__ __forceinline__ void p0_load(const P0Desc& d, int lane, float (&tv)[32]) {
#pragma unroll
    for (int i = 0; i < 32; ++i) tv[i] = __builtin_nontemporal_load(&d.W[(size_t)(d.k0 + 2 * i + (lane >> 5)) * d.ldw + d.src + (lane & 31)]);
}
__device__ __forceinline__ void p0_store(const P0Desc& d, LAS float* scr, int lane, const float (&tv)[32]) {
#pragma unroll
    for (int i = 0; i < 32; ++i) scr[(2 * i + (lane >> 5)) * 33 + (lane & 31)] = tv[i];
    LDS_WAIT(); asm volatile("" ::: "memory");
    const int c = lane & 7;
#pragma unroll
    for (int j = 0; j < 4; ++j) { const int n = (lane >> 3) + 8 * j; const LAS float* s = scr + (8 * c) * 33 + n;
        v4u o; o.x = pk2(s[0 * 33], s[1 * 33]); o.y = pk2(s[2 * 33], s[3 * 33]); o.z = pk2(s[4 * 33], s[5 * 33]); o.w = pk2(s[6 * 33], s[7 * 33]);
        *(GAS v4u*)(d.WT + (size_t)(d.n0 + n) * d.K + d.k0 + 8 * c) = o; }
    LDS_WAIT(); asm volatile("" ::: "memory");
}
__device__ __forceinline__ void p0_prologue(const Ptrs& P, LAS unsigned char* lds, int gw, int NGW, int wave, int lane) {
    LAS float* scr = (LAS float*)(lds + RING_OFF + wave * 16384);
    float ta[32], tb[32];
    int it = gw;
    P0Desc da = p0_desc(P, it < P0_NITEMS ? it : 0), db = da;
    if (it < P0_NITEMS) p0_load(da, lane, ta);
    for (; it < P0_NITEMS; it += 2 * NGW) {
        const int i1 = it + NGW, i2 = it + 2 * NGW;
        if (i1 < P0_NITEMS) { db = p0_desc(P, i1); p0_load(db, lane, tb); }
        p0_store(da, scr, lane, ta);
        if (i2 < P0_NITEMS) { da = p0_desc(P, i2); p0_load(da, lane, ta); }
        if (i1 < P0_NITEMS) p0_store(db, scr, lane, tb);
    }
    bf16* XB = (bf16*)(P.ws + WS_XB);
    for (int m = gw; m < M; m += NGW) {
        const GAS f32x4* xr = (const GAS f32x4*)(P.x + (size_t)m * DM) + lane;
        GAS v2u* o8 = (GAS v2u*)(XB + (size_t)m * DM) + lane;
#pragma unroll
        for (int j = 0; j < 8; ++j) { const f32x4 v = xr[64 * j]; v2u o; o.x = pk2(v.x, v.y); o.y = pk2(v.z, v.w); o8[64 * j] = o; }
    }
}

template <bool XIN_F32, bool OUT_F32, bool OUT_BF16>
__device__ __forceinline__ void ln_phase(const float* xin, const bf16* XBin, const bf16* H, const float* gain, const float* bias, float* xout, bf16* XB, int gw, int NGW, int lane) {
    f32x4 g[8], bb[8];
#pragma unroll
    for (int j = 0; j < 8; ++j) { g[j] = ((const GAS f32x4*)gain)[lane + 64 * j]; bb[j] = ((const GAS f32x4*)bias)[lane + 64 * j]; }
    for (int m = gw; m < M; m += 2 * NGW) {
        const int m2 = m + NGW; const bool two = m2 < M; const int mb = two ? m2 : m;
        const GAS v2u* hra = (const GAS v2u*)(H + (size_t)m * DM) + lane; const GAS v2u* hrb = (const GAS v2u*)(H + (size_t)mb * DM) + lane;
        f32x4 va[8], vb[8]; float sa = 0.f, sb = 0.f;
        f32x4 xa[8], xb[8]; v2u ha[8], hb[8];
        if (XIN_F32) { const GAS f32x4* xra = (const GAS f32x4*)(xin + (size_t)m * DM) + lane; const GAS f32x4* xrb = (const GAS f32x4*)(xin + (size_t)mb * DM) + lane;
#pragma unroll
            for (int j = 0; j < 8; ++j) { xa[j] = xra[64 * j]; ha[j] = __builtin_nontemporal_load(&hra[64 * j]); }
#pragma unroll
            for (int j = 0; j < 8; ++j) { xb[j] = xrb[64 * j]; hb[j] = __builtin_nontemporal_load(&hrb[64 * j]); }
        } else { const GAS v2u* xra = (const GAS v2u*)(XBin + (size_t)m * DM) + lane; const GAS v2u* xrb = (const GAS v2u*)(XBin + (size_t)mb * DM) + lane; v2u ta[8], tb2[8];
#pragma unroll
            for (int j = 0; j < 8; ++j) { ta[j] = xra[64 * j]; ha[j] = __builtin_nontemporal_load(&hra[64 * j]); }
#pragma unroll
            for (int j = 0; j < 8; ++j) { tb2[j] = xrb[64 * j]; hb[j] = __builtin_nontemporal_load(&hrb[64 * j]); }
#pragma unroll
            for (int j = 0; j < 8; ++j) { xa[j] = (f32x4){bf_lo(ta[j].x), bf_hi(ta[j].x), bf_lo(ta[j].y), bf_hi(ta[j].y)}; xb[j] = (f32x4){bf_lo(tb2[j].x), bf_hi(tb2[j].x), bf_lo(tb2[j].y), bf_hi(tb2[j].y)}; } }
#pragma unroll
        for (int j = 0; j < 8; ++j) {
            va[j].x = ALPHA * xa[j].x + bf_lo(ha[j].x); va[j].y = ALPHA * xa[j].y + bf_hi(ha[j].x); va[j].z = ALPHA * xa[j].z + bf_lo(ha[j].y); va[j].w = ALPHA * xa[j].w + bf_hi(ha[j].y);
            vb[j].x = ALPHA * xb[j].x + bf_lo(hb[j].x); vb[j].y = ALPHA * xb[j].y + bf_hi(hb[j].x); vb[j].z = ALPHA * xb[j].z + bf_lo(hb[j].y); vb[j].w = ALPHA * xb[j].w + bf_hi(hb[j].y);
            sa += (va[j].x + va[j].y) + (va[j].z + va[j].w); sb += (vb[j].x + vb[j].y) + (vb[j].z + vb[j].w); }
#pragma unroll
        for (int o = 1; o < 64; o <<= 1) { sa += __shfl_xor(sa, o); sb += __shfl_xor(sb, o); }
        const float meana = sa * (1.f / DM), meanb = sb * (1.f / DM); float qa = 0.f, qb = 0.f;
#pragma unroll
        for (int j = 0; j < 8; ++j) { va[j] = va[j] - meana; vb[j] = vb[j] - meanb;
            qa += (va[j].x * va[j].x + va[j].y * va[j].y) + (va[j].z * va[j].z + va[j].w * va[j].w); qb += (vb[j].x * vb[j].x + vb[j].y * vb[j].y) + (vb[j].z * vb[j].z + vb[j].w * vb[j].w); }
#pragma unroll
        for (int o = 1; o < 64; o <<= 1) { qa += __shfl_xor(qa, o); qb += __shfl_xor(qb, o); }
        const float rsa = 1.f / sqrtf(qa * (1.f / DM) + LN_EPS), rsb = 1.f / sqrtf(qb * (1.f / DM) + LN_EPS);
#pragma unroll
        for (int j = 0; j < 8; ++j) { const f32x4 o = va[j] * rsa * g[j] + bb[j];
            if (OUT_F32) ((GAS f32x4*)(xout + (size_t)m * DM) + lane)[64 * j] = o; if (OUT_BF16) { v2u w; w.x = pk2(o.x, o.y); w.y = pk2(o.z, o.w); ((GAS v2u*)(XB + (size_t)m * DM) + lane)[64 * j] = w; } }
        if (two) {
#pragma unroll
            for (int j = 0; j < 8; ++j) { const f32x4 o = vb[j] * rsb * g[j] + bb[j];
                if (OUT_F32) ((GAS f32x4*)(xout + (size_t)m2 * DM) + lane)[64 * j] = o; if (OUT_BF16) { v2u w; w.x = pk2(o.x, o.y); w.y = pk2(o.z, o.w); ((GAS v2u*)(XB + (size_t)m2 * DM) + lane)[64 * j] = w; } } }
    }
}

__device__ __forceinline__ void sc_conv_phase(const bf16* GB, const bf16* CU, const float* cw  , bf16* A2, int gt, int NGT) {
    constexpr int RB = 16, NCG = DM / 8, NITEMS = (M / RB) * NCG;
    for (int it = gt; it < NITEMS; it += NGT) {
        const int cgp = it % NCG, rb = it / NCG, c0 = cgp * 8, r0 = rb * RB;
        float w0[8], w1[8], w2[8];
#pragma unroll
        for (int e = 0; e < 8; e += 4) { const f32x4 a = *(const GAS f32x4*)(cw + c0 + e), b = *(const GAS f32x4*)(cw + DM + c0 + e), c = *(const GAS f32x4*)(cw + 2 * DM + c0 + e);
            w0[e] = a.x; w0[e + 1] = a.y; w0[e + 2] = a.z; w0[e + 3] = a.w; w1[e] = b.x; w1[e + 1] = b.y; w1[e + 2] = b.z; w1[e + 3] = b.w; w2[e] = c.x; w2[e + 1] = c.y; w2[e + 2] = c.z; w2[e + 3] = c.w; }
        float um2[8], um1[8];
        const bool first = (r0 % SEQ) == 0;
        if (first) {
#pragma unroll
            for (int e = 0; e < 8; ++e) { um2[e] = 0.f; um1[e] = 0.f; } }
        else { unpack8(*(const GAS v4u*)(CU + (size_t)(r0 - 2) * DM + c0), um2); unpack8(*(const GAS v4u*)(CU + (size_t)(r0 - 1) * DM + c0), um1); }
#pragma unroll 4
        for (int r = 0; r < RB; ++r) {
            float u0[8], gb[8], o[8];
            unpack8(*(const GAS v4u*)(CU + (size_t)(r0 + r) * DM + c0), u0);
            unpack8(*(const GAS v4u*)(GB + (size_t)(r0 + r) * DM + c0), gb);
#pragma unroll
            for (int e = 0; e < 8; ++e) { o[e] = gb[e] * (w0[e] * um2[e] + w1[e] * um1[e] + w2[e] * u0[e]); um2[e] = um1[e]; um1[e] = u0[e]; }
            *(GAS v4u*)(A2 + (size_t)(r0 + r) * DM + c0) = pack8(o);
        }
    }
}

__device__ __forceinline__ void dn_pre_phase(const bf16* QKVr, const float* cw  , bf16* QC, bf16* KC, bf16* VC, const float* BA, const float* a_log, const float* dt_bias, float* BETA, float* DEC, float* GL,
                                             int gw, int NGW, int lane, int gt, int NGT) {
    constexpr int RB = 8, NCG = QKV / 512, NITEMS = (M / RB) * NCG;
    for (int it = gw; it < NITEMS; it += NGW) {
        const int cgp = it % NCG, rb = it / NCG, c0 = cgp * 512 + lane * 8, r0 = rb * RB;
        float w[4][8];
#pragma unroll
        for (int j = 0; j < 4; ++j)
#pragma unroll
            for (int e = 0; e < 8; e += 4) { const f32x4 a = *(const GAS f32x4*)(cw + (size_t)j * QKV + c0 + e); w[j][e] = a.x; w[j][e + 1] = a.y; w[j][e + 2] = a.z; w[j][e + 3] = a.w; }
        float h3[8], h2[8], h1[8];
        const bool first = (r0 % SEQ) == 0;
        if (first) {
#pragma unroll
            for (int e = 0; e < 8; ++e) { h3[e] = 0.f; h2[e] = 0.f; h1[e] = 0.f; } }
        else { unpack8(*(const GAS v4u*)(QKVr + (size_t)(r0 - 3) * QKV + c0), h3); unpack8(*(const GAS v4u*)(QKVr + (size_t)(r0 - 2) * QKV + c0), h2); unpack8(*(const GAS v4u*)(QKVr + (size_t)(r0 - 1) * QKV + c0), h1); }
        bf16* dst; int ldd, cd; float qs = 1.f; bool norm;
        if (c0 < KDIM) { dst = QC; ldd = KDIM; cd = c0; norm = true; qs = 0.08838834764831845f; }
        else if (c0 < 2 * KDIM) { dst = KC; ldd = KDIM; cd = c0 - KDIM; norm = true; }
        else { dst = VC; ldd = VDIM; cd = c0 - 2 * KDIM; norm = false; }
        v4u rowv[RB];
#pragma unroll
        for (int r = 0; r < RB; ++r) rowv[r] = *(const GAS v4u*)(QKVr + (size_t)(r0 + r) * QKV + c0);
#pragma unroll
        for (int r = 0; r < RB; ++r) {
            float u0[8], o[8]; float ss = 0.f;
            unpack8(rowv[r], u0);
#pragma unroll
            for (int e = 0; e < 8; ++e) { const float c = w[0][e] * h3[e] + w[1][e] * h2[e] + w[2][e] * h1[e] + w[3][e] * u0[e]; o[e] = silu_f(c); ss += o[e] * o[e]; h3[e] = h2[e]; h2[e] = h1[e]; h1[e] = u0[e]; }
            if (norm) { ss = sum16(ss); const float sc = qs / sqrtf(ss + RMS_EPS);
#pragma unroll
                for (int e = 0; e < 8; ++e) o[e] *= sc; }
            *(GAS v4u*)(dst + (size_t)(r0 + r) * ldd + cd) = pack8(o);
        }
    }
    for (int i = gt; i < M * HV; i += NGT) {
        const int hv = i & (HV - 1), row = i >> 5;
        const float br = BA[(size_t)row * 64 + hv], ar = BA[(size_t)row * 64 + HV + hv];
        const float xx = ar + dt_bias[hv];
        const float sp = fmaxf(xx, 0.f) + log1pf(__expf(-fabsf(xx)));
        const float gg = -__expf(a_log[hv]) * sp;
        BETA[i] = 1.f / (1.f + __expf(-br));
        DEC[i] = __expf(gg);
        GL[i] = gg;
    }
}

__device__ __forceinline__ void ba_phase(const bf16* XB, const bf16* Wba, float* BA, LAS unsigned char* lds, int unit, int wave, int lane, int tid) {
    const int r = lane & 31, h = lane >> 5;
    const bf16* ap = XB + (size_t)(unit * 64 + r) * DM + wave * 256 + 8 * h;
    const bf16* bp = Wba + (size_t)r * DM + wave * 256 + 8 * h;
    f32x16 acc[4] = {{}, {}, {}, {}};
#pragma unroll
    for (int half = 0; half < 2; ++half) {
        bf16x8 a0[8], a1[8], b0[8], b1[8];
#pragma unroll
        for (int ks = 0; ks < 8; ++ks) { const int ko = (half * 8 + ks) * 16;
            a0[ks] = *(const GAS bf16x8*)(ap + ko); a1[ks] = *(const GAS bf16x8*)(ap + (size_t)32 * DM + ko);
            b0[ks] = *(const GAS bf16x8*)(bp + ko); b1[ks] = *(const GAS bf16x8*)(bp + (size_t)32 * DM + ko); }
#pragma unroll
        for (int ks = 0; ks < 8; ++ks) {
            acc[0] = __builtin_amdgcn_mfma_f32_32x32x16_bf16(a0[ks], b0[ks], acc[0], 0, 0, 0); acc[1] = __builtin_amdgcn_mfma_f32_32x32x16_bf16(a0[ks], b1[ks], acc[1], 0, 0, 0);
            acc[2] = __builtin_amdgcn_mfma_f32_32x32x16_bf16(a1[ks], b0[ks], acc[2], 0, 0, 0); acc[3] = __builtin_amdgcn_mfma_f32_32x32x16_bf16(a1[ks], b1[ks], acc[3], 0, 0, 0); }
    }
    LAS float* red = (LAS float*)(lds + RING_OFF);
#pragma unroll
    for (int t = 0; t < 4; ++t)
#pragma unroll
        for (int i = 0; i < 16; ++i) red[((wave * 4 + t) * 16 + i) * 64 + lane] = acc[t][i];
    LDS_WAIT(); __syncthreads();
#pragma unroll
    for (int q = 0; q < 8; ++q) { const int e = tid + 512 * q, l = e & 63, i = (e >> 6) & 15, t = e >> 10; float v = 0.f;
#pragma unroll
        for (int w = 0; w < 8; ++w) v += red[((w * 4 + t) * 16 + i) * 64 + l];
        const int row = unit * 64 + (t >> 1) * 32 + (i & 3) + 8 * (i >> 2) + 4 * (l >> 5);
        BA[(size_t)row * 64 + (t & 1) * 32 + (l & 31)] = v; }
    LDS_WAIT(); __syncthreads();
}

__device__ __forceinline__ void dn_naive_phase(const bf16* QC, const bf16* KC, const bf16* VC, const float* BETA, const float* DEC, float* O, LAS unsigned char* lds, int unit, int tid) {
    constexpr int CT = 32, NCH = SEQ / CT;
    constexpr int BUF = 16384 + 16384 + 4096 + 256;
    const int bh = unit >> 2, vq = unit & 3, b = bh >> 5, hv = bh & 31, hk = hv >> 1;
    const int vl = tid >> 4, p = tid & 15;
    LAS float* ob = (LAS float*)(lds + 2 * BUF);
    const size_t row0 = (size_t)b * SEQ;
    const int lr = tid >> 4, lp = tid & 15;
    const bf16* qsrc = QC + (row0 + lr) * KDIM + hk * HD + lp * 8;
    const bf16* ksrc = KC + (row0 + lr) * KDIM + hk * HD + lp * 8;
    const int vr = (tid & 127) >> 2, vp = tid & 3;
    const bf16* vsrc = VC + (row0 + vr) * VDIM + hv * HD + vq * 32 + vp * 8;
    const float* gsrc = (tid < 32 ? BETA : DEC) + (row0 + (tid & 31)) * HV + hv;
    v4u rq, rk, rv = {0u, 0u, 0u, 0u}; float rg = 0.f;
    rq = *(const GAS v4u*)qsrc; rk = *(const GAS v4u*)ksrc; if (tid < 128) rv = *(const GAS v4u*)vsrc; if (tid < 64) rg = *gsrc;
    float S[8];
#pragma unroll
    for (int i = 0; i < 8; ++i) S[i] = 0.f;
    for (int c = 0; c < NCH; ++c) {
        LAS unsigned char* buf = lds + (c & 1) * BUF;
        { float f[8]; unpack8(rq, f); LAS f32x4* d = (LAS f32x4*)(buf + (lr * 128 + lp * 8) * 4); d[0] = (f32x4){f[0], f[1], f[2], f[3]}; d[1] = (f32x4){f[4], f[5], f[6], f[7]};
          unpack8(rk, f); d = (LAS f32x4*)(buf + 16384 + (lr * 128 + lp * 8) * 4); d[0] = (f32x4){f[0], f[1], f[2], f[3]}; d[1] = (f32x4){f[4], f[5], f[6], f[7]};
          if (tid < 128) { unpack8(rv, f); d = (LAS f32x4*)(buf + 32768 + (vr * 32 + vp * 8) * 4); d[0] = (f32x4){f[0], f[1], f[2], f[3]}; d[1] = (f32x4){f[4], f[5], f[6], f[7]}; }
          if (tid < 64) ((LAS float*)(buf + 36864))[tid] = rg; }
        __syncthreads();
        if (c + 1 < NCH) { const size_t adv = (size_t)(c + 1) * CT;
            rq = *(const GAS v4u*)(qsrc + adv * KDIM); rk = *(const GAS v4u*)(ksrc + adv * KDIM); if (tid < 128) rv = *(const GAS v4u*)(vsrc + adv * VDIM); if (tid < 64) rg = gsrc[adv * HV]; }
        const LAS float* qf = (const LAS float*)buf; const LAS float* kf = (const LAS float*)(buf + 16384); const LAS float* vf = (const LAS float*)(buf + 32768); const LAS float* gf = (const LAS float*)(buf + 36864);
#pragma unroll 4
        for (int tt = 0; tt < CT; ++tt) {
            const f32x4 k0 = *(const LAS f32x4*)(kf + tt * 128 + 8 * p), k1 = *(const LAS f32x4*)(kf + tt * 128 + 8 * p + 4);
            const f32x4 q0 = *(const LAS f32x4*)(qf + tt * 128 + 8 * p), q1 = *(const LAS f32x4*)(qf + tt * 128 + 8 * p + 4);
            const float vt = vf[tt * 32 + vl], bt = gf[tt], at = gf[32 + tt];
            float pred = (S[0] * k0.x + S[1] * k0.y) + (S[2] * k0.z + S[3] * k0.w) + (S[4] * k1.x + S[5] * k1.y) + (S[6] * k1.z + S[7] * k1.w);
            pred = rowsum16(pred);
            const float delta = bt * (vt - at * pred);
            S[0] = at * S[0] + k0.x * delta; S[1] = at * S[1] + k0.y * delta; S[2] = at * S[2] + k0.z * delta; S[3] = at * S[3] + k0.w * delta;
            S[4] = at * S[4] + k1.x * delta; S[5] = at * S[5] + k1.y * delta; S[6] = at * S[6] + k1.z * delta; S[7] = at * S[7] + k1.w * delta;
            float o = (S[0] * q0.x + S[1] * q0.y) + (S[2] * q0.z + S[3] * q0.w) + (S[4] * q1.x + S[5] * q1.y) + (S[6] * q1.z + S[7] * q1.w);
            o = rowsum16(o);
            if (p == 0) ob[tt * 32 + vl] = o;
        }
        __syncthreads();
        if (tid < 256) { const int orow = tid >> 3, oc = (tid & 7) * 4; const f32x4 v = *(const LAS f32x4*)(ob + orow * 32 + oc);
            *(GAS f32x4*)(O + (row0 + (size_t)c * CT + orow) * VDIM + hv * HD + vq * 32 + oc) = v; }
    }
    __syncthreads();
}


constexpr int PL_Q = 0, PL_K = 16384, PL_KT = 32768, PL_VT = 49152, PL_A = 81920, PL_SM = 114688, PL_T0 = 116736, PL_TB = 0;
__device__ __forceinline__ int rm_addr(int row, int col) { return row * 256 + (((col >> 3) ^ (row & 15)) << 4) + (col & 7) * 2; }
__device__ __forceinline__ int kt_addr(int d, int c) { return d * 128 + ((((c >> 3) ^ (d >> 3)) & 7) << 4) + (c & 7) * 2; }
__device__ __forceinline__ int rowof(int rho, int h) { return (rho & 3) + 8 * (rho >> 2) + 4 * h; }
__device__ __forceinline__ unsigned short bf1(float v) { return (unsigned short)(pk2(v, v) & 0xffffu); }

struct PrepPre { f32x4 w[8]; float br, ar; };
__device__ __forceinline__ void prep_load_aux(const float* cw, const float* BA, int item, int tid, PrepPre& pp) {
    const int chunk = item & 127, bk = item >> 7, hk = bk & 15, b = bk >> 4;
    int c0;
    if (tid < 256) c0 = (tid >> 7) * KDIM + hk * HD + (tid & 15) * 8; else c0 = 2 * KDIM + hk * 2 * HD + ((tid - 256) & 31) * 8;
#pragma unroll
    for (int j = 0; j < 4; ++j) { pp.w[2 * j] = *(const GAS f32x4*)(cw + (size_t)j * QKV + c0); pp.w[2 * j + 1] = *(const GAS f32x4*)(cw + (size_t)j * QKV + c0 + 4); }
    pp.br = 0.f; pp.ar = 0.f;
    if (tid < 128) { const int hv = 2 * hk + (tid >> 6); const size_t tk = (size_t)b * SEQ + (size_t)chunk * 64 + (tid & 63); pp.br = BA[tk * 64 + hv]; pp.ar = BA[tk * 64 + HV + hv]; }
}
__device__ __forceinline__ void prep_load_rows(const bf16* QKVr, int item, int tid, v4u (&rowv)[11]) {
    const int chunk = item & 127, bk = item >> 7, hk = bk & 15, b = bk >> 4;
    int c0, run;
    if (tid < 256) { const int tq = tid & 127; run = tq >> 4; c0 = (tid >> 7) * KDIM + hk * HD + (tq & 15) * 8; }
    else { const int tv = tid - 256; run = tv >> 5; c0 = 2 * KDIM + hk * 2 * HD + (tv & 31) * 8; }
    const size_t rr0 = (size_t)b * SEQ + (size_t)chunk * 64 + run * 8;
    const bool first = (chunk == 0) && (run == 0);
#pragma unroll
    for (int q = 0; q < 11; ++q) rowv[q] = (first && q < 3) ? (v4u){0u, 0u, 0u, 0u} : __builtin_nontemporal_load((const GAS v4u*)(QKVr + (rr0 + q - 3) * QKV + c0));
}
template <int STG> __device__ __forceinline__ void dn_prep_item(const bf16* QKVr, const float* cw  , const float* BA, const float* a_log, const float* dt_bias, bf16* Wf, bf16* Qf, bf16* Kf, bf16* AQKf, bf16* Uf, float* SC,
                                             LAS unsigned char* lds, int item, int next_item, v4u (&rowv)[11], PrepPre& pp, int tid, int wave, int lane) {
    asm volatile("" : "+v"(tid), "+v"(lane));
    const int chunk = item & 127, bk = item >> 7, hk = bk & 15, b = bk >> 4;
    const size_t tok0 = (size_t)b * SEQ + (size_t)chunk * 64;
    const size_t ki = (size_t)item;
    const int r = lane & 31, h = lane >> 5;
    LAS float* betl = (LAS float*)(lds + PL_SM);
    LAS float* gcl_ = (LAS float*)(lds + PL_SM + 512);
    LAS float* facl = (LAS float*)(lds + PL_SM + 1024);
    float gate_br = 0.f, gate_ar = 0.f;
    if (STG & 1) {
    {   int c0, run, kind;
        if (tid < 256) { const int tq = tid & 127; kind = tid >> 7; run = tq >> 4; c0 = kind * KDIM + hk * HD + (tq & 15) * 8; }
        else { const int tv = tid - 256; kind = 2; run = tv >> 5; c0 = 2 * KDIM + hk * 2 * HD + (tv & 31) * 8; }
        const int lc = (kind == 2) ? (tid & 31) * 8 : (tid & 15) * 8;
        float w[4][8];
#pragma unroll
        for (int j = 0; j < 4; ++j) { const f32x4 a = pp.w[2 * j], a2 = pp.w[2 * j + 1]; w[j][0] = a.x; w[j][1] = a.y; w[j][2] = a.z; w[j][3] = a.w; w[j][4] = a2.x; w[j][5] = a2.y; w[j][6] = a2.z; w[j][7] = a2.w; }
        const float br_ = pp.br, ar_ = pp.ar;
        float h3[8], h2[8], h1[8];
        unpack8(rowv[0], h3); unpack8(rowv[1], h2); unpack8(rowv[2], h1);
        const float qs = (kind == 0) ? 0.08838834764831845f : 1.0f;
        unsigned pw[8][4];
#pragma unroll
        for (int q = 0; q < 8; ++q) {
            float u0[8], o[8]; float ss = 0.f;
            unpack8(rowv[3 + q], u0);
#pragma unroll
            for (int e = 0; e < 8; ++e) { const float c = w[0][e] * h3[e] + w[1][e] * h2[e] + w[2][e] * h1[e] + w[3][e] * u0[e]; o[e] = silu_f(c); ss += o[e] * o[e]; h3[e] = h2[e]; h2[e] = h1[e]; h1[e] = u0[e]; }
            ss = rowsum16(ss);
            const float sc = (kind == 2) ? 1.0f : qs / sqrtf(ss + RMS_EPS);
#pragma unroll
            for (int e = 0; e < 8; ++e) o[e] *= sc;
            const v4u pv = pack8(o); const int row = run * 8 + q;
            pw[q][0] = pv.x; pw[q][1] = pv.y; pw[q][2] = pv.z; pw[q][3] = pv.w;
            if (kind == 0) *(LAS v4u*)(lds + PL_Q + rm_addr(row, lc)) = pv;
            else if (kind == 1) *(LAS v4u*)(lds + PL_K + rm_addr(row, lc)) = pv;
        }
        if (next_item >= 0) { prep_load_rows(QKVr, next_item, tid, rowv); prep_load_aux(cw, BA, next_item, tid, pp); }
        gate_br = br_; gate_ar = ar_;
        if (kind != 0) {
            const int tbase = (kind == 1) ? PL_KT : PL_VT;
#pragma unroll
            for (int e2 = 0; e2 < 8; ++e2) { v4u t; unsigned tw[4];
#pragma unroll
                for (int pr = 0; pr < 4; ++pr) { const unsigned a = pw[2 * pr][e2 >> 1], bq = pw[2 * pr + 1][e2 >> 1]; tw[pr] = (e2 & 1) ? ((a >> 16) | (bq & 0xffff0000u)) : ((a & 0xffffu) | (bq << 16)); }
                t.x = tw[0]; t.y = tw[1]; t.z = tw[2]; t.w = tw[3];
                *(LAS v4u*)(lds + tbase + kt_addr(lc + e2, run * 8)) = t; }
        }
    }
    if (wave < 2) { const int hv = 2 * hk + wave;
        const float br = gate_br, ar = gate_ar;
        const float xx = ar + dt_bias[hv];
        const float sp = fmaxf(xx, 0.f) + log1pf(__expf(-fabsf(xx)));
        const float bt = 1.f / (1.f + __expf(-br)); float gc = -__expf(a_log[hv]) * sp;
#pragma unroll
        for (int o = 1; o < 64; o <<= 1) { const float t = __shfl_up(gc, o); if (lane >= o) gc += t; }
        const float gl = __shfl(gc, 63);
        betl[wave * 64 + lane] = bt; gcl_[wave * 64 + lane] = gc; const float eg = __expf(gc);
        facl[(wave * 2 + 0) * 64 + lane] = bt; facl[(wave * 2 + 1) * 64 + lane] = bt * eg;
        float* sc = SC + ((size_t)(b * HV + hv) * 128 + chunk) * 256;
        sc[lane] = eg; sc[64 + lane] = __expf(gl - gc); if (lane == 0) sc[128] = __expf(gl); }
    }
    LDS_WAIT(); __syncthreads();
    if (STG & 2)
    {   f32x16 acc = {};
        if (wave < 4) { const int tc = wave >> 1, tm = wave & 1;
#pragma unroll
            for (int ks = 0; ks < 8; ++ks) { const bf16x8 a = *(const LAS bf16x8*)(lds + PL_K + rm_addr(32 * tc + r, 16 * ks + 8 * h)), bb = *(const LAS bf16x8*)(lds + PL_K + rm_addr(32 * tm + r, 16 * ks + 8 * h));
                acc = __builtin_amdgcn_mfma_f32_32x32x16_bf16(a, bb, acc, 0, 0, 0); }
#pragma unroll
            for (int hvl = 0; hvl < 2; ++hvl) { const int m = 32 * tm + r; const float gm = gcl_[hvl * 64 + m];
                f32x4 g4[4], b4[4];
#pragma unroll
                for (int g = 0; g < 4; ++g) { g4[g] = *(const LAS f32x4*)(gcl_ + hvl * 64 + 32 * tc + 8 * g + 4 * h); b4[g] = *(const LAS f32x4*)(betl + hvl * 64 + 32 * tc + 8 * g + 4 * h); }
#pragma unroll
                for (int rho = 0; rho < 16; ++rho) { const int c = 32 * tc + rowof(rho, h); const float e = __expf(fminf(g4[rho >> 2][rho & 3] - gm, 0.f));
                    const float val = (c > m) ? b4[rho >> 2][rho & 3] * acc[rho] * e : 0.f;
                    *(LAS float*)(lds + PL_A + hvl * 16384 + (c * 64 + m) * 4) = val; } }
        } else { const int tm = (wave - 4) >> 1, tcp = (wave - 4) & 1;
#pragma unroll
            for (int ks = 0; ks < 8; ++ks) { const bf16x8 a = *(const LAS bf16x8*)(lds + PL_K + rm_addr(32 * tm + r, 16 * ks + 8 * h)), bb = *(const LAS bf16x8*)(lds + PL_Q + rm_addr(32 * tcp + r, 16 * ks + 8 * h));
                acc = __builtin_amdgcn_mfma_f32_32x32x16_bf16(a, bb, acc, 0, 0, 0); }
#pragma unroll
            for (int hvl = 0; hvl < 2; ++hvl) { const int cp = 32 * tcp + r; const float gp = gcl_[hvl * 64 + cp]; float val[16];
                f32x4 g4[4];
#pragma unroll
                for (int g = 0; g < 4; ++g) g4[g] = *(const LAS f32x4*)(gcl_ + hvl * 64 + 32 * tm + 8 * g + 4 * h);
#pragma unroll
                for (int rho = 0; rho < 16; ++rho) { const int m = 32 * tm + rowof(rho, h); const float e = __expf(fminf(gp - g4[rho >> 2][rho & 3], 0.f)); val[rho] = (cp >= m) ? acc[rho] * e : 0.f; }
                bf16* dst = AQKf + ((size_t)(b * HV + 2 * hk + hvl) * 128 + chunk) * 4096 + ((tcp * 2 + tm) * 2) * 512 + lane * 8;
                v4u w0, w1; w0.x = pk2(val[0], val[1]); w0.y = pk2(val[2], val[3]); w0.z = pk2(val[4], val[5]); w0.w = pk2(val[6], val[7]);
                w1.x = pk2(val[8], val[9]); w1.y = pk2(val[10], val[11]); w1.z = pk2(val[12], val[13]); w1.w = pk2(val[14], val[15]);
                *(GAS v4u*)dst = w0; *(GAS v4u*)(dst + 512) = w1; } }
#pragma unroll
        for (int e = 0; e < 2; ++e) { const int f = 2 * wave + e;
            { const int t = f >> 3, i = (f >> 1) & 3, s = f & 1, row = 32 * t + r, col0 = 32 * i + 16 * s + 4 * h;
              const v2u lo = *(const LAS v2u*)(lds + PL_Q + rm_addr(row, col0)), hi = *(const LAS v2u*)(lds + PL_Q + rm_addr(row, col0 + 8));
              *(GAS v4u*)(Qf + ki * 8192 + f * 512 + lane * 8) = (v4u){lo.x, lo.y, hi.x, hi.y}; }
            { const int i = f >> 2, t = (f >> 1) & 1, s = f & 1, d = 32 * i + r, c0 = 32 * t + 16 * s + 4 * h;
              const v2u lo = *(const LAS v2u*)(lds + PL_KT + kt_addr(d, c0)), hi = *(const LAS v2u*)(lds + PL_KT + kt_addr(d, c0 + 8));
              *(GAS v4u*)(Kf + ki * 8192 + f * 512 + lane * 8) = (v4u){lo.x, lo.y, hi.x, hi.y}; } }
    }
    LDS_WAIT(); __syncthreads();
    if ((STG & 4) && wave < 2) {
        const int hvl = wave, blk = h, m = r;
        const LAS float* Ah = (const LAS float*)(lds + PL_A + hvl * 16384);
        const LAS float* Ab = Ah + (32 * blk) * 64 + 32 * blk;
        float X[32]; f32x4 ar[2][8];
        ar[1][0] = *(const LAS f32x4*)(Ab + 64);
#pragma unroll
        for (int i = 0; i < 32; ++i) {
            if (i + 1 < 32) {
#pragma unroll
                for (int c = 0; c < (i + 1 + 3) / 4; ++c) ar[(i + 1) & 1][c] = *(const LAS f32x4*)(Ab + (i + 1) * 64 + 4 * c); }
            __builtin_amdgcn_sched_barrier(0);
            float acc = (i == m) ? 1.f : 0.f, acc1 = 0.f, acc2 = 0.f, acc3 = 0.f;
#pragma unroll
            for (int j0 = 0; j0 < i; j0 += 4) { const f32x4 a = ar[i & 1][j0 >> 2];
                acc -= a.x * X[j0]; if (j0 + 1 < i) acc1 -= a.y * X[j0 + 1]; if (j0 + 2 < i) acc2 -= a.z * X[j0 + 2]; if (j0 + 3 < i) acc3 -= a.w * X[j0 + 3]; }
            X[i] = (acc + acc1) + (acc2 + acc3);
            __builtin_amdgcn_sched_barrier(0); }
        LAS unsigned char* t0 = lds + PL_T0 + hvl * 4096;
        if (blk == 0) {
#pragma unroll
            for (int q = 0; q < 4; ++q) { v4u w; w.x = pk2(X[8 * q + 0], X[8 * q + 1]); w.y = pk2(X[8 * q + 2], X[8 * q + 3]); w.z = pk2(X[8 * q + 4], X[8 * q + 5]); w.w = pk2(X[8 * q + 6], X[8 * q + 7]);
                *(LAS v4u*)(t0 + m * 64 + q * 16) = w; }
        } else {
#pragma unroll
            for (int i = 0; i < 32; ++i) *(LAS unsigned short*)(t0 + 2048 + i * 64 + m * 2) = bf1(X[i]);
        }
        LDS_WAIT();
        f32x16 Yv = {}, T10 = {};
#pragma unroll
        for (int sidx = 0; sidx < 2; ++sidx) { const LAS float* ap = Ah + (32 + r) * 64 + 16 * sidx + 8 * h; const f32x4 a0 = *(const LAS f32x4*)ap, a1 = *(const LAS f32x4*)(ap + 4);
            const bf16x8 af = __builtin_bit_cast(bf16x8, (v4u){pk2(a0.x, a0.y), pk2(a0.z, a0.w), pk2(a1.x, a1.y), pk2(a1.z, a1.w)});
            const bf16x8 bq = *(const LAS bf16x8*)(t0 + r * 64 + (16 * sidx + 8 * h) * 2);
            Yv = __builtin_amdgcn_mfma_f32_32x32x16_bf16(af, bq, Yv, 0, 0, 0); }
#pragma unroll
        for (int sidx = 0; sidx < 2; ++sidx) { const v2u lo = *(const LAS v2u*)(t0 + 2048 + r * 64 + (16 * sidx + 4 * h) * 2), hi = *(const LAS v2u*)(t0 + 2048 + r * 64 + (16 * sidx + 8 + 4 * h) * 2);
            const bf16x8 af = __builtin_bit_cast(bf16x8, (v4u){lo.x, lo.y, hi.x, hi.y});
            const bf16x8 bq = __builtin_bit_cast(bf16x8, (v4u){pk2(Yv[8 * sidx + 0], Yv[8 * sidx + 1]), pk2(Yv[8 * sidx + 2], Yv[8 * sidx + 3]), pk2(Yv[8 * sidx + 4], Yv[8 * sidx + 5]), pk2(Yv[8 * sidx + 6], Yv[8 * sidx + 7])});
            T10 = __builtin_amdgcn_mfma_f32_32x32x16_bf16(af, bq, T10, 0, 0, 0); }
        LAS unsigned char* tb = lds + PL_TB + (hvl * 2) * 8192; LAS unsigned char* tbg = tb + 8192;
        { const float bm = betl[hvl * 64 + lane], bgm = facl[(hvl * 2 + 1) * 64 + lane];
#pragma unroll
          for (int i = 0; i < 32; ++i) { const int a = kt_addr(32 * blk + i, lane); *(LAS unsigned short*)(tb + a) = bf1(X[i] * bm); *(LAS unsigned short*)(tbg + a) = bf1(X[i] * bgm); }
          if (blk == 1) {
#pragma unroll
              for (int i = 0; i < 32; ++i) { const int a = kt_addr(i, lane); *(LAS unsigned short*)(tb + a) = 0; *(LAS unsigned short*)(tbg + a) = 0; } } }
        { const float bm = betl[hvl * 64 + m], bgm = facl[(hvl * 2 + 1) * 64 + m];
#pragma unroll
          for (int rho = 0; rho < 16; ++rho) { const int a = kt_addr(32 + rowof(rho, h), m); *(LAS unsigned short*)(tb + a) = bf1(-T10[rho] * bm); *(LAS unsigned short*)(tbg + a) = bf1(-T10[rho] * bgm); } }
    }
    LDS_WAIT(); __syncthreads();
    if (STG & 8)
#pragma unroll
    for (int e = 0; e < 4; ++e) { const int idx = wave * 4 + e, hvl = idx >> 4, job = idx & 15;
        const LAS unsigned char* tb = lds + PL_TB + (hvl * 2) * 8192; const LAS unsigned char* tbg = tb + 8192;
        const size_t ci = (size_t)(b * HV + 2 * hk + hvl) * 128 + chunk;
        f32x16 acc = {};
        if (job < 8) { const int tc = job >> 2, jd = job & 3;
#pragma unroll
            for (int ks = 0; ks < 4; ++ks) { const bf16x8 a = *(const LAS bf16x8*)(tb + kt_addr(32 * tc + r, 16 * ks + 8 * h)), bq = *(const LAS bf16x8*)(lds + PL_VT + kt_addr(hvl * 128 + 32 * jd + r, 16 * ks + 8 * h));
                acc = __builtin_amdgcn_mfma_f32_32x32x16_bf16(a, bq, acc, 0, 0, 0); }
            v4u w0, w1; w0.x = pk2(acc[0], acc[1]); w0.y = pk2(acc[2], acc[3]); w0.z = pk2(acc[4], acc[5]); w0.w = pk2(acc[6], acc[7]);
            w1.x = pk2(acc[8], acc[9]); w1.y = pk2(acc[10], acc[11]); w1.z = pk2(acc[12], acc[13]); w1.w = pk2(acc[14], acc[15]);
            bf16* dst = Uf + ci * 8192 + (size_t)(((jd * 2 + tc) * 64 + lane) * 16);
            *(GAS v4u*)dst = w0; *(GAS v4u*)(dst + 8) = w1;
        } else { const int i = (job - 8) >> 1, t = (job - 8) & 1;
#pragma unroll
            for (int ks = 0; ks < 4; ++ks) { const bf16x8 a = *(const LAS bf16x8*)(lds + PL_KT + kt_addr(32 * i + r, 16 * ks + 8 * h)), bq = *(const LAS bf16x8*)(tbg + kt_addr(32 * t + r, 16 * ks + 8 * h));
                acc = __builtin_amdgcn_mfma_f32_32x32x16_bf16(a, bq, acc, 0, 0, 0); }
            v4u w0, w1; w0.x = pk2(-acc[0], -acc[1]); w0.y = pk2(-acc[2], -acc[3]); w0.z = pk2(-acc[4], -acc[5]); w0.w = pk2(-acc[6], -acc[7]);
            w1.x = pk2(-acc[8], -acc[9]); w1.y = pk2(-acc[10], -acc[11]); w1.z = pk2(-acc[12], -acc[13]); w1.w = pk2(-acc[14], -acc[15]);
            bf16* dst = Wf + ci * 8192 + ((t * 4 + i) * 2) * 512 + lane * 8;
            *(GAS v4u*)dst = w0; *(GAS v4u*)(dst + 512) = w1;
        }
    }
    LDS_WAIT(); __syncthreads();
}

template <int VAR> __device__ __forceinline__ void dn_scan_phase(const bf16* Wf, const bf16* Qf, const bf16* Kf, const bf16* AQKf, const bf16* Uf, const float* SC, bf16* O, LAS unsigned char* lds, int unit, int wave, int lane) {
    constexpr int BUFB = 58368, NST = SEQ / 64;
    constexpr int HOFF = 2 * BUFB, HFLAG = HOFF + 12288;
    const int bh = unit >> 2, jd = unit & 3, b = bh >> 5, hv = bh & 31, hk = hv >> 1;
    const size_t ci0 = (size_t)(b * HV + hv) * 128, ki0 = (size_t)(b * HK + hk) * 128;
    const int r = lane & 31, h = lane >> 5;
    if (wave == 0 && lane < 2) ((LAS unsigned*)(lds + HFLAG))[lane] = 0u;
#define MF(a, bq, c) __builtin_amdgcn_mfma_f32_32x32x16_bf16(a, bq, c, 0, 0, 0)
#define FRAG(off) (*(const LAS bf16x8*)(bp + (off) + lane * 16))
#define PK8(V, s) __builtin_bit_cast(bf16x8, (v4u){pk2(V[8 * (s) + 0], V[8 * (s) + 1]), pk2(V[8 * (s) + 2], V[8 * (s) + 3]), pk2(V[8 * (s) + 4], V[8 * (s) + 5]), pk2(V[8 * (s) + 6], V[8 * (s) + 7])})
#define SBAR() __builtin_amdgcn_sched_barrier(0)
#define RD4(D, o0, o1, o2, o3) do { D[0] = FRAG(o0); D[1] = FRAG(o1); D[2] = FRAG(o2); D[3] = FRAG(o3); } while (0)
#define WF(f) ((f) * 1024)
#define QF(f) (16384 + (f) * 1024)
#define KF(f) (32768 + (f) * 1024)
#define AF(f) (49152 + (f) * 1024)
#define HSB(e) (*(LAS bf16x8*)(lds + HOFF + (e) * 1024 + lane * 16))
#define HVB(e) (*(LAS bf16x8*)(lds + HOFF + 8192 + (e) * 1024 + lane * 16))
#define POLL(w_, val_) do { volatile LAS unsigned* fl_ = (volatile LAS unsigned*)(lds + HFLAG); while (fl_[w_] != (unsigned)(val_)) __builtin_amdgcn_s_sleep(0); asm volatile("" ::: "memory"); } while (0)
    if (wave > 0) {
        const bf16* src; size_t stride;
        if (wave <= 2) { src = Wf + ci0 * 8192 + (wave - 1) * 4096; stride = 8192; }
        else if (wave <= 4) { src = Qf + ki0 * 8192 + (wave - 3) * 4096; stride = 8192; }
        else if (wave <= 6) { src = Kf + ki0 * 8192 + (wave - 5) * 4096; stride = 8192; }
        else { src = AQKf + ci0 * 4096; stride = 4096; }
        src += lane * 8;
        const float* ssrc = SC + ci0 * 256 + lane * 4;
        const int dofs = (wave - 1) * 8192 + lane * 16;
        GAS v4u* obase = (GAS v4u*)(O + ((size_t)b * SEQ + (lane >> 2)) * VDIM + hv * HD + jd * 32 + (lane & 3) * 8);
        v4u RA[8], RB[8]; f32x4 RsA = {0.f, 0.f, 0.f, 0.f}, RsB = {0.f, 0.f, 0.f, 0.f};
#define LD_SET(R, Rs, st) do { const bf16* sp_ = src + (size_t)(st) * stride; _Pragma("unroll") for (int e = 0; e < 8; ++e) R[e] = *(const GAS v4u*)(sp_ + e * 512); if (wave == 1) Rs = *(const GAS f32x4*)(ssrc + (size_t)(st) * 256); } while (0)
#define ST_SET(R, Rs, st) do { LAS unsigned char* bp_ = lds + ((st) & 1) * BUFB; _Pragma("unroll") for (int e = 0; e < 8; ++e) *(LAS v4u*)(bp_ + dofs + e * 1024) = R[e]; if (wave == 1) *(LAS f32x4*)(bp_ + 57344 + lane * 16) = Rs; } while (0)
#define OSTEP(n_) do { if (wave == 1 && VAR < 2) { \
            const LAS unsigned char* bp = lds + ((n_) & 1) * BUFB; const LAS float* scl = (const LAS float*)(bp + 57344); \
            bf16x8 X[4], Y[4], Z[2], Sb[8], Vb[4]; f32x16 oa0 = {}, oa1 = {}; \
            RD4(X, QF(0), QF(1), QF(2), QF(3)); \
            POLL(0, (n_) + 1); \
            _Pragma("unroll") for (int e = 0; e < 8; ++e) Sb[e] = HSB(e); \
            SBAR(); \
            RD4(Y, QF(4), QF(5), QF(6), QF(7)); \
            oa0 = MF(X[0], Sb[0], oa0); oa0 = MF(X[1], Sb[1], oa0); oa0 = MF(X[2], Sb[2], oa0); oa0 = MF(X[3], Sb[3], oa0); \
            SBAR(); \
            RD4(X, QF(8), QF(9), QF(10), QF(11)); \
            oa0 = MF(Y[0], Sb[4], oa0); oa0 = MF(Y[1], Sb[5], oa0); oa0 = MF(Y[2], Sb[6], oa0); oa0 = MF(Y[3], Sb[7], oa0); \
            SBAR(); \
            RD4(Y, QF(12), QF(13), QF(14), QF(15)); \
            oa1 = MF(X[0], Sb[0], oa1); oa1 = MF(X[1], Sb[1], oa1); oa1 = MF(X[2], Sb[2], oa1); oa1 = MF(X[3], Sb[3], oa1); \
            SBAR(); \
            RD4(X, AF(0), AF(1), AF(4), AF(5)); \
            oa1 = MF(Y[0], Sb[4], oa1); oa1 = MF(Y[1], Sb[5], oa1); oa1 = MF(Y[2], Sb[6], oa1); oa1 = MF(Y[3], Sb[7], oa1); \
            SBAR(); \
            Z[0] = FRAG(AF(6)); Z[1] = FRAG(AF(7)); \
            _Pragma("unroll") for (int g = 0; g < 4; ++g) { const f32x4 e0 = *(const LAS f32x4*)(scl + 8 * g + 4 * h), e1 = *(const LAS f32x4*)(scl + 32 + 8 * g + 4 * h); \
                oa0[4 * g + 0] *= e0.x; oa0[4 * g + 1] *= e0.y; oa0[4 * g + 2] *= e0.z; oa0[4 * g + 3] *= e0.w; \
                oa1[4 * g + 0] *= e1.x; oa1[4 * g + 1] *= e1.y; oa1[4 * g + 2] *= e1.z; oa1[4 * g + 3] *= e1.w; } \
            POLL(1, (n_) + 1); \
            _Pragma("unroll") for (int e = 0; e < 4; ++e) Vb[e] = HVB(e); \
            SBAR(); \
            oa0 = MF(X[0], Vb[0], oa0); oa0 = MF(X[1], Vb[1], oa0); \
            oa1 = MF(X[2], Vb[0], oa1); oa1 = MF(X[3], Vb[1], oa1); oa1 = MF(Z[0], Vb[2], oa1); oa1 = MF(Z[1], Vb[3], oa1); \
            if (VAR == 0) { LAS unsigned char* stg = lds + HOFF + 8192;     \
              _Pragma("unroll") for (int rho = 0; rho < 16; ++rho) { *(LAS unsigned short*)(stg + rowof(rho, h) * 64 + r * 2) = bf1(oa0[rho]); *(LAS unsigned short*)(stg + (32 + rowof(rho, h)) * 64 + r * 2) = bf1(oa1[rho]); } \
              LDS_WAIT(); \
              _Pragma("unroll") for (int q = 0; q < 4; ++q) { const v4u ov = *(const LAS v4u*)(stg + (16 * q + (lane >> 2)) * 64 + (lane & 3) * 16); obase[(((size_t)(n_) * 64 + 16 * q) * VDIM) / 8] = ov; } } \
            else { asm volatile("" :: "v"(oa0), "v"(oa1)); } \
            SBAR(); } } while (0)
        LD_SET(RA, RsA, 0); ST_SET(RA, RsA, 0);
        LD_SET(RA, RsA, 1); LD_SET(RB, RsB, 2);
        for (int n = 0; n < NST; n += 2) {
            LDS_WAIT(); __builtin_amdgcn_s_barrier(); asm volatile("" ::: "memory");
            if (n + 1 < NST) ST_SET(RA, RsA, n + 1);
            if (n + 3 < NST) LD_SET(RA, RsA, n + 3);
            OSTEP(n);
            LDS_WAIT(); __builtin_amdgcn_s_barrier(); asm volatile("" ::: "memory");
            if (n + 2 < NST) ST_SET(RB, RsB, n + 2);
            if (n + 4 < NST) LD_SET(RB, RsB, n + 4);
            OSTEP(n + 1);
        }
#undef LD_SET
#undef ST_SET
#undef OSTEP
    } else {
        f32x16 S0 = {}, S1 = {}, S2 = {}, S3 = {};
        const bf16* usrc = Uf + ci0 * 8192 + (size_t)((jd * 2) * 64 + lane) * 16;
        v4u un[4];
        un[0] = *(const GAS v4u*)usrc; un[1] = *(const GAS v4u*)(usrc + 8); un[2] = *(const GAS v4u*)(usrc + 1024); un[3] = *(const GAS v4u*)(usrc + 1032);
        for (int n = 0; n < NST; ++n) {
            LDS_WAIT(); __builtin_amdgcn_s_barrier(); asm volatile("" ::: "memory");
            if (VAR == 3) continue;
            const LAS unsigned char* bp = lds + (n & 1) * BUFB;
            const LAS float* scl = (const LAS float*)(bp + 57344);
            bf16x8 X[4], Y[4];
            RD4(X, WF(0), WF(1), WF(2), WF(3));
            f32x16 P0, P1;
            { float uu[8]; unpack8(un[0], uu);
#pragma unroll
              for (int e = 0; e < 8; ++e) P0[e] = uu[e];
              unpack8(un[1], uu);
#pragma unroll
              for (int e = 0; e < 8; ++e) P0[8 + e] = uu[e];
              unpack8(un[2], uu);
#pragma unroll
              for (int e = 0; e < 8; ++e) P1[e] = uu[e];
              unpack8(un[3], uu);
#pragma unroll
              for (int e = 0; e < 8; ++e) P1[8 + e] = uu[e]; }
            if (n + 1 < NST) { const bf16* up = usrc + (size_t)(n + 1) * 8192; un[0] = *(const GAS v4u*)up; un[1] = *(const GAS v4u*)(up + 8); un[2] = *(const GAS v4u*)(up + 1024); un[3] = *(const GAS v4u*)(up + 1032); }
            const bf16x8 Sb00 = PK8(S0, 0), Sb01 = PK8(S0, 1), Sb10 = PK8(S1, 0), Sb11 = PK8(S1, 1), Sb20 = PK8(S2, 0), Sb21 = PK8(S2, 1), Sb30 = PK8(S3, 0), Sb31 = PK8(S3, 1);
            HSB(0) = Sb00; HSB(1) = Sb01; HSB(2) = Sb10; HSB(3) = Sb11; HSB(4) = Sb20; HSB(5) = Sb21; HSB(6) = Sb30; HSB(7) = Sb31;
            asm volatile("" ::: "memory");
            if (lane == 0) ((volatile LAS unsigned*)(lds + HFLAG))[0] = (unsigned)(n + 1);
            SBAR();
            RD4(Y, WF(4), WF(5), WF(6), WF(7));
            P0 = MF(X[0], Sb00, P0); P0 = MF(X[1], Sb01, P0); P0 = MF(X[2], Sb10, P0); P0 = MF(X[3], Sb11, P0);
            { const float cd = scl[128]; S0 = S0 * cd; S1 = S1 * cd; S2 = S2 * cd; S3 = S3 * cd; }
            SBAR();
            RD4(X, WF(8), WF(9), WF(10), WF(11));
            P0 = MF(Y[0], Sb20, P0); P0 = MF(Y[1], Sb21, P0); P0 = MF(Y[2], Sb30, P0); P0 = MF(Y[3], Sb31, P0);
            SBAR();
            RD4(Y, WF(12), WF(13), WF(14), WF(15));
            P1 = MF(X[0], Sb00, P1); P1 = MF(X[1], Sb01, P1); P1 = MF(X[2], Sb10, P1); P1 = MF(X[3], Sb11, P1);
            bf16x8 Vb00, Vb01, Ve00, Ve01, Vb10, Vb11, Ve10, Ve11;
            { float E[16];
#pragma unroll
              for (int g = 0; g < 4; ++g) { const f32x4 k0 = *(const LAS f32x4*)(scl + 64 + 8 * g + 4 * h);
                  E[4 * g + 0] = P0[4 * g + 0] * k0.x; E[4 * g + 1] = P0[4 * g + 1] * k0.y; E[4 * g + 2] = P0[4 * g + 2] * k0.z; E[4 * g + 3] = P0[4 * g + 3] * k0.w; }
              Vb00 = PK8(P0, 0); Vb01 = PK8(P0, 1); Ve00 = PK8(E, 0); Ve01 = PK8(E, 1); }
            SBAR();
            RD4(X, KF(0), KF(1), KF(4), KF(5));
            P1 = MF(Y[0], Sb20, P1); P1 = MF(Y[1], Sb21, P1); P1 = MF(Y[2], Sb30, P1); P1 = MF(Y[3], Sb31, P1);
            HVB(0) = Vb00; HVB(1) = Vb01;
            SBAR();
            RD4(Y, KF(8), KF(9), KF(12), KF(13));
            S0 = MF(X[0], Ve00, S0); S0 = MF(X[1], Ve01, S0); S1 = MF(X[2], Ve00, S1); S1 = MF(X[3], Ve01, S1);
            { float E[16];
#pragma unroll
              for (int g = 0; g < 4; ++g) { const f32x4 k1 = *(const LAS f32x4*)(scl + 64 + 32 + 8 * g + 4 * h);
                  E[4 * g + 0] = P1[4 * g + 0] * k1.x; E[4 * g + 1] = P1[4 * g + 1] * k1.y; E[4 * g + 2] = P1[4 * g + 2] * k1.z; E[4 * g + 3] = P1[4 * g + 3] * k1.w; }
              Vb10 = PK8(P1, 0); Vb11 = PK8(P1, 1); Ve10 = PK8(E, 0); Ve11 = PK8(E, 1); }
            SBAR();
            RD4(X, KF(2), KF(3), KF(6), KF(7));
            S2 = MF(Y[0], Ve00, S2); S2 = MF(Y[1], Ve01, S2); S3 = MF(Y[2], Ve00, S3); S3 = MF(Y[3], Ve01, S3);
            HVB(2) = Vb10; HVB(3) = Vb11;
            asm volatile("" ::: "memory");
            if (lane == 0) ((volatile LAS unsigned*)(lds + HFLAG))[1] = (unsigned)(n + 1);
            SBAR();
            RD4(Y, KF(10), KF(11), KF(14), KF(15));
            S0 = MF(X[0], Ve10, S0); S0 = MF(X[1], Ve11, S0); S1 = MF(X[2], Ve10, S1); S1 = MF(X[3], Ve11, S1);
            SBAR();
            S2 = MF(Y[0], Ve10, S2); S2 = MF(Y[1], Ve11, S2); S3 = MF(Y[2], Ve10, S3); S3 = MF(Y[3], Ve11, S3);
            SBAR();
        }
        asm volatile("" :: "v"(S0), "v"(S1), "v"(S2), "v"(S3));
    }
#undef MF
#undef FRAG
#undef PK8
#undef SBAR
#undef RD4
#undef WF
#undef QF
#undef KF
#undef AF
#undef HSB
#undef HVB
#undef POLL
    LDS_WAIT(); __syncthreads();
}

__device__ __forceinline__ void dn_gnorm_phase(const bf16* O, const bf16* Z, const float* nw, bf16* A3, int gw, int NGW, int lane) {
    constexpr int NCG = VDIM / 512, NITEMS = M * NCG;
    float wv[8];
    { const f32x4 a = *(const GAS f32x4*)(nw + (lane & 15) * 8), b = *(const GAS f32x4*)(nw + (lane & 15) * 8 + 4); wv[0] = a.x; wv[1] = a.y; wv[2] = a.z; wv[3] = a.w; wv[4] = b.x; wv[5] = b.y; wv[6] = b.z; wv[7] = b.w; }
#pragma unroll 4
    for (int it = gw; it < NITEMS; it += NGW) {
        const int cgp = it % NCG, row = it / NCG, c0 = cgp * 512 + lane * 8;
        float o[8]; unpack8(__builtin_nontemporal_load((const GAS v4u*)(O + (size_t)row * VDIM + c0)), o);
        float z[8]; unpack8(__builtin_nontemporal_load((const GAS v4u*)(Z + (size_t)row * VDIM + c0)), z);
        float ss = 0.f;
#pragma unroll
        for (int e = 0; e < 8; ++e) ss += o[e] * o[e];
        ss = sum16(ss);
        const float rs = 1.f / sqrtf(ss * (1.f / HD) + RMS_EPS);
#pragma unroll
        for (int e = 0; e < 8; ++e) o[e] = o[e] * rs * wv[e] * silu_f(z[e]);
        *(GAS v4u*)(A3 + (size_t)row * VDIM + c0) = pack8(o);
    }
}

struct Args { const float* in[14]; float* out; unsigned char* ws; int ph_lo, ph_hi, li, pad; };
__device__ __forceinline__ unsigned long long ptab_get(LAS unsigned char* lds, int i) {
    volatile LAS unsigned* p = (volatile LAS unsigned*)(lds + PTAB_OFF) + 2 * i;
    const unsigned lo = __builtin_amdgcn_readfirstlane(p[0]), hi = __builtin_amdgcn_readfirstlane(p[1]);
    return ((unsigned long long)hi << 32) | lo;
}
#ifndef SCAN_PROBE
#define SCAN_PROBE 0
#endif
#ifndef PREP_PROBE
#define PREP_PROBE 0
#endif
#ifndef REP_MASK
#define REP_MASK 0
#endif
#define REPS(t) for (int rep_ = 0; rep_ < 1 + ((REP_MASK >> (t)) & 1); ++rep_)
#define PIN(i) ((const float*)ptab_get(lds, (i)))
#define POUT ((float*)ptab_get(lds, 14))
#define PWS ((unsigned char*)ptab_get(lds, 15))
#define LOCAL_IDS int tid = threadIdx.x; asm volatile("" : "+v"(tid)); const int lane = tid & 63, wave = __builtin_amdgcn_readfirstlane(tid >> 6); const int G = gridDim.x, bx = blockIdx.x; \
    const int vcu = (G % 8 == 0) ? (bx % 8) * (G / 8) + bx / 8 : bx; const int gw = vcu * NWAVES + wave, NGW = G * NWAVES, gt = vcu * (NWAVES * 64) + tid, NGT = G * NWAVES * 64; \
    unsigned char* const ws = PWS; (void)lane; (void)gw; (void)NGW; (void)gt; (void)NGT; (void)ws
__global__ void __launch_bounds__(NWAVES * 64, 2) fwd(Args args) {
    extern __shared__ __attribute__((aligned(16))) unsigned char lds_raw[];
    LAS unsigned char* lds = (LAS unsigned char*)lds_raw;
    volatile LAS unsigned* MISC = (volatile LAS unsigned*)(lds + MISC_OFF);
    for (int u = threadIdx.x; u < (LDS_BYTES - LDSCTL_OFF) / 4; u += NWAVES * 64) ((LAS unsigned*)(lds + LDSCTL_OFF))[u] = 0u;
    __syncthreads();
    if (threadIdx.x == 0) {
        LAS unsigned long long* pt = (LAS unsigned long long*)(lds + PTAB_OFF);
#pragma unroll
        for (int i = 0; i < 14; ++i) pt[i] = (unsigned long long)args.in[i];
        pt[14] = (unsigned long long)args.out; pt[15] = (unsigned long long)args.ws;
    }
    __syncthreads();
    if (threadIdx.x == 0) { LAS unsigned* pw = (LAS unsigned*)(lds + PTAB_OFF) + 32; pw[0] = (unsigned)args.ph_lo; pw[1] = (unsigned)args.ph_hi; }
    if (!MK_PER_PHASE) (void)xcd_barrier_post((unsigned*)(args.ws + WS_CTL) + CW_BAR, MISC + 8);
    __syncthreads();
#define PH_LO ((int)__builtin_amdgcn_readfirstlane(((volatile LAS unsigned*)(lds + PTAB_OFF))[32]))
#define PH_HI ((int)__builtin_amdgcn_readfirstlane(((volatile LAS unsigned*)(lds + PTAB_OFF))[33]))
#define IN(k) (PH_LO <= (k) && (k) < PH_HI)
#define SEAM(k) do { if (!MK_PER_PHASE) { if (IN(k) && IN((k) + 1)) { XcdBarrier bar_; bar_.bar = (unsigned*)(PWS + WS_CTL) + CW_BAR; bar_.x = xb_xcc_id(); bar_.st = MISC + 8; xcd_barrier(bar_); } } } while (0)

    if (IN(0)) REPS(0) { LOCAL_IDS; Ptrs P; P.x = PIN(0); P.sc_w_in = PIN(1); P.sc_w_out = PIN(3); P.dn_w_in = PIN(4); P.dn_w_out = PIN(9); P.ffn_gu = PIN(10); P.ffn_down = PIN(11); P.ws = ws;
        p0_prologue(P, lds, gw, NGW, wave, lane); }
    SEAM(0);

    for (int L = 0; L < DEPTH; ++L) {
        const int j = L >> 1;
        const int pb = 1 + 17 * j + ((L & 1) ? 7 : 0);
        int fb;
        if ((L & 1) == 0) {
            if (IN(pb + 0)) REPS(1) {
                LOCAL_IDS;
                pg8::Gemm g{(const bf16*)(ws + WS_XB), (const bf16*)(ws + WS_W_SCIN) + (size_t)j * 3 * DM * DM, M, 3 * DM, DM}; pg8::StaticOrder S; S.init(M, 3 * DM, G, bx);
                pg8::EpiGate<0> E{(bf16*)(ws + WS_GB), DM, (bf16*)(ws + WS_CU), DM, DM / 256};
                pg8::gemm_phase<pg8::EpiGate<0>, pg8::StaticOrder, PG8_ALIGN, PG8_SP2>(lds + RING_OFF, g, S, E);
            }
            SEAM(pb + 0);
            if (IN(pb + 1)) REPS(2) { LOCAL_IDS; sc_conv_phase((const bf16*)(ws + WS_GB), (const bf16*)(ws + WS_CU), PIN(2) + (size_t)j * 3 * DM, (bf16*)(ws + WS_A2), gt, NGT); }
            SEAM(pb + 1);
            if (IN(pb + 2)) REPS(3) {
                LOCAL_IDS;
                pg8::Gemm g{(const bf16*)(ws + WS_A2), (const bf16*)(ws + WS_W_SCOUT) + (size_t)j * DM * DM, M, DM, DM}; pg8::StaticOrder S; S.init(M, DM, G, bx);
                pg8::EpiStore2 E{(bf16*)(ws + WS_H1), DM, (bf16*)(ws + WS_H1), DM, 1 << 30};
                pg8::gemm_phase<pg8::EpiStore2, pg8::StaticOrder, PG8_ALIGN, PG8_SP2>(lds + RING_OFF, g, S, E);
            }
            SEAM(pb + 2);
#define LN_ARGS(s_) (const bf16*)(ws + WS_XB), (const bf16*)(ws + WS_H1), PIN(12) + (size_t)(L * 2 + (s_)) * DM, PIN(13) + (size_t)(L * 2 + (s_)) * DM, POUT, (rep_ ? (bf16*)POUT : (bf16*)(ws + WS_XB)), gw, NGW, lane
#if XRES_BF16
            if (IN(pb + 3)) REPS(4) { LOCAL_IDS; if (L == 0) ln_phase<true, false, true>(PIN(0), LN_ARGS(0)); else ln_phase<false, false, true>(PIN(0), LN_ARGS(0)); }
#else
            if (IN(pb + 3)) { LOCAL_IDS; const int rep_ = 0; ln_phase<true, true, true>((L == 0) ? PIN(0) : (const float*)POUT, LN_ARGS(0)); }
#endif
            SEAM(pb + 3);
            fb = pb + 4;
        } else {
            if (IN(pb + 0)) REPS(5) {
                LOCAL_IDS;
                pg8::Gemm g{(const bf16*)(ws + WS_XB), (const bf16*)(ws + WS_W_DNIN) + (size_t)j * DNP_MAIN * DM, M, DNP_MAIN, DM}; pg8::StaticOrder S; S.init(M, DNP_MAIN, G, bx);
                pg8::EpiStore2 E{(bf16*)(ws + WS_QKV), QKV, (bf16*)(ws + WS_Z), VDIM, QKV};
                pg8::gemm_phase<pg8::EpiStore2, pg8::StaticOrder, PG8_ALIGN, PG8_SP2>(lds + RING_OFF, g, S, E);
            }
            if (IN(pb + 0)) {
                LOCAL_IDS;
                for (int u = bx; u < M / 64; u += G) ba_phase((const bf16*)(ws + WS_XB), (const bf16*)(ws + WS_W_BA) + (size_t)j * 64 * DM, (float*)(ws + WS_BA), lds, u, wave, lane, tid);
            }
            SEAM(pb + 0);
#if DN_CHUNKED
            if (IN(pb + 2)) { LOCAL_IDS; constexpr int NIT = BATCH * HK * (SEQ / 64);
                v4u rowv[11];
                prep_load_rows((const bf16*)(ws + WS_QKV), vcu < NIT ? vcu : 0, tid, rowv);
                PrepPre pp; prep_load_aux(PIN(5) + (size_t)j * 4 * QKV, (const float*)(ws + WS_BA), vcu < NIT ? vcu : 0, tid, pp);
                for (int it = vcu; it < NIT; it += G) {
                    dn_prep_item<15>((const bf16*)(ws + WS_QKV), PIN(5) + (size_t)j * 4 * QKV, (const float*)(ws + WS_BA), PIN(6) + j * HV, PIN(7) + j * HV,
                                     (bf16*)(ws + WS_WF2), (bf16*)(ws + WS_QF), (bf16*)(ws + WS_KF), (bf16*)(ws + WS_AQKF), (bf16*)(ws + WS_UF2), (float*)(ws + WS_SC), lds, it, (it + G < NIT) ? it + G : -1, rowv, pp, tid, wave, lane);
#if PREP_PROBE
                    { v4u rowp[11]; prep_load_rows((const bf16*)(ws + WS_QKV), it, tid, rowp); PrepPre pq; prep_load_aux(PIN(5) + (size_t)j * 4 * QKV, (const float*)(ws + WS_BA), it, tid, pq);
                      dn_prep_item<PREP_PROBE>((const bf16*)(ws + WS_QKV), PIN(5) + (size_t)j * 4 * QKV, (const float*)(ws + WS_BA), PIN(6) + j * HV, PIN(7) + j * HV,
                                     (bf16*)(ws + WS_WF2), (bf16*)(ws + WS_QF), (bf16*)(ws + WS_KF), (bf16*)(ws + WS_AQKF), (bf16*)(ws + WS_UF2), (float*)(ws + WS_SC), lds, it, -1, rowp, pq, tid, wave, lane); }
#endif
                } }
            SEAM(pb + 2);
            if (IN(pb + 3)) REPS(12) { LOCAL_IDS; for (int u = vcu; u < BATCH * HV * 4; u += G)
                dn_scan_phase<0>((const bf16*)(ws + WS_WF2), (const bf16*)(ws + WS_QF), (const bf16*)(ws + WS_KF), (const bf16*)(ws + WS_AQKF), (const bf16*)(ws + WS_UF2), (const float*)(ws + WS_SC), (bf16*)(ws + WS_O), lds, u, wave, lane); }
#if SCAN_PROBE
            if (IN(pb + 3)) { LOCAL_IDS; for (int u = vcu; u < BATCH * HV * 4; u += G)
                dn_scan_phase<SCAN_PROBE>((const bf16*)(ws + WS_WF2), (const bf16*)(ws + WS_QF), (const bf16*)(ws + WS_KF), (const bf16*)(ws + WS_AQKF), (const bf16*)(ws + WS_UF2), (const float*)(ws + WS_SC), (bf16*)(ws + WS_O), lds, u, wave, lane); }
#endif
            SEAM(pb + 3);
            if (IN(pb + 4)) REPS(8) { LOCAL_IDS; dn_gnorm_phase((const bf16*)(ws + WS_O), (const bf16*)(ws + WS_Z), PIN(8) + j * HD, (bf16*)(ws + WS_A3), gw, NGW, lane); }
#else
#error "the token-recurrent reference path was removed (see the earlier versions); build with DN_CHUNKED = 1"
#endif
            SEAM(pb + 4);
            if (IN(pb + 5)) REPS(9) {
                LOCAL_IDS;
                pg8::Gemm g{(const bf16*)(ws + WS_A3), (const bf16*)(ws + WS_W_DNOUT) + (size_t)j * DM * VDIM, M, DM, VDIM}; pg8::StaticOrder S; S.init(M, DM, G, bx);
                pg8::EpiStore2 E{(bf16*)(ws + WS_H1), DM, (bf16*)(ws + WS_H1), DM, 1 << 30};
                pg8::gemm_phase<pg8::EpiStore2, pg8::StaticOrder, PG8_ALIGN, PG8_SP2>(lds + RING_OFF, g, S, E);
            }
            SEAM(pb + 5);
#if XRES_BF16
            if (IN(pb + 6)) REPS(4) { LOCAL_IDS; ln_phase<false, false, true>(PIN(0), LN_ARGS(0)); }
#else
            if (IN(pb + 6)) { LOCAL_IDS; const int rep_ = 0; ln_phase<true, true, true>((const float*)POUT, LN_ARGS(0)); }
#endif
            SEAM(pb + 6);
            fb = pb + 7;
        }
        if (IN(fb + 0)) REPS(10) {
            LOCAL_IDS;
            pg8::Gemm g{(const bf16*)(ws + WS_XB), (const bf16*)(ws + WS_W_GU) + (size_t)L * 2 * FF * DM, M, 2 * FF, DM}; pg8::StaticOrder S; S.init(M, 2 * FF, G, bx);
            pg8::EpiGate<1> E{(bf16*)(ws + WS_HID), FF, (bf16*)(ws + WS_HID), FF, 0};
            pg8::gemm_phase<pg8::EpiGate<1>, pg8::StaticOrder, PG8_ALIGN, PG8_SP2>(lds + RING_OFF, g, S, E);
        }
        SEAM(fb + 0);
        if (IN(fb + 1)) REPS(11) {
            LOCAL_IDS;
            pg8::Gemm g{(const bf16*)(ws + WS_HID), (const bf16*)(ws + WS_W_DOWN) + (size_t)L * DM * FF, M, DM, FF}; pg8::StaticOrder S; S.init(M, DM, G, bx);
            pg8::EpiStore2 E{(bf16*)(ws + WS_H1), DM, (bf16*)(ws + WS_H1), DM, 1 << 30};
            pg8::gemm_phase<pg8::EpiStore2, pg8::StaticOrder, PG8_ALIGN, PG8_SP2>(lds + RING_OFF, g, S, E);
        }
        SEAM(fb + 1);
#if XRES_BF16
        if (IN(fb + 2)) REPS(4) { LOCAL_IDS; if (L == DEPTH - 1) { if (rep_ == 0) ln_phase<false, true, false>(PIN(0), LN_ARGS(1)); } else ln_phase<false, false, true>(PIN(0), LN_ARGS(1)); }
#else
        if (IN(fb + 2)) { LOCAL_IDS; const int rep_ = 0; ln_phase<true, true, true>((const float*)POUT, LN_ARGS(1)); }
#endif
        SEAM(fb + 2);
    }
#undef IN
#undef SEAM
}

extern "C" void kernel_launch(void* const* d_in, const int* in_sizes, int n_in, void* d_out, int out_size, void* d_ws, size_t ws_size, hipStream_t stream) {
    static int grid = 0;
    if (grid == 0) {
        if (n_in != 14 || in_sizes[0] != M * DM || out_size != M * DM || ws_size < WS_END) { fprintf(stderr, "kernel_launch: unexpected shapes (n_in %d, in0 %d, out %d, ws %zu < %zu); nothing launched\n", n_in, n_in > 0 ? in_sizes[0] : -1, out_size, ws_size, (size_t)WS_END); grid = -1; return; }
        int dev = 0, cus = 0, per_cu = 0;
        if (hipGetDevice(&dev) != hipSuccess || hipDeviceGetAttribute(&cus, hipDeviceAttributeMultiprocessorCount, dev) != hipSuccess) { grid = -1; return; }
        if (hipFuncSetAttribute((const void*)fwd, hipFuncAttributeMaxDynamicSharedMemorySize, LDS_BYTES) != hipSuccess) { fprintf(stderr, "kernel_launch: hipFuncSetAttribute failed\n"); grid = -1; return; }
        if (hipOccupancyMaxActiveBlocksPerMultiprocessor(&per_cu, (const void*)fwd, NWAVES * 64, LDS_BYTES) != hipSuccess || per_cu < 1) fprintf(stderr, "kernel_launch: occupancy query reports %d\n", per_cu);
        (void)hipGetLastError();
        grid = cus;
        if (grid > 256) grid = 256;
    }
    if (grid < 0) return;
    if (hipMemsetAsync((char*)d_ws + WS_CTL, 0, CTL_ZERO_BYTES, stream) != hipSuccess) return;
    Args a{};
    for (int i = 0; i < 14; ++i) a.in[i] = (const float*)d_in[i];
    a.out = (float*)d_out; a.ws = (unsigned char*)d_ws;
#if MK_PER_PHASE
    for (int p = 0; p < N_PHASES; ++p) { a.ph_lo = p; a.ph_hi = p + 1; a.li = p; hipLaunchKernelGGL(fwd, dim3(grid), dim3(NWAVES * 64), LDS_BYTES, stream, a); }
#else
    a.ph_lo = 0; a.ph_hi = N_PHASES; a.li = 0;
    hipLaunchKernelGGL(fwd, dim3(grid), dim3(NWAVES * 64), LDS_BYTES, stream, a);
#endif
}
```
